# Optimizing an MI355X kernel written in HIP

```python
import jax, jax.numpy as jnp
from jax import lax
import numpy as np

D_MODEL = 1024
BATCH = 8
SEQ = 2048
DEPTH = 1

D_MIX = 1024
POOL_WINDOWS = (2, 4, 8, 16)
POOL_WIDTH = 512
POOL_GROUP = POOL_WIDTH // len(POOL_WINDOWS)
N_HEADS = 8
N_KV_HEADS = 2
HEAD_DIM = 64
ATTN_WIDTH = N_HEADS * HEAD_DIM
KV_WIDTH = N_KV_HEADS * HEAD_DIM
N_IDX_HEADS = 8
IDX_DIM = 64
TOPK_MAX = 256
ROPE_THETA = 10000.0
Q_BLOCK = 128
EPS = 1e-6
SPLITS = (POOL_WIDTH, POOL_WIDTH, ATTN_WIDTH, KV_WIDTH, KV_WIDTH, ATTN_WIDTH,
          N_IDX_HEADS * IDX_DIM, IDX_DIM, N_IDX_HEADS)
D_IN_PROJ = 2888

kernel_name = "hybrid_pool_dsa_parallel_heads"


def rms_norm(x, w):
    xf = x.astype(jnp.float32)
    y = xf * lax.rsqrt(jnp.mean(xf * xf, axis=-1, keepdims=True) + EPS)
    return (y * w.astype(jnp.float32)).astype(x.dtype)


def rope(x, pos):
    d = x.shape[-1]
    half = d // 2
    freqs = ROPE_THETA ** (-jnp.arange(half, dtype=jnp.float32) / half)
    ang = pos.astype(jnp.float32)[:, None] * freqs[None, :]
    cos = jnp.cos(ang)[None, :, None, :]
    sin = jnp.sin(ang)[None, :, None, :]
    xf = x.astype(jnp.float32)
    x1, x2 = xf[..., :half], xf[..., half:]
    out = jnp.concatenate([x1 * cos - x2 * sin, x2 * cos + x1 * sin], axis=-1)
    return out.astype(x.dtype)


def pool_mixer(u, w_pool, pool_scale):
    B, S, _ = u.shape
    ug = u.reshape(B, S, len(POOL_WINDOWS), POOL_GROUP).astype(jnp.float32)
    cs = jnp.cumsum(ug, axis=1)
    n_avail = jnp.arange(1, S + 1)
    means = []
    for g, w in enumerate(POOL_WINDOWS):
        csg = cs[:, :, g]
        lag = jnp.pad(csg, ((0, 0), (w, 0), (0, 0)))[:, :S]
        cnt = jnp.minimum(n_avail, w).astype(jnp.float32)[None, :, None]
        means.append((csg - lag) / cnt)
    pooled = jnp.stack(means, axis=2) - ug
    mixed = jnp.einsum('bsgc,gcd->bsgd', pooled, w_pool.astype(jnp.float32))
    mixed = mixed.reshape(B, S, POOL_WIDTH) * pool_scale.astype(jnp.float32)
    return mixed.astype(u.dtype)


def dsa_attention(q, k, v, q_idx, k_idx, w_idx):
    B, S = q.shape[0], q.shape[1]
    nb = S // Q_BLOCK
    k_top = min(TOPK_MAX, S // 4)
    grp = N_HEADS // N_KV_HEADS
    key_pos = jnp.arange(S)
    kf_idx = k_idx.astype(jnp.float32)

    def to_blocks(a):
        return jnp.moveaxis(a.reshape(B, nb, Q_BLOCK, *a.shape[2:]), 1, 0)

    def one_block(args):
        blk, qb, qib, wb = args
        q_pos = blk * Q_BLOCK + jnp.arange(Q_BLOCK)
        logits = jnp.einsum('bqhd,bsd->bqhs', qib.astype(jnp.float32), kf_idx) * (IDX_DIM ** -0.5)
        score = jnp.einsum('bqhs,bqh->bqs', jax.nn.relu(logits),
                           wb.astype(jnp.float32)) * (N_IDX_HEADS ** -0.5)
        causal = key_pos[None, :] <= q_pos[:, None]
        score = jnp.where(causal[None], score, -jnp.inf)
        _, sel = lax.top_k(score, k_top)
        valid = sel <= q_pos[None, :, None]
        k_sel = jax.vmap(lambda kk, ii: kk[ii])(k, sel)
        v_sel = jax.vmap(lambda vv, ii: vv[ii])(v, sel)
        qg = qb.reshape(B, Q_BLOCK, N_KV_HEADS, grp, HEAD_DIM).astype(jnp.float32)
        s = jnp.einsum('bqhgd,bqkhd->bqhgk', qg, k_sel.astype(jnp.float32)) * (HEAD_DIM ** -0.5)
        s = jnp.where(valid[:, :, None, None, :], s, -jnp.inf)
        p = jax.nn.softmax(s, axis=-1)
        o = jnp.einsum('bqhgk,bqkhd->bqhgd', p, v_sel.astype(jnp.float32))
        return o.reshape(B, Q_BLOCK, ATTN_WIDTH).astype(q.dtype)

    out = lax.map(one_block, (jnp.arange(nb), to_blocks(q), to_blocks(q_idx), to_blocks(w_idx)))
    return jnp.moveaxis(out, 0, 1).reshape(B, S, ATTN_WIDTH)


def setup_inputs(seed: int = 0) -> dict:
    key = jax.random.key(seed)
    ks = jax.random.split(key, 12)
    f32 = jnp.float32
    x = jax.random.normal(ks[0], (BATCH, SEQ, D_MODEL), f32)
    c = jax.random.normal(ks[1], (BATCH, D_MODEL), f32)
    norm_w = 1.0 + 0.1 * jax.random.normal(ks[2], (DEPTH, D_MODEL), f32)
    w_ada = jax.random.normal(ks[3], (DEPTH, D_MODEL, 3 * D_MODEL), f32) * D_MODEL ** -0.5
    b_ada = 0.01 * jax.random.normal(ks[4], (DEPTH, 3 * D_MODEL), f32)
    w_in = jax.random.normal(ks[5], (DEPTH, D_MODEL, D_IN_PROJ), f32) * D_MODEL ** -0.5
    q_norm_w = 1.0 + 0.1 * jax.random.normal(ks[6], (DEPTH, HEAD_DIM), f32)
    k_norm_w = 1.0 + 0.1 * jax.random.normal(ks[7], (DEPTH, HEAD_DIM), f32)
    w_pool = jax.random.normal(ks[8], (DEPTH, len(POOL_WINDOWS), POOL_GROUP, POOL_GROUP), f32) * POOL_GROUP ** -0.5
    pool_scale = 1.0 + 0.1 * jax.random.normal(ks[9], (DEPTH, POOL_WIDTH), f32)
    w_out = jax.random.normal(ks[10], (DEPTH, D_MIX, D_MODEL), f32) * D_MIX ** -0.5
    return {"x": x, "c": c, "norm_w": norm_w, "w_ada": w_ada, "b_ada": b_ada,
            "w_in": w_in, "q_norm_w": q_norm_w, "k_norm_w": k_norm_w,
            "w_pool": w_pool, "pool_scale": pool_scale, "w_out": w_out}


def reference(x, c, norm_w, w_ada, b_ada, w_in, q_norm_w, k_norm_w, w_pool, pool_scale, w_out):
    B, S, _ = x.shape
    pos = jnp.arange(S)
    split_points = [int(p) for p in np.cumsum(SPLITS)[:-1]]
    for l in range(DEPTH):
        mod = jnp.einsum('bd,de->be', jax.nn.silu(c), w_ada[l]) + b_ada[l]
        shift, scale, gate = jnp.split(mod, 3, axis=-1)
        h = rms_norm(x, norm_w[l]) * (1.0 + scale[:, None, :]) + shift[:, None, :]
        proj = jnp.einsum('bsd,de->bse', h, w_in[l])
        u_pool, g_pool, q, k, v, g_attn, qi, ki, wi = jnp.split(proj, split_points, axis=-1)
        pool_out = pool_mixer(u_pool, w_pool[l], pool_scale[l]) * jax.nn.silu(g_pool)
        q = rope(rms_norm(q.reshape(B, S, N_HEADS, HEAD_DIM), q_norm_w[l]), pos)
        k = rope(rms_norm(k.reshape(B, S, N_KV_HEADS, HEAD_DIM), k_norm_w[l]), pos)
        v = v.reshape(B, S, N_KV_HEADS, HEAD_DIM)
        qi = rope(qi.reshape(B, S, N_IDX_HEADS, IDX_DIM), pos)
        ki = rope(ki[:, :, None, :], pos)[:, :, 0, :]
        attn_out = dsa_attention(q, k, v, qi, ki, wi) * jax.nn.silu(g_attn)
        y = jnp.einsum('bse,ed->bsd', jnp.concatenate([pool_out, attn_out], axis=-1), w_out[l])
        x = x + gate[:, None, :] * y
    return x
```

```cpp
#include <hip/hip_runtime.h>
#include <stdint.h>

typedef unsigned short u16;
typedef _Float16 bf16x8 __attribute__((ext_vector_type(8)));
typedef float f32x16 __attribute__((ext_vector_type(16)));

constexpr int NB = 8, SEQ = 2048, DM = 1024, MT = NB * SEQ;
constexpr int NPROJ = 2888, NPAD = 3072;
constexpr float QSCALE = 0.18033688011112042f;
constexpr float EPS = 1e-6f;

constexpr size_t WS_MOD = 0;
constexpr size_t WS_ROPE = WS_MOD + (size_t)NB * 3072 * 4;
constexpr size_t WS_WINT = WS_ROPE + (size_t)SEQ * 32 * 8;
constexpr size_t WS_WOUTT = WS_WINT + (size_t)NPAD * DM * 2;
constexpr size_t WS_XN = WS_WOUTT + (size_t)DM * DM * 2;
constexpr size_t WS_U = WS_XN + (size_t)MT * DM * 2;
constexpr size_t WS_SG = WS_U + (size_t)MT * 512 * 2;
constexpr size_t WS_Q = WS_SG + (size_t)MT * 512 * 2;
constexpr size_t WS_GA = WS_Q + (size_t)MT * 512 * 2;
constexpr size_t WS_QI = WS_GA + (size_t)MT * 512 * 2;
constexpr size_t WS_K = WS_QI + (size_t)MT * 512 * 2;
constexpr size_t WS_V = WS_K + (size_t)MT * 128 * 2;
constexpr size_t WS_KI = WS_V + (size_t)MT * 128 * 2;
constexpr size_t WS_WI = WS_KI + (size_t)MT * 64 * 2;
constexpr size_t WS_MASK = WS_WI + (size_t)MT * 8 * 4;
constexpr size_t WS_MIX = WS_MASK + (size_t)MT * 64 * 4;
constexpr size_t WS_END = WS_MIX + (size_t)MT * DM * 2;

__device__ __forceinline__ u16 f2bf(float f) { return __builtin_bit_cast(u16, (_Float16)f); }
__device__ __forceinline__ float bf2f(u16 h) { return (float)__builtin_bit_cast(_Float16, h); }
__device__ __forceinline__ float silu_f(float v) { return v / (1.f + __expf(-v)); }
__device__ __forceinline__ float wave_sum(float v) {
#pragma unroll
    for (int o = 1; o < 64; o <<= 1) v += __shfl_xor(v, o);
    return v;
}

__constant__ double ROPE_FREQ[32] = {1.0,0.7498942093324559,0.5623413251903491,0.4216965034285822,0.31622776601683794,0.23713737056616552,0.1778279410038923,0.1333521432163324,0.1,0.07498942093324558,0.05623413251903491,0.042169650342858224,0.03162277660168379,0.023713737056616554,0.01778279410038923,0.01333521432163324,0.01,0.007498942093324558,0.005623413251903491,0.004216965034285823,0.0031622776601683794,0.0023713737056616554,0.0017782794100389228,0.001333521432163324,0.001,0.0007498942093324559,0.0005623413251903491,0.00042169650342858224,0.00031622776601683794,0.00023713737056616554,0.00017782794100389227,0.0001333521432163324};

__global__ __launch_bounds__(256) void k_mod(const float* __restrict__ c, const float* __restrict__ w_ada, const float* __restrict__ b_ada, float* __restrict__ mod) {
    __shared__ float sc[DM];
    const int b = blockIdx.y;
    for (int i = threadIdx.x; i < DM; i += 256) sc[i] = silu_f(c[b * DM + i]);
    __syncthreads();
    const int e = blockIdx.x * 256 + threadIdx.x;
    float acc = b_ada[e];
    for (int d = 0; d < DM; ++d) acc += sc[d] * w_ada[(size_t)d * 3072 + e];
    mod[b * 3072 + e] = acc;
}

__global__ __launch_bounds__(256) void k_rope(float2* __restrict__ tab) {
    const int idx = blockIdx.x * 256 + threadIdx.x;
    const int pos = idx >> 5, i = idx & 31;
    const double ang = (double)pos * ROPE_FREQ[i];
    double t = ang * 0.15915494309189533576888;
    t -= floor(t + 0.5);
    const double x = t * 6.283185307179586476925287, x2 = x * x;
    double s = 0.0, cc = 0.0, ts = x, tc = 1.0;
#pragma unroll 1
    for (int n = 0; n < 14; ++n) { cc += tc; s += ts; tc *= -x2 / (double)((2 * n + 1) * (2 * n + 2)); ts *= -x2 / (double)((2 * n + 2) * (2 * n + 3)); }
    tab[idx] = make_float2((float)cc, (float)s);
}

__global__ __launch_bounds__(256) void k_convw(const float* __restrict__ w, int N, int Npad, u16* __restrict__ wt) {
    const size_t idx = (size_t)blockIdx.x * 256 + threadIdx.x;
    if (idx >= (size_t)Npad * DM) return;
    const int n = (int)(idx >> 10), k = (int)(idx & 1023);
    wt[idx] = n < N ? f2bf(w[(size_t)k * N + n]) : (u16)0;
}

__global__ __launch_bounds__(256) void k_xn(const float* __restrict__ x, const float* __restrict__ nw, const float* __restrict__ mod, u16* __restrict__ xn) {
    const int row = blockIdx.x * 4 + (threadIdx.x >> 6), lane = threadIdx.x & 63, b = row >> 11;
    const float4* xr = (const float4*)(x + (size_t)row * DM) + lane;
    float4 v[4]; float s = 0.f;
#pragma unroll
    for (int j = 0; j < 4; ++j) { v[j] = xr[64 * j]; s += v[j].x * v[j].x + v[j].y * v[j].y + v[j].z * v[j].z + v[j].w * v[j].w; }
    const float rstd = rsqrtf(wave_sum(s) * (1.f / DM) + EPS);
    const float* shift = mod + b * 3072; const float* scale = shift + 1024;
#pragma unroll
    for (int j = 0; j < 4; ++j) {
        const int k = 4 * lane + 256 * j;
        const float4 w4 = *(const float4*)(nw + k), s4 = *(const float4*)(scale + k), h4 = *(const float4*)(shift + k);
        const float o0 = v[j].x * rstd * w4.x * (1.f + s4.x) + h4.x, o1 = v[j].y * rstd * w4.y * (1.f + s4.y) + h4.y;
        const float o2 = v[j].z * rstd * w4.z * (1.f + s4.z) + h4.z, o3 = v[j].w * rstd * w4.w * (1.f + s4.w) + h4.w;
        ushort4 o; o.x = f2bf(o0); o.y = f2bf(o1); o.z = f2bf(o2); o.w = f2bf(o3);
        *(ushort4*)(xn + (size_t)row * DM + k) = o;
    }
}

struct P1Out { u16 *U, *SG, *Q, *GA, *QI, *K, *V, *KI; float* WI; };
__global__ __launch_bounds__(256) void k_gemm1(const u16* __restrict__ XN, const u16* __restrict__ WinT, const float* __restrict__ qnw, const float* __restrict__ knw,
                                                const float2* __restrict__ rope, P1Out o) {
    __shared__ float tile[64][65];
    const int g = blockIdx.x, r0 = blockIdx.y * 64, tid = threadIdx.x, w = tid >> 6, lane = tid & 63;
    const int wr = w & 1, wcn = w >> 1;
    const u16* ap = XN + (size_t)(r0 + wr * 32 + (lane & 31)) * DM + 8 * (lane >> 5);
    const u16* bp = WinT + (size_t)(g * 64 + wcn * 32 + (lane & 31)) * DM + 8 * (lane >> 5);
    f32x16 acc;
#pragma unroll
    for (int r = 0; r < 16; ++r) acc[r] = 0.f;
    for (int k0 = 0; k0 < DM; k0 += 16) {
        const bf16x8 a = *(const bf16x8*)(ap + k0), bb = *(const bf16x8*)(bp + k0);
        acc = __builtin_amdgcn_mfma_f32_32x32x16_f16(a, bb, acc, 0, 0, 0);
    }
#pragma unroll
    for (int r = 0; r < 16; ++r) tile[wr * 32 + (r & 3) + 8 * (r >> 2) + 4 * (lane >> 5)][wcn * 32 + (lane & 31)] = acc[r];
    __syncthreads();
    const int row = tid >> 2, sub = tid & 3, t = r0 + row, pos = t & (SEQ - 1);
    const float* tr = tile[row];
    if (g < 8) {
        for (int c = 16 * sub; c < 16 * sub + 16; ++c) o.U[(size_t)t * 512 + g * 64 + c] = f2bf(tr[c]);
    } else if (g < 16) {
        for (int c = 16 * sub; c < 16 * sub + 16; ++c) o.SG[(size_t)t * 512 + (g - 8) * 64 + c] = f2bf(silu_f(tr[c]));
    } else if (g < 26) {
        float ss = 0.f;
        for (int c = 16 * sub; c < 16 * sub + 16; ++c) ss += tr[c] * tr[c];
        ss += __shfl_xor(ss, 1); ss += __shfl_xor(ss, 2);
        const float rinv = rsqrtf(ss * (1.f / 64.f) + EPS);
        const bool isq = g < 24; const float* nwp = isq ? qnw : knw; const float osc = isq ? QSCALE : 1.f;
        u16* dst = isq ? o.Q + (size_t)t * 512 + (g - 16) * 64 : o.K + (size_t)t * 128 + (g - 24) * 64;
        for (int i = 8 * sub; i < 8 * sub + 8; ++i) {
            const float x1 = tr[i] * rinv * nwp[i], x2 = tr[i + 32] * rinv * nwp[i + 32];
            const float2 cs = rope[pos * 32 + i];
            dst[i] = f2bf((x1 * cs.x - x2 * cs.y) * osc); dst[i + 32] = f2bf((x2 * cs.x + x1 * cs.y) * osc);
        }
    } else if (g < 28) {
        for (int c = 16 * sub; c < 16 * sub + 16; ++c) o.V[(size_t)t * 128 + (g - 26) * 64 + c] = f2bf(tr[c]);
    } else if (g < 36) {
        for (int c = 16 * sub; c < 16 * sub + 16; ++c) o.GA[(size_t)t * 512 + (g - 28) * 64 + c] = f2bf(silu_f(tr[c]));
    } else if (g < 45) {
        u16* dst = g < 44 ? o.QI + (size_t)t * 512 + (g - 36) * 64 : o.KI + (size_t)t * 64;
        for (int i = 8 * sub; i < 8 * sub + 8; ++i) {
            const float x1 = tr[i], x2 = tr[i + 32];
            const float2 cs = rope[pos * 32 + i];
            dst[i] = f2bf(x1 * cs.x - x2 * cs.y); dst[i + 32] = f2bf(x2 * cs.x + x1 * cs.y);
        }
    } else {
        if (sub == 0) for (int c = 0; c < 8; ++c) o.WI[(size_t)t * 8 + c] = tr[c];
    }
}

__global__ __launch_bounds__(256) void k_pool(const u16* __restrict__ U, const u16* __restrict__ SG, const float* __restrict__ w_pool, const float* __restrict__ pool_scale, u16* __restrict__ MIX) {
    __shared__ float pl[64][128];
    const int t0 = blockIdx.x * 64, g = blockIdx.y, tid = threadIdx.x, win = 2 << g;
    for (int idx = tid; idx < 64 * 128; idx += 256) {
        const int tl = idx >> 7, c = idx & 127, t = t0 + tl, pos = t & (SEQ - 1);
        const int cnt = (pos + 1 < win) ? pos + 1 : win;
        float s = 0.f;
        for (int j = 0; j < cnt; ++j) s += bf2f(U[(size_t)(t - j) * 512 + g * 128 + c]);
        pl[tl][c] = s / (float)cnt - bf2f(U[(size_t)t * 512 + g * 128 + c]);
    }
    __syncthreads();
    const int d = tid & 127, rh = tid >> 7;
    float acc[32];
#pragma unroll
    for (int i = 0; i < 32; ++i) acc[i] = 0.f;
    const float* wp = w_pool + (size_t)g * 128 * 128 + d;
    for (int c = 0; c < 128; ++c) {
        const float wv = wp[(size_t)c * 128];
#pragma unroll
        for (int i = 0; i < 32; ++i) acc[i] += pl[rh * 32 + i][c] * wv;
    }
    const float ps = pool_scale[g * 128 + d];
#pragma unroll
    for (int i = 0; i < 32; ++i) {
        const int t = t0 + rh * 32 + i;
        MIX[(size_t)t * 1024 + g * 128 + d] = f2bf(acc[i] * ps * bf2f(SG[(size_t)t * 512 + g * 128 + d]));
    }
}

__device__ __forceinline__ unsigned fkey(float f) { const unsigned u = __float_as_uint(f); return (u & 0x80000000u) ? ~u : (u | 0x80000000u); }

__device__ __forceinline__ int block_sum_int(int v, int* red) {
#pragma unroll
    for (int o = 1; o < 64; o <<= 1) v += __shfl_xor(v, o);
    __syncthreads();
    if ((threadIdx.x & 63) == 0) red[threadIdx.x >> 6] = v;
    __syncthreads();
    return red[0] + red[1] + red[2] + red[3];
}

__global__ __launch_bounds__(256) void k_selattn(const u16* __restrict__ Q, const u16* __restrict__ K, const u16* __restrict__ V, const u16* __restrict__ GA, const u16* __restrict__ QI,
                                                  const u16* __restrict__ KI, const float* __restrict__ WI, unsigned* __restrict__ MASK, u16* __restrict__ MIX) {
    __shared__ float qs[512];
    __shared__ unsigned keys[SEQ];
    __shared__ unsigned mk[64];
    __shared__ int wpre[65];
    __shared__ int red[4];
    __shared__ int sel[256];
    __shared__ float p[256][9];
    __shared__ float hm[8], hl[8];
    const int t = blockIdx.x, b = t >> 11, pos = t & (SEQ - 1), n = pos + 1, tid = threadIdx.x;
    for (int i = tid; i < 512; i += 256) qs[i] = bf2f(QI[(size_t)t * 512 + i]);
    if (tid < 64) mk[tid] = 0u;
    float wi[8];
#pragma unroll
    for (int h = 0; h < 8; ++h) wi[h] = WI[(size_t)t * 8 + h];
    __syncthreads();
    for (int s = tid; s < n; s += 256) {
        const u16* kp = KI + (size_t)(b * SEQ + s) * 64;
        float kv[64];
#pragma unroll
        for (int i = 0; i < 8; ++i) { const bf16x8 v8 = *(const bf16x8*)(kp + 8 * i);
#pragma unroll
            for (int j = 0; j < 8; ++j) kv[8 * i + j] = (float)v8[j]; }
        float sc = 0.f;
#pragma unroll
        for (int h = 0; h < 8; ++h) { float d = 0.f;
#pragma unroll
            for (int i = 0; i < 64; ++i) d += qs[h * 64 + i] * kv[i];
            sc += wi[h] * fmaxf(d, 0.f); }
        keys[s] = fkey(sc);
    }
    __syncthreads();
    if (n <= 256) {
        for (int s = tid; s < n; s += 256) atomicOr(&mk[s >> 5], 1u << (s & 31));
    } else {
        unsigned T = 0u;
        for (int bit = 31; bit >= 0; --bit) {
            const unsigned cand = T | (1u << bit);
            int c = 0;
            for (int s = tid; s < n; s += 256) c += keys[s] >= cand;
            if (block_sum_int(c, red) >= 256) T = cand;
        }
        int c = 0;
        for (int s = tid; s < n; s += 256) c += keys[s] > T;
        const int cgt = block_sum_int(c, red);
        for (int s = tid; s < n; s += 256) if (keys[s] > T) atomicOr(&mk[s >> 5], 1u << (s & 31));
        __syncthreads();
        if (tid == 0) { int need = 256 - cgt; for (int s = 0; s < n && need > 0; ++s) if (keys[s] == T) { mk[s >> 5] |= 1u << (s & 31); --need; } }
    }
    __syncthreads();
    if (tid < 64) MASK[(size_t)t * 64 + tid] = mk[tid];
    if (tid == 0) { int a = 0; for (int i = 0; i < 64; ++i) { wpre[i] = a; a += __popc(mk[i]); } wpre[64] = a; }
    __syncthreads();
    const int nsel = wpre[64];
    for (int s = tid; s < n; s += 256) { const unsigned wv = mk[s >> 5]; if ((wv >> (s & 31)) & 1u) sel[wpre[s >> 5] + __popc(wv & ((1u << (s & 31)) - 1u))] = s; }
    for (int i = tid; i < 512; i += 256) qs[i] = bf2f(Q[(size_t)t * 512 + i]);
    __syncthreads();
    if (tid < nsel) {
        const int s = sel[tid];
#pragma unroll
        for (int kvh = 0; kvh < 2; ++kvh) {
            const u16* kp = K + (size_t)(b * SEQ + s) * 128 + kvh * 64;
            float kv[64];
#pragma unroll
            for (int i = 0; i < 8; ++i) { const bf16x8 v8 = *(const bf16x8*)(kp + 8 * i);
#pragma unroll
                for (int j = 0; j < 8; ++j) kv[8 * i + j] = (float)v8[j]; }
#pragma unroll
            for (int gq = 0; gq < 4; ++gq) { const int h = kvh * 4 + gq; float d = 0.f;
#pragma unroll
                for (int i = 0; i < 64; ++i) d += qs[h * 64 + i] * kv[i];
                p[tid][h] = d; }
        }
    } else {
#pragma unroll
        for (int h = 0; h < 8; ++h) p[tid][h] = -INFINITY;
    }
    __syncthreads();
    {
        const int w = tid >> 6, lane = tid & 63;
#pragma unroll
        for (int hh = 0; hh < 2; ++hh) {
            const int h = 2 * w + hh;
            float m = -INFINITY;
            for (int j = lane; j < 256; j += 64) m = fmaxf(m, p[j][h]);
#pragma unroll
            for (int o2 = 1; o2 < 64; o2 <<= 1) m = fmaxf(m, __shfl_xor(m, o2));
            float l = 0.f;
            for (int j = lane; j < 256; j += 64) { const float e = exp2f(p[j][h] - m); p[j][h] = e; l += e; }
            l = wave_sum(l);
            if (lane == 0) { hm[h] = m; hl[h] = l; }
        }
    }
    __syncthreads();
    {
        const int h = tid >> 5, d = 2 * (tid & 31), kvh = h >> 2;
        float a0 = 0.f, a1 = 0.f;
        for (int j = 0; j < nsel; ++j) {
            const unsigned vv = *(const unsigned*)(V + (size_t)(b * SEQ + sel[j]) * 128 + kvh * 64 + d);
            const float pj = p[j][h];
            a0 += pj * bf2f((u16)(vv & 0xffffu)); a1 += pj * bf2f((u16)(vv >> 16));
        }
        const float inv = 1.f / hl[h];
        const unsigned gg = *(const unsigned*)(GA + (size_t)t * 512 + h * 64 + d);
        const unsigned out = (unsigned)f2bf(a0 * inv * bf2f((u16)(gg & 0xffffu))) | ((unsigned)f2bf(a1 * inv * bf2f((u16)(gg >> 16))) << 16);
        *(unsigned*)(MIX + (size_t)t * 1024 + 512 + h * 64 + d) = out;
    }
}

__global__ __launch_bounds__(256) void k_gemm2(const u16* __restrict__ MIX, const u16* __restrict__ WoutT, const float* __restrict__ x, const float* __restrict__ mod, float* __restrict__ out) {
    const int c0 = blockIdx.x * 64, r0 = blockIdx.y * 64, tid = threadIdx.x, w = tid >> 6, lane = tid & 63;
    const int wr = w & 1, wcn = w >> 1;
    const u16* ap = MIX + (size_t)(r0 + wr * 32 + (lane & 31)) * DM + 8 * (lane >> 5);
    const u16* bp = WoutT + (size_t)(c0 + wcn * 32 + (lane & 31)) * DM + 8 * (lane >> 5);
    f32x16 acc;
#pragma unroll
    for (int r = 0; r < 16; ++r) acc[r] = 0.f;
    for (int k0 = 0; k0 < DM; k0 += 16) {
        const bf16x8 a = *(const bf16x8*)(ap + k0), bb = *(const bf16x8*)(bp + k0);
        acc = __builtin_amdgcn_mfma_f32_32x32x16_f16(a, bb, acc, 0, 0, 0);
    }
    const int col = c0 + wcn * 32 + (lane & 31), b = r0 >> 11;
    const float gate = mod[b * 3072 + 2048 + col];
#pragma unroll
    for (int r = 0; r < 16; ++r) {
        const int row = r0 + wr * 32 + (r & 3) + 8 * (r >> 2) + 4 * (lane >> 5);
        out[(size_t)row * DM + col] = x[(size_t)row * DM + col] + gate * acc[r];
    }
}

extern "C" void kernel_launch(void* const* d_in, const int* in_sizes, int n_in, void* d_out, int out_size, void* d_ws, size_t ws_size, hipStream_t stream) {
    (void)in_sizes; (void)n_in; (void)out_size; (void)ws_size;
    const float* x = (const float*)d_in[0]; const float* c = (const float*)d_in[1]; const float* norm_w = (const float*)d_in[2];
    const float* w_ada = (const float*)d_in[3]; const float* b_ada = (const float*)d_in[4]; const float* w_in = (const float*)d_in[5];
    const float* qnw = (const float*)d_in[6]; const float* knw = (const float*)d_in[7]; const float* w_pool = (const float*)d_in[8];
    const float* pool_scale = (const float*)d_in[9]; const float* w_out = (const float*)d_in[10];
    unsigned char* ws = (unsigned char*)d_ws;
    float* mod = (float*)(ws + WS_MOD); float2* rope = (float2*)(ws + WS_ROPE);
    u16* WinT = (u16*)(ws + WS_WINT); u16* WoutT = (u16*)(ws + WS_WOUTT); u16* XN = (u16*)(ws + WS_XN);
    P1Out o; o.U = (u16*)(ws + WS_U); o.SG = (u16*)(ws + WS_SG); o.Q = (u16*)(ws + WS_Q); o.GA = (u16*)(ws + WS_GA); o.QI = (u16*)(ws + WS_QI);
    o.K = (u16*)(ws + WS_K); o.V = (u16*)(ws + WS_V); o.KI = (u16*)(ws + WS_KI); o.WI = (float*)(ws + WS_WI);
    unsigned* MASK = (unsigned*)(ws + WS_MASK); u16* MIX = (u16*)(ws + WS_MIX);
    hipLaunchKernelGGL(k_mod, dim3(12, NB), dim3(256), 0, stream, c, w_ada, b_ada, mod);
    hipLaunchKernelGGL(k_rope, dim3(SEQ * 32 / 256), dim3(256), 0, stream, rope);
    hipLaunchKernelGGL(k_convw, dim3(NPAD * DM / 256), dim3(256), 0, stream, w_in, NPROJ, NPAD, WinT);
    hipLaunchKernelGGL(k_convw, dim3(DM * DM / 256), dim3(256), 0, stream, w_out, DM, DM, WoutT);
    hipLaunchKernelGGL(k_xn, dim3(MT / 4), dim3(256), 0, stream, x, norm_w, (const float*)mod, XN);
    hipLaunchKernelGGL(k_gemm1, dim3(46, MT / 64), dim3(256), 0, stream, (const u16*)XN, (const u16*)WinT, qnw, knw, (const float2*)rope, o);
    hipLaunchKernelGGL(k_pool, dim3(MT / 64, 4), dim3(256), 0, stream, (const u16*)o.U, (const u16*)o.SG, w_pool, pool_scale, MIX);
    hipLaunchKernelGGL(k_selattn, dim3(MT), dim3(256), 0, stream, (const u16*)o.Q, (const u16*)o.K, (const u16*)o.V, (const u16*)o.GA, (const u16*)o.QI, (const u16*)o.KI, (const float*)o.WI, MASK, MIX);
    hipLaunchKernelGGL(k_gemm2, dim3(DM / 64, MT / 64), dim3(256), 0, stream, (const u16*)MIX, (const u16*)WoutT, x, (const float*)mod, (float*)d_out);
}
```

```cpp
#include <hip/hip_runtime.h>
#include <stdint.h>
#include <cstdio>

typedef unsigned short u16;
typedef _Float16 h16x8 __attribute__((ext_vector_type(8)));
typedef float f32x16 __attribute__((ext_vector_type(16)));
typedef float f32x4 __attribute__((ext_vector_type(4)));
typedef unsigned v4u __attribute__((ext_vector_type(4)));
#define LAS __attribute__((address_space(3)))
#define GAS __attribute__((address_space(1)))

constexpr int NB = 8, SEQ = 2048, DM = 1024, MT = NB * SEQ;
constexpr int NPROJ = 2888, NPAD = 3072;
constexpr int NTH = 512, NWAVES = 8;
constexpr float QSCALE = 0.18033688011112042f;
constexpr float EPS = 1e-6f;

constexpr size_t WS_CTL = 0, CTL_ZERO_BYTES = 65536;
constexpr size_t WS_MOD = 65536;
constexpr size_t WS_ROPE = WS_MOD + (size_t)NB * 3072 * 4;
constexpr size_t WS_WINT = WS_ROPE + (size_t)SEQ * 32 * 8;
constexpr size_t WS_WOUTT = WS_WINT + (size_t)NPAD * DM * 2;
constexpr size_t WS_XN = WS_WOUTT + (size_t)DM * DM * 2;
constexpr size_t WS_U = WS_XN + (size_t)MT * DM * 2;
constexpr size_t WS_SG = WS_U + (size_t)MT * 512 * 2;
constexpr size_t WS_Q = WS_SG + (size_t)MT * 512 * 2;
constexpr size_t WS_GA = WS_Q + (size_t)MT * 512 * 2;
constexpr size_t WS_QI = WS_GA + (size_t)MT * 512 * 2;
constexpr size_t WS_K = WS_QI + (size_t)MT * 512 * 2;
constexpr size_t WS_V = WS_K + (size_t)MT * 128 * 2;
constexpr size_t WS_KI = WS_V + (size_t)MT * 128 * 2;
constexpr size_t WS_WI = WS_KI + (size_t)MT * 64 * 2;
constexpr size_t WS_MASK = WS_WI + (size_t)MT * 8 * 4;
constexpr size_t WS_MIX = WS_MASK + (size_t)MT * 64 * 4;
constexpr size_t WS_END = WS_MIX + (size_t)MT * DM * 2;
constexpr int CW_BAR = 1024;

constexpr int RING_BYTES = 131072;
constexpr int LDSCTL_OFF = RING_BYTES, MISC_OFF = LDSCTL_OFF + 320;
constexpr int LDS_BYTES = 147456;

__device__ __forceinline__ u16 f2h(float f) { return __builtin_bit_cast(u16, (_Float16)f); }
__device__ __forceinline__ float h2f(u16 h) { return (float)__builtin_bit_cast(_Float16, h); }
__device__ __forceinline__ float silu_f(float v) { return v / (1.f + __expf(-v)); }
__device__ __forceinline__ float wave_sum(float v) {
#pragma unroll
    for (int o = 1; o < 64; o <<= 1) v += __shfl_xor(v, o);
    return v;
}

__constant__ double ROPE_FREQ[32] = {1.0,0.7498942093324559,0.5623413251903491,0.4216965034285822,0.31622776601683794,0.23713737056616552,0.1778279410038923,0.1333521432163324,0.1,0.07498942093324558,0.05623413251903491,0.042169650342858224,0.03162277660168379,0.023713737056616554,0.01778279410038923,0.01333521432163324,0.01,0.007498942093324558,0.005623413251903491,0.004216965034285823,0.0031622776601683794,0.0023713737056616554,0.0017782794100389228,0.001333521432163324,0.001,0.0007498942093324559,0.0005623413251903491,0.00042169650342858224,0.00031622776601683794,0.00023713737056616554,0.00017782794100389227,0.0001333521432163324};

#define XB_TMO      128
#define XB_XCNT(j)  (256  + 64 * (j))
#define XB_XSUB(j)  (1280 + 64 * (j))
#define XB_XGEN(j)  (2304 + 64 * (j))
#define XB_TOP      3328
#define XB_TOPGEN   3392
#define XCD_BAR_WORDS 3456
#define XB_SPIN_CAP (1u << 18)

__device__ __forceinline__ unsigned xb_ld(unsigned* p)              { return __hip_atomic_load(p, __ATOMIC_RELAXED, __HIP_MEMORY_SCOPE_AGENT); }
__device__ __forceinline__ unsigned xb_add(unsigned* p, unsigned v) { return __hip_atomic_fetch_add(p, v, __ATOMIC_RELAXED, __HIP_MEMORY_SCOPE_AGENT); }
__device__ __forceinline__ unsigned xb_xcc_id() { return (unsigned)__builtin_amdgcn_s_getreg((3 << 11) | 20) & 0xFu; }
#define XB_SPIN(cond, bar) do { unsigned _sp = 0; while (cond) { __builtin_amdgcn_s_sleep(1); \
    if ((++_sp & 255u) == 0u) { if (xb_ld(&(bar)[XB_TMO])) break; if (_sp > XB_SPIN_CAP) { atomicAdd(&(bar)[XB_TMO], 1u); break; } } } } while (0)

struct XcdBarrier {
    unsigned* bar; unsigned x;
    volatile LAS unsigned* st;
};

__device__ __forceinline__ XcdBarrier xcd_barrier_post(unsigned* bar, volatile LAS unsigned* st) {
    XcdBarrier b; b.bar = bar; b.x = xb_xcc_id(); b.st = st;
    if (threadIdx.x == 0) (void)xb_add(&bar[XB_XCNT(b.x)], 1u);
    return b;
}
__device__ __forceinline__ void xcd_barrier_complete(unsigned* bar, unsigned x, unsigned& nloc, unsigned& nx) {
    const unsigned G = gridDim.x * gridDim.y * gridDim.z;
    unsigned sum, cnt, mine, sp = 0u;
    for (;;) {
        sum = 0u; cnt = 0u; mine = 0u;
#pragma unroll
        for (unsigned j = 0; j < 16; ++j) { const unsigned c = xb_ld(&bar[XB_XCNT(j)]); sum += c; cnt += (c > 0u) ? 1u : 0u; mine = (j == x) ? c : mine; }
        if (sum == G) break;
        __builtin_amdgcn_s_sleep(1);
        if ((++sp & 255u) == 0u) { if (xb_ld(&bar[XB_TMO])) break; if (sp > XB_SPIN_CAP) { atomicAdd(&bar[XB_TMO], 1u); break; } }
    }
    nloc = mine > 0u ? mine : 1u; nx = cnt > 0u ? cnt : 1u;
}

__device__ __forceinline__ void xcd_barrier(const XcdBarrier& b) {
    asm volatile("s_waitcnt vmcnt(0)" ::: "memory");
    __syncthreads();
    if (threadIdx.x == 0) {
        unsigned* bar = b.bar;
        __builtin_amdgcn_s_waitcnt(0);
        unsigned nloc = b.st[0], nx = b.st[1];
        if (nloc == 0u) { xcd_barrier_complete(bar, b.x, nloc, nx); b.st[0] = nloc; b.st[1] = nx; }
        const unsigned old = xb_add(&bar[XB_XSUB(b.x)], 1u);
        const unsigned gen = old / nloc;
        if (old + 1u == (gen + 1u) * nloc) {
            __builtin_amdgcn_fence(__ATOMIC_RELEASE, "agent");
            asm volatile("s_waitcnt vmcnt(0)" ::: "memory");
            const unsigned og = xb_add(&bar[XB_TOP], 1u);
            const unsigned tg = og / nx;
            if (og + 1u == (tg + 1u) * nx) xb_add(&bar[XB_TOPGEN], 1u);
            else XB_SPIN(xb_ld(&bar[XB_TOPGEN]) == tg, bar);
            __builtin_amdgcn_fence(__ATOMIC_ACQUIRE, "agent");
            xb_add(&bar[XB_XGEN(b.x)], 1u);
            asm volatile("s_waitcnt vmcnt(0)" ::: "memory");
        } else {
            XB_SPIN(xb_ld(&bar[XB_XGEN(b.x)]) == gen, bar);
            __builtin_amdgcn_fence(__ATOMIC_ACQUIRE, "agent");
            asm volatile("s_waitcnt vmcnt(0)" ::: "memory");
        }
    }
    __syncthreads();
}


struct Ctx {
    const float *x, *c, *norm_w, *w_ada, *b_ada, *w_in, *qnw, *knw, *w_pool, *pool_scale, *w_out;
    float* out;
    float* mod; float2* rope; u16 *WinT, *WoutT, *XN, *U, *SG, *Q, *GA, *QI, *K, *V, *KI; float* WI; unsigned* MASK; u16* MIX;
    LAS unsigned char* lds;
    int tid, lane, wave, bid, G;
};

__device__ __forceinline__ void p0_mod_unit(const Ctx& C, int u) {
    LAS float* sc = (LAS float*)C.lds;
    const int b = u / 6, e = (u % 6) * 512 + C.tid;
    __syncthreads();
    for (int i = C.tid; i < DM; i += NTH) sc[i] = silu_f(C.c[b * DM + i]);
    __syncthreads();
    float acc = C.b_ada[e];
    for (int d = 0; d < DM; ++d) acc += sc[d] * C.w_ada[(size_t)d * 3072 + e];
    C.mod[b * 3072 + e] = acc;
}
__device__ __forceinline__ void p0_rope_unit(const Ctx& C, int u) {
    const int idx = u * NTH + C.tid, pos = idx >> 5, i = idx & 31;
    const double ang = (double)pos * ROPE_FREQ[i];
    double t = ang * 0.15915494309189533576888;
    t -= floor(t + 0.5);
    const double x = t * 6.283185307179586476925287, x2 = x * x;
    double s = 0.0, cc = 0.0, ts = x, tc = 1.0;
#pragma unroll 1
    for (int n = 0; n < 14; ++n) { cc += tc; s += ts; tc *= -x2 / (double)((2 * n + 1) * (2 * n + 2)); ts *= -x2 / (double)((2 * n + 2) * (2 * n + 3)); }
    C.rope[idx] = make_float2((float)cc, (float)s);
}
__device__ __forceinline__ void p0_conv_unit(const Ctx& C, const float* W, int N, u16* WT, int u) {
    LAS float* tl = (LAS float*)C.lds;
    const int nb = u >> 4, kb = u & 15, k0 = kb * 64, n0 = nb * 64;
    __syncthreads();
#pragma unroll
    for (int i = 0; i < 8; ++i) { const int kk = (C.tid >> 6) + 8 * i, nn = C.tid & 63, n = n0 + nn;
        tl[kk * 65 + nn] = n < N ? W[(size_t)(k0 + kk) * N + n] : 0.f; }
    __syncthreads();
    const int nn = C.tid >> 3, kc = (C.tid & 7) * 8;
    v4u o;
    o.x = (unsigned)f2h(tl[(kc + 0) * 65 + nn]) | ((unsigned)f2h(tl[(kc + 1) * 65 + nn]) << 16);
    o.y = (unsigned)f2h(tl[(kc + 2) * 65 + nn]) | ((unsigned)f2h(tl[(kc + 3) * 65 + nn]) << 16);
    o.z = (unsigned)f2h(tl[(kc + 4) * 65 + nn]) | ((unsigned)f2h(tl[(kc + 5) * 65 + nn]) << 16);
    o.w = (unsigned)f2h(tl[(kc + 6) * 65 + nn]) | ((unsigned)f2h(tl[(kc + 7) * 65 + nn]) << 16);
    *(v4u*)(WT + (size_t)(n0 + nn) * DM + k0 + kc) = o;
}
__device__ __forceinline__ void phase0(const Ctx& C) {
    constexpr int U_MOD = 48, U_ROPE = 128, U_WIN = 48 * 16, U_WOUT = 16 * 16, U_ALL = U_MOD + U_ROPE + U_WIN + U_WOUT;
    for (int u = C.bid; u < U_ALL; u += C.G) {
        int r = u;
        if (r < U_MOD) { p0_mod_unit(C, r); continue; } r -= U_MOD;
        if (r < U_ROPE) { p0_rope_unit(C, r); continue; } r -= U_ROPE;
        if (r < U_WIN) { p0_conv_unit(C, C.w_in, NPROJ, C.WinT, r); continue; } r -= U_WIN;
        p0_conv_unit(C, C.w_out, DM, C.WoutT, r);
    }
}

__device__ __forceinline__ void phase0b(const Ctx& C) {
    for (int row = C.bid * NWAVES + C.wave; row < MT; row += C.G * NWAVES) {
        const int lane = C.lane, b = row >> 11;
        const float4* xr = (const float4*)(C.x + (size_t)row * DM) + lane;
        float4 v[4]; float s = 0.f;
#pragma unroll
        for (int j = 0; j < 4; ++j) { v[j] = xr[64 * j]; s += v[j].x * v[j].x + v[j].y * v[j].y + v[j].z * v[j].z + v[j].w * v[j].w; }
        const float rstd = rsqrtf(wave_sum(s) * (1.f / DM) + EPS);
        const float* shift = C.mod + b * 3072; const float* scale = shift + 1024;
#pragma unroll
        for (int j = 0; j < 4; ++j) {
            const int k = 4 * lane + 256 * j;
            const float4 w4 = *(const float4*)(C.norm_w + k), s4 = *(const float4*)(scale + k), h4 = *(const float4*)(shift + k);
            const float o0 = v[j].x * rstd * w4.x * (1.f + s4.x) + h4.x, o1 = v[j].y * rstd * w4.y * (1.f + s4.y) + h4.y;
            const float o2 = v[j].z * rstd * w4.z * (1.f + s4.z) + h4.z, o3 = v[j].w * rstd * w4.w * (1.f + s4.w) + h4.w;
            ushort4 o; o.x = f2h(o0); o.y = f2h(o1); o.z = f2h(o2); o.w = f2h(o3);
            *(ushort4*)(C.XN + (size_t)row * DM + k) = o;
        }
    }
}

__device__ __forceinline__ void p1_epilogue_row(const Ctx& C, int g, int t, int sub, const LAS float* tr) {
    const int pos = t & (SEQ - 1);
    if (g < 8) {
        for (int c = 16 * sub; c < 16 * sub + 16; ++c) C.U[(size_t)t * 512 + g * 64 + c] = f2h(tr[c]);
    } else if (g < 16) {
        for (int c = 16 * sub; c < 16 * sub + 16; ++c) C.SG[(size_t)t * 512 + (g - 8) * 64 + c] = f2h(silu_f(tr[c]));
    } else if (g < 26) {
        float ss = 0.f;
        for (int c = 16 * sub; c < 16 * sub + 16; ++c) ss += tr[c] * tr[c];
        ss += __shfl_xor(ss, 1); ss += __shfl_xor(ss, 2);
        const float rinv = rsqrtf(ss * (1.f / 64.f) + EPS);
        const bool isq = g < 24; const float* nwp = isq ? C.qnw : C.knw; const float osc = isq ? QSCALE : 1.f;
        u16* dst = isq ? C.Q + (size_t)t * 512 + (g - 16) * 64 : C.K + (size_t)t * 128 + (g - 24) * 64;
        for (int i = 8 * sub; i < 8 * sub + 8; ++i) {
            const float x1 = tr[i] * rinv * nwp[i], x2 = tr[i + 32] * rinv * nwp[i + 32];
            const float2 cs = C.rope[pos * 32 + i];
            dst[i] = f2h((x1 * cs.x - x2 * cs.y) * osc); dst[i + 32] = f2h((x2 * cs.x + x1 * cs.y) * osc);
        }
    } else if (g < 28) {
        for (int c = 16 * sub; c < 16 * sub + 16; ++c) C.V[(size_t)t * 128 + (g - 26) * 64 + c] = f2h(tr[c]);
    } else if (g < 36) {
        for (int c = 16 * sub; c < 16 * sub + 16; ++c) C.GA[(size_t)t * 512 + (g - 28) * 64 + c] = f2h(silu_f(tr[c]));
    } else if (g < 45) {
        u16* dst = g < 44 ? C.QI + (size_t)t * 512 + (g - 36) * 64 : C.KI + (size_t)t * 64;
        for (int i = 8 * sub; i < 8 * sub + 8; ++i) {
            const float x1 = tr[i], x2 = tr[i + 32];
            const float2 cs = C.rope[pos * 32 + i];
            dst[i] = f2h(x1 * cs.x - x2 * cs.y); dst[i + 32] = f2h(x2 * cs.x + x1 * cs.y);
        }
    } else {
        if (sub == 0) for (int c = 0; c < 8; ++c) C.WI[(size_t)t * 8 + c] = tr[c];
    }
}
__device__ __forceinline__ void phase1_naive(const Ctx& C) {
    LAS float* tile = (LAS float*)C.lds;
    for (int u = C.bid; u < 46 * 128; u += C.G) {
        const int g = u % 46, r0 = (u / 46) * 128, w = C.wave, lane = C.lane, wr = w & 3, wcn = w >> 2;
        const u16* ap = C.XN + (size_t)(r0 + wr * 32 + (lane & 31)) * DM + 8 * (lane >> 5);
        const u16* bp = C.WinT + (size_t)(g * 64 + wcn * 32 + (lane & 31)) * DM + 8 * (lane >> 5);
        f32x16 acc;
#pragma unroll
        for (int r = 0; r < 16; ++r) acc[r] = 0.f;
        for (int k0 = 0; k0 < DM; k0 += 16) {
            const h16x8 a = *(const h16x8*)(ap + k0), bb = *(const h16x8*)(bp + k0);
            acc = __builtin_amdgcn_mfma_f32_32x32x16_f16(a, bb, acc, 0, 0, 0);
        }
        __syncthreads();
#pragma unroll
        for (int r = 0; r < 16; ++r) tile[(wr * 32 + (r & 3) + 8 * (r >> 2) + 4 * (lane >> 5)) * 65 + wcn * 32 + (lane & 31)] = acc[r];
        __syncthreads();
        const int row = C.tid >> 2, sub = C.tid & 3;
        p1_epilogue_row(C, g, r0 + row, sub, tile + row * 65);
    }
}

__device__ __forceinline__ void pool_unit_naive(const Ctx& C, int u) {
    LAS float* pl = (LAS float*)C.lds;
    const int t0 = (u >> 2) * 64, g = u & 3, tid = C.tid, win = 2 << g;
    __syncthreads();
    for (int idx = tid; idx < 64 * 128; idx += NTH) {
        const int tl = idx >> 7, c = idx & 127, t = t0 + tl, pos = t & (SEQ - 1);
        const int cnt = (pos + 1 < win) ? pos + 1 : win;
        float s = 0.f;
        for (int j = 0; j < cnt; ++j) s += h2f(C.U[(size_t)(t - j) * 512 + g * 128 + c]);
        pl[tl * 128 + c] = s / (float)cnt - h2f(C.U[(size_t)t * 512 + g * 128 + c]);
    }
    __syncthreads();
    const int d = tid & 127, rh = tid >> 7;
    float acc[16];
#pragma unroll
    for (int i = 0; i < 16; ++i) acc[i] = 0.f;
    const float* wp = C.w_pool + (size_t)g * 128 * 128 + d;
    for (int c = 0; c < 128; ++c) {
        const float wv = wp[(size_t)c * 128];
#pragma unroll
        for (int i = 0; i < 16; ++i) acc[i] += pl[(rh * 16 + i) * 128 + c] * wv;
    }
    const float ps = C.pool_scale[g * 128 + d];
#pragma unroll
    for (int i = 0; i < 16; ++i) {
        const int t = t0 + rh * 16 + i;
        C.MIX[(size_t)t * 1024 + g * 128 + d] = f2h(acc[i] * ps * h2f(C.SG[(size_t)t * 512 + g * 128 + d]));
    }
}

__device__ __forceinline__ unsigned fkey(float f) { const unsigned u = __float_as_uint(f); return (u & 0x80000000u) ? ~u : (u | 0x80000000u); }
__device__ __forceinline__ int block_sum_int(int v, LAS int* red) {
#pragma unroll
    for (int o = 1; o < 64; o <<= 1) v += __shfl_xor(v, o);
    __syncthreads();
    if ((threadIdx.x & 63) == 0) red[threadIdx.x >> 6] = v;
    __syncthreads();
    return red[0] + red[1] + red[2] + red[3] + red[4] + red[5] + red[6] + red[7];
}
__device__ __forceinline__ void selattn_row_naive(const Ctx& C, int t) {
    LAS float* qs = (LAS float*)C.lds;
    LAS unsigned* keys = (LAS unsigned*)(C.lds + 2048);
    LAS unsigned* mk = (LAS unsigned*)(C.lds + 10240);
    LAS int* wpre = (LAS int*)(C.lds + 10496);
    LAS int* red = (LAS int*)(C.lds + 10816);
    LAS int* sel = (LAS int*)(C.lds + 10880);
    LAS float* p = (LAS float*)(C.lds + 11904);
    LAS float* hl = (LAS float*)(C.lds + 21120);
    const int b = t >> 11, pos = t & (SEQ - 1), n = pos + 1, tid = C.tid;
    __syncthreads();
    for (int i = tid; i < 512; i += NTH) qs[i] = h2f(C.QI[(size_t)t * 512 + i]);
    if (tid < 64) mk[tid] = 0u;
    float wi[8];
#pragma unroll
    for (int h = 0; h < 8; ++h) wi[h] = C.WI[(size_t)t * 8 + h];
    __syncthreads();
    for (int s = tid; s < n; s += NTH) {
        const u16* kp = C.KI + (size_t)(b * SEQ + s) * 64;
        float dh[8];
#pragma unroll
        for (int h = 0; h < 8; ++h) dh[h] = 0.f;
#pragma unroll 1
        for (int i = 0; i < 8; ++i) { const h16x8 v8 = *(const h16x8*)(kp + 8 * i);
#pragma unroll
            for (int h = 0; h < 8; ++h) {
#pragma unroll
                for (int j = 0; j < 8; ++j) dh[h] += qs[h * 64 + 8 * i + j] * (float)v8[j]; } }
        float sc = 0.f;
#pragma unroll
        for (int h = 0; h < 8; ++h) sc += wi[h] * fmaxf(dh[h], 0.f);
        keys[s] = fkey(sc);
    }
    __syncthreads();
    if (n <= 256) {
        for (int s = tid; s < n; s += NTH) atomicOr((unsigned*)&mk[s >> 5], 1u << (s & 31));
    } else {
        unsigned T = 0u;
        for (int bit = 31; bit >= 0; --bit) {
            const unsigned cand = T | (1u << bit);
            int c = 0;
            for (int s = tid; s < n; s += NTH) c += keys[s] >= cand;
            if (block_sum_int(c, red) >= 256) T = cand;
        }
        int c = 0;
        for (int s = tid; s < n; s += NTH) c += keys[s] > T;
        const int cgt = block_sum_int(c, red);
        for (int s = tid; s < n; s += NTH) if (keys[s] > T) atomicOr((unsigned*)&mk[s >> 5], 1u << (s & 31));
        __syncthreads();
        if (tid == 0) { int need = 256 - cgt; for (int s = 0; s < n && need > 0; ++s) if (keys[s] == T) { mk[s >> 5] |= 1u << (s & 31); --need; } }
    }
    __syncthreads();
    if (tid < 64) C.MASK[(size_t)t * 64 + tid] = mk[tid];
    if (tid == 0) { int a = 0; for (int i = 0; i < 64; ++i) { wpre[i] = a; a += __popc(mk[i]); } wpre[64] = a; }
    __syncthreads();
    const int nsel = wpre[64];
    for (int s = tid; s < n; s += NTH) { const unsigned wv = mk[s >> 5]; if ((wv >> (s & 31)) & 1u) sel[wpre[s >> 5] + __popc(wv & ((1u << (s & 31)) - 1u))] = s; }
    for (int i = tid; i < 512; i += NTH) qs[i] = h2f(C.Q[(size_t)t * 512 + i]);
    __syncthreads();
    if (tid < 256) {
        if (tid < nsel) {
            const int s = sel[tid];
#pragma unroll
            for (int kvh = 0; kvh < 2; ++kvh) {
                const u16* kp = C.K + (size_t)(b * SEQ + s) * 128 + kvh * 64;
                float dq[4] = {0.f, 0.f, 0.f, 0.f};
#pragma unroll 1
                for (int i = 0; i < 8; ++i) { const h16x8 v8 = *(const h16x8*)(kp + 8 * i);
#pragma unroll
                    for (int gq = 0; gq < 4; ++gq) {
#pragma unroll
                        for (int j = 0; j < 8; ++j) dq[gq] += qs[(kvh * 4 + gq) * 64 + 8 * i + j] * (float)v8[j]; } }
#pragma unroll
                for (int gq = 0; gq < 4; ++gq) p[tid * 9 + kvh * 4 + gq] = dq[gq];
            }
        } else {
#pragma unroll
            for (int h = 0; h < 8; ++h) p[tid * 9 + h] = -INFINITY;
        }
    }
    __syncthreads();
    {
        const int h = C.wave, lane = C.lane;
        float m = -INFINITY;
        for (int j = lane; j < 256; j += 64) m = fmaxf(m, p[j * 9 + h]);
#pragma unroll
        for (int o2 = 1; o2 < 64; o2 <<= 1) m = fmaxf(m, __shfl_xor(m, o2));
        float l = 0.f;
        for (int j = lane; j < 256; j += 64) { const float e = exp2f(p[j * 9 + h] - m); p[j * 9 + h] = e; l += e; }
        l = wave_sum(l);
        if (lane == 0) hl[h] = l;
    }
    __syncthreads();
    {
        const int h = tid >> 6, d = tid & 63, kvh = h >> 2;
        float a0 = 0.f;
        for (int j = 0; j < nsel; ++j) a0 += p[j * 9 + h] * h2f(C.V[(size_t)(b * SEQ + sel[j]) * 128 + kvh * 64 + d]);
        C.MIX[(size_t)t * 1024 + 512 + h * 64 + d] = f2h(a0 / hl[h] * h2f(C.GA[(size_t)t * 512 + h * 64 + d]));
    }
}

__device__ __forceinline__ void phase3_naive(const Ctx& C) {
    for (int u = C.bid; u < 16 * 128; u += C.G) {
        const int c0 = (u & 15) * 64, r0 = (u >> 4) * 128, w = C.wave, lane = C.lane, wr = w & 3, wcn = w >> 2;
        const u16* ap = C.MIX + (size_t)(r0 + wr * 32 + (lane & 31)) * DM + 8 * (lane >> 5);
        const u16* bp = C.WoutT + (size_t)(c0 + wcn * 32 + (lane & 31)) * DM + 8 * (lane >> 5);
        f32x16 acc;
#pragma unroll
        for (int r = 0; r < 16; ++r) acc[r] = 0.f;
        for (int k0 = 0; k0 < DM; k0 += 16) {
            const h16x8 a = *(const h16x8*)(ap + k0), bb = *(const h16x8*)(bp + k0);
            acc = __builtin_amdgcn_mfma_f32_32x32x16_f16(a, bb, acc, 0, 0, 0);
        }
        const int col = c0 + wcn * 32 + (lane & 31), b = r0 >> 11;
        const float gate = C.mod[b * 3072 + 2048 + col];
#pragma unroll
        for (int r = 0; r < 16; ++r) {
            const int row = r0 + wr * 32 + (r & 3) + 8 * (r >> 2) + 4 * (lane >> 5);
            C.out[(size_t)row * DM + col] = C.x[(size_t)row * DM + col] + gate * acc[r];
        }
    }
}

struct Args { const float* in[11]; float* out; unsigned char* ws; };
__global__ void __launch_bounds__(NTH, 2) mk_fwd(Args a) {
    extern __shared__ __attribute__((aligned(16))) unsigned char lds_raw[];
    Ctx C;
    C.lds = (LAS unsigned char*)lds_raw;
    C.tid = threadIdx.x; C.lane = C.tid & 63; C.wave = __builtin_amdgcn_readfirstlane(C.tid >> 6); C.bid = blockIdx.x; C.G = gridDim.x;
    C.x = a.in[0]; C.c = a.in[1]; C.norm_w = a.in[2]; C.w_ada = a.in[3]; C.b_ada = a.in[4]; C.w_in = a.in[5]; C.qnw = a.in[6]; C.knw = a.in[7];
    C.w_pool = a.in[8]; C.pool_scale = a.in[9]; C.w_out = a.in[10]; C.out = a.out;
    unsigned char* ws = a.ws;
    C.mod = (float*)(ws + WS_MOD); C.rope = (float2*)(ws + WS_ROPE); C.WinT = (u16*)(ws + WS_WINT); C.WoutT = (u16*)(ws + WS_WOUTT); C.XN = (u16*)(ws + WS_XN);
    C.U = (u16*)(ws + WS_U); C.SG = (u16*)(ws + WS_SG); C.Q = (u16*)(ws + WS_Q); C.GA = (u16*)(ws + WS_GA); C.QI = (u16*)(ws + WS_QI);
    C.K = (u16*)(ws + WS_K); C.V = (u16*)(ws + WS_V); C.KI = (u16*)(ws + WS_KI); C.WI = (float*)(ws + WS_WI); C.MASK = (unsigned*)(ws + WS_MASK); C.MIX = (u16*)(ws + WS_MIX);
    volatile LAS unsigned* MISC = (volatile LAS unsigned*)(C.lds + MISC_OFF);
    for (int u = C.tid; u < (LDS_BYTES - LDSCTL_OFF) / 4; u += NTH) ((LAS unsigned*)(C.lds + LDSCTL_OFF))[u] = 0u;
    __syncthreads();
    XcdBarrier bar = xcd_barrier_post((unsigned*)(ws + WS_CTL) + CW_BAR, MISC + 8);

    phase0(C);
    xcd_barrier(bar);
    phase0b(C);
    xcd_barrier(bar);
    phase1_naive(C);
    xcd_barrier(bar);
    for (int u = C.bid; u < 1024; u += C.G) pool_unit_naive(C, u);
    for (int t = C.bid; t < MT; t += C.G) selattn_row_naive(C, t);
    xcd_barrier(bar);
    phase3_naive(C);
}

extern "C" void kernel_launch(void* const* d_in, const int* in_sizes, int n_in, void* d_out, int out_size, void* d_ws, size_t ws_size, hipStream_t stream) {
    (void)in_sizes; (void)out_size;
    static int grid = 0;
    if (grid == 0) {
        if (n_in != 11 || ws_size < WS_END) { fprintf(stderr, "kernel_launch: unexpected inputs / workspace (%d, %zu)\n", n_in, ws_size); grid = -1; return; }
        int dev = 0, cus = 0, per_cu = 0;
        hipGetDevice(&dev); hipDeviceGetAttribute(&cus, hipDeviceAttributeMultiprocessorCount, dev);
        hipFuncSetAttribute((const void*)mk_fwd, hipFuncAttributeMaxDynamicSharedMemorySize, LDS_BYTES);
        hipOccupancyMaxActiveBlocksPerMultiprocessor(&per_cu, (const void*)mk_fwd, NTH, LDS_BYTES);
        (void)hipGetLastError();
        if (per_cu < 1) { fprintf(stderr, "kernel_launch: occupancy query says %d blocks per CU\n", per_cu); per_cu = 1; }
        grid = cus;
    }
    if (grid < 0) return;
    hipMemsetAsync((char*)d_ws + WS_CTL, 0, CTL_ZERO_BYTES, stream);
    Args a{};
    for (int i = 0; i < 11; ++i) a.in[i] = (const float*)d_in[i];
    a.out = (float*)d_out; a.ws = (unsigned char*)d_ws;
    void* kargs[] = {&a};
    hipError_t e = hipLaunchCooperativeKernel((const void*)mk_fwd, dim3(grid), dim3(NTH), kargs, LDS_BYTES, stream);
    if (e != hipSuccess) fprintf(stderr, "kernel_launch: cooperative launch failed: %s (grid %d)\n", hipGetErrorString(e), grid);
}
```

```cpp
#include <hip/hip_runtime.h>
#include <stdint.h>
#include <cstdio>

typedef unsigned short u16;
typedef _Float16 h16x8 __attribute__((ext_vector_type(8)));
typedef float f32x16 __attribute__((ext_vector_type(16)));
typedef float f32x4 __attribute__((ext_vector_type(4)));
typedef unsigned v4u __attribute__((ext_vector_type(4)));
#define LAS __attribute__((address_space(3)))
#define GAS __attribute__((address_space(1)))

constexpr int NB = 8, SEQ = 2048, DM = 1024, MT = NB * SEQ;
constexpr int NPROJ = 2888, NPAD = 3072;
constexpr int NTH = 512, NWAVES = 8;
constexpr float QSCALE = 0.18033688011112042f;
constexpr float EPS = 1e-6f;

constexpr size_t WS_CTL = 0, CTL_ZERO_BYTES = 65536;
constexpr size_t WS_MOD = 65536;
constexpr size_t WS_ROPE = WS_MOD + (size_t)NB * 3072 * 4;
constexpr size_t WS_WINT = WS_ROPE + (size_t)SEQ * 32 * 8;
constexpr size_t WS_WOUTT = WS_WINT + (size_t)NPAD * DM * 2;
constexpr size_t WS_XN = WS_WOUTT + (size_t)DM * DM * 2;
constexpr size_t WS_U = WS_XN + (size_t)MT * DM * 2;
constexpr size_t WS_SG = WS_U + (size_t)MT * 512 * 2;
constexpr size_t WS_Q = WS_SG + (size_t)MT * 512 * 2;
constexpr size_t WS_GA = WS_Q + (size_t)MT * 512 * 2;
constexpr size_t WS_QI = WS_GA + (size_t)MT * 512 * 2;
constexpr size_t WS_K = WS_QI + (size_t)MT * 512 * 2;
constexpr size_t WS_V = WS_K + (size_t)MT * 128 * 2;
constexpr size_t WS_KI = WS_V + (size_t)MT * 128 * 2;
constexpr size_t WS_WI = WS_KI + (size_t)MT * 64 * 2;
constexpr size_t WS_MASK = WS_WI + (size_t)MT * 8 * 4;
constexpr size_t WS_MIX = WS_MASK + (size_t)MT * 64 * 4;
constexpr size_t WS_END = WS_MIX + (size_t)MT * DM * 2;
constexpr int CW_BAR = 1024;

constexpr int RING_BYTES = 131072;
constexpr int LDSCTL_OFF = RING_BYTES, MISC_OFF = LDSCTL_OFF + 320;
constexpr int LDS_BYTES = 147456;

__device__ __forceinline__ u16 f2h(float f) { return __builtin_bit_cast(u16, (_Float16)f); }
__device__ __forceinline__ float h2f(u16 h) { return (float)__builtin_bit_cast(_Float16, h); }
__device__ __forceinline__ float silu_f(float v) { return v / (1.f + __expf(-v)); }
__device__ __forceinline__ float wave_sum(float v) {
#pragma unroll
    for (int o = 1; o < 64; o <<= 1) v += __shfl_xor(v, o);
    return v;
}

__constant__ double ROPE_FREQ[32] = {1.0,0.7498942093324559,0.5623413251903491,0.4216965034285822,0.31622776601683794,0.23713737056616552,0.1778279410038923,0.1333521432163324,0.1,0.07498942093324558,0.05623413251903491,0.042169650342858224,0.03162277660168379,0.023713737056616554,0.01778279410038923,0.01333521432163324,0.01,0.007498942093324558,0.005623413251903491,0.004216965034285823,0.0031622776601683794,0.0023713737056616554,0.0017782794100389228,0.001333521432163324,0.001,0.0007498942093324559,0.0005623413251903491,0.00042169650342858224,0.00031622776601683794,0.00023713737056616554,0.00017782794100389227,0.0001333521432163324};

#define XB_TMO      128
#define XB_XCNT(j)  (256  + 64 * (j))
#define XB_XSUB(j)  (1280 + 64 * (j))
#define XB_XGEN(j)  (2304 + 64 * (j))
#define XB_TOP      3328
#define XB_TOPGEN   3392
#define XCD_BAR_WORDS 3456
#define XB_SPIN_CAP (1u << 18)

__device__ __forceinline__ unsigned xb_ld(unsigned* p)              { return __hip_atomic_load(p, __ATOMIC_RELAXED, __HIP_MEMORY_SCOPE_AGENT); }
__device__ __forceinline__ unsigned xb_add(unsigned* p, unsigned v) { return __hip_atomic_fetch_add(p, v, __ATOMIC_RELAXED, __HIP_MEMORY_SCOPE_AGENT); }
__device__ __forceinline__ unsigned xb_xcc_id() { return (unsigned)__builtin_amdgcn_s_getreg((3 << 11) | 20) & 0xFu; }
#define XB_SPIN(cond, bar) do { unsigned _sp = 0; while (cond) { __builtin_amdgcn_s_sleep(1); \
    if ((++_sp & 255u) == 0u) { if (xb_ld(&(bar)[XB_TMO])) break; if (_sp > XB_SPIN_CAP) { atomicAdd(&(bar)[XB_TMO], 1u); break; } } } } while (0)

struct XcdBarrier {
    unsigned* bar; unsigned x;
    volatile LAS unsigned* st;
};

__device__ __forceinline__ XcdBarrier xcd_barrier_post(unsigned* bar, volatile LAS unsigned* st) {
    XcdBarrier b; b.bar = bar; b.x = xb_xcc_id(); b.st = st;
    if (threadIdx.x == 0) (void)xb_add(&bar[XB_XCNT(b.x)], 1u);
    return b;
}
__device__ __forceinline__ void xcd_barrier_complete(unsigned* bar, unsigned x, unsigned& nloc, unsigned& nx) {
    const unsigned G = gridDim.x * gridDim.y * gridDim.z;
    unsigned sum, cnt, mine, sp = 0u;
    for (;;) {
        sum = 0u; cnt = 0u; mine = 0u;
#pragma unroll
        for (unsigned j = 0; j < 16; ++j) { const unsigned c = xb_ld(&bar[XB_XCNT(j)]); sum += c; cnt += (c > 0u) ? 1u : 0u; mine = (j == x) ? c : mine; }
        if (sum == G) break;
        __builtin_amdgcn_s_sleep(1);
        if ((++sp & 255u) == 0u) { if (xb_ld(&bar[XB_TMO])) break; if (sp > XB_SPIN_CAP) { atomicAdd(&bar[XB_TMO], 1u); break; } }
    }
    nloc = mine > 0u ? mine : 1u; nx = cnt > 0u ? cnt : 1u;
}

__device__ __forceinline__ void xcd_barrier(const XcdBarrier& b) {
    asm volatile("s_waitcnt vmcnt(0)" ::: "memory");
    __syncthreads();
    if (threadIdx.x == 0) {
        unsigned* bar = b.bar;
        __builtin_amdgcn_s_waitcnt(0);
        unsigned nloc = b.st[0], nx = b.st[1];
        if (nloc == 0u) { xcd_barrier_complete(bar, b.x, nloc, nx); b.st[0] = nloc; b.st[1] = nx; }
        const unsigned old = xb_add(&bar[XB_XSUB(b.x)], 1u);
        const unsigned gen = old / nloc;
        if (old + 1u == (gen + 1u) * nloc) {
            __builtin_amdgcn_fence(__ATOMIC_RELEASE, "agent");
            asm volatile("s_waitcnt vmcnt(0)" ::: "memory");
            const unsigned og = xb_add(&bar[XB_TOP], 1u);
            const unsigned tg = og / nx;
            if (og + 1u == (tg + 1u) * nx) xb_add(&bar[XB_TOPGEN], 1u);
            else XB_SPIN(xb_ld(&bar[XB_TOPGEN]) == tg, bar);
            __builtin_amdgcn_fence(__ATOMIC_ACQUIRE, "agent");
            xb_add(&bar[XB_XGEN(b.x)], 1u);
            asm volatile("s_waitcnt vmcnt(0)" ::: "memory");
        } else {
            XB_SPIN(xb_ld(&bar[XB_XGEN(b.x)]) == gen, bar);
            __builtin_amdgcn_fence(__ATOMIC_ACQUIRE, "agent");
            asm volatile("s_waitcnt vmcnt(0)" ::: "memory");
        }
    }
    __syncthreads();
}


struct Ctx {
    const float *x, *c, *norm_w, *w_ada, *b_ada, *w_in, *qnw, *knw, *w_pool, *pool_scale, *w_out;
    float* out;
    float* mod; float2* rope; u16 *WinT, *WoutT, *XN, *U, *SG, *Q, *GA, *QI, *K, *V, *KI; float* WI; unsigned* MASK; u16* MIX;
    LAS unsigned char* lds;
    int tid, lane, wave, bid, G;
};

__device__ __forceinline__ void p0_mod_unit(const Ctx& C, int u) {
    LAS float* sc = (LAS float*)C.lds;
    const int b = u / 6, e = (u % 6) * 512 + C.tid;
    __syncthreads();
    for (int i = C.tid; i < DM; i += NTH) sc[i] = silu_f(C.c[b * DM + i]);
    __syncthreads();
    float acc = C.b_ada[e];
    for (int d = 0; d < DM; ++d) acc += sc[d] * C.w_ada[(size_t)d * 3072 + e];
    C.mod[b * 3072 + e] = acc;
}
__device__ __forceinline__ void p0_rope_unit(const Ctx& C, int u) {
    const int idx = u * NTH + C.tid, pos = idx >> 5, i = idx & 31;
    const double ang = (double)pos * ROPE_FREQ[i];
    double t = ang * 0.15915494309189533576888;
    t -= floor(t + 0.5);
    const double x = t * 6.283185307179586476925287, x2 = x * x;
    double s = 0.0, cc = 0.0, ts = x, tc = 1.0;
#pragma unroll 1
    for (int n = 0; n < 14; ++n) { cc += tc; s += ts; tc *= -x2 / (double)((2 * n + 1) * (2 * n + 2)); ts *= -x2 / (double)((2 * n + 2) * (2 * n + 3)); }
    C.rope[idx] = make_float2((float)cc, (float)s);
}
__device__ __forceinline__ void p0_conv_unit(const Ctx& C, const float* W, int N, u16* WT, int u, bool perm) {
    LAS float* tl = (LAS float*)C.lds;
    const int nb = u >> 4, kb = u & 15, k0 = kb * 64, n0 = nb * 64;
    __syncthreads();
#pragma unroll
    for (int i = 0; i < 8; ++i) { const int kk = (C.tid >> 6) + 8 * i, nn = C.tid & 63, n = n0 + nn;
        tl[kk * 65 + nn] = n < N ? W[(size_t)(k0 + kk) * N + n] : 0.f; }
    __syncthreads();
    const int nn = C.tid >> 3, kc = (C.tid & 7) * 8;
    v4u o;
    o.x = (unsigned)f2h(tl[(kc + 0) * 65 + nn]) | ((unsigned)f2h(tl[(kc + 1) * 65 + nn]) << 16);
    o.y = (unsigned)f2h(tl[(kc + 2) * 65 + nn]) | ((unsigned)f2h(tl[(kc + 3) * 65 + nn]) << 16);
    o.z = (unsigned)f2h(tl[(kc + 4) * 65 + nn]) | ((unsigned)f2h(tl[(kc + 5) * 65 + nn]) << 16);
    o.w = (unsigned)f2h(tl[(kc + 6) * 65 + nn]) | ((unsigned)f2h(tl[(kc + 7) * 65 + nn]) << 16);
    const int nl = n0 + nn, np = perm ? ((nl & ~255) | (((nl >> 5) & 1) << 7) | (((nl >> 6) & 3) << 5) | (nl & 31)) : nl;
    *(v4u*)(WT + (size_t)np * DM + k0 + kc) = o;
}
__device__ __forceinline__ void phase0(const Ctx& C) {
    constexpr int U_MOD = 48, U_ROPE = 128, U_WIN = 48 * 16, U_WOUT = 16 * 16, U_ALL = U_MOD + U_ROPE + U_WIN + U_WOUT;
    for (int u = C.bid; u < U_ALL; u += C.G) {
        int r = u;
        if (r < U_MOD) { p0_mod_unit(C, r); continue; } r -= U_MOD;
        if (r < U_ROPE) { p0_rope_unit(C, r); continue; } r -= U_ROPE;
        if (r < U_WIN) { p0_conv_unit(C, C.w_in, NPROJ, C.WinT, r, true); continue; } r -= U_WIN;
        p0_conv_unit(C, C.w_out, DM, C.WoutT, r, false);
    }
}

__device__ __forceinline__ void phase0b(const Ctx& C) {
    for (int row = C.bid * NWAVES + C.wave; row < MT; row += C.G * NWAVES) {
        const int lane = C.lane, b = row >> 11;
        const float4* xr = (const float4*)(C.x + (size_t)row * DM) + lane;
        float4 v[4]; float s = 0.f;
#pragma unroll
        for (int j = 0; j < 4; ++j) { v[j] = xr[64 * j]; s += v[j].x * v[j].x + v[j].y * v[j].y + v[j].z * v[j].z + v[j].w * v[j].w; }
        const float rstd = rsqrtf(wave_sum(s) * (1.f / DM) + EPS);
        const float* shift = C.mod + b * 3072; const float* scale = shift + 1024;
#pragma unroll
        for (int j = 0; j < 4; ++j) {
            const int k = 4 * lane + 256 * j;
            const float4 w4 = *(const float4*)(C.norm_w + k), s4 = *(const float4*)(scale + k), h4 = *(const float4*)(shift + k);
            const float o0 = v[j].x * rstd * w4.x * (1.f + s4.x) + h4.x, o1 = v[j].y * rstd * w4.y * (1.f + s4.y) + h4.y;
            const float o2 = v[j].z * rstd * w4.z * (1.f + s4.z) + h4.z, o3 = v[j].w * rstd * w4.w * (1.f + s4.w) + h4.w;
            ushort4 o; o.x = f2h(o0); o.y = f2h(o1); o.z = f2h(o2); o.w = f2h(o3);
            *(ushort4*)(C.XN + (size_t)row * DM + k) = o;
        }
    }
}


namespace pg8 {
#define PG8_LAS __attribute__((address_space(3)))
typedef unsigned short bf16_t;
typedef _Float16 bf16x8 __attribute__((ext_vector_type(8)));
typedef float f32x4 __attribute__((ext_vector_type(4)));
typedef unsigned u32x4 __attribute__((ext_vector_type(4)));
constexpr int BM = 256, BK = 64, HALF = 128, HTB = HALF * BK * 2  , STAGE_BYTES = 8 * HTB, NXCD = 8, WGM = 8;

__host__ __device__ __forceinline__ int lds_byte(int r, int c) { const int st = (r >> 4) * 2 + (c >> 5), rr = r & 15, cc = c & 31, ob = rr * 64 + cc * 2; return st * 1024 + (ob ^ (((ob >> 9) & 1) << 5)); }
__host__ __device__ __forceinline__ void stage_rc(int b, int& R, int& C) { const int st = b / 1024, sb = b % 1024, swz = sb ^ (((sb >> 9) & 1) << 5); R = (st >> 1) * 16 + swz / 64; C = (st & 1) * 32 + (swz % 64) / 2; }
__host__ __device__ __forceinline__ int perm32(int rho) { const int n = rho >> 4, i = rho & 15; return 8 * (i >> 2) + 4 * n + (i & 3); }

struct Unit { int pm, pn; };
struct Gemm { const bf16_t* A; const bf16_t* Bt; int M, N, K; };

struct StaticOrder {
    int nM, nN, nwg, G, c;
    __host__ __device__ void init(int M, int N, int G_, int c_) { nM = M / BM; nN = N / BM; nwg = nM * nN; G = G_; c = c_; }
    __host__ __device__ bool next(int i, Unit& u) const {
        const long L = (long)i * G + c; if (L >= nwg) return false;
        int wgid = (int)L; { const int q = nwg / NXCD, r = nwg % NXCD, xcd = wgid % NXCD, off = wgid / NXCD; wgid = (xcd < r ? xcd * (q + 1) : r * (q + 1) + (xcd - r) * q) + off; }
        const int nig = WGM * nN, gid = wgid / nig, fm = gid * WGM, gsz = (nM - fm) < WGM ? (nM - fm) : WGM;
        u.pm = fm + ((wgid % nig) % gsz); u.pn = (wgid % nig) / gsz; return true;
    }
    __device__ __forceinline__ void a_ready(const Unit&) const {}
    __device__ __forceinline__ void done(const Unit&) const {}
};

template <class Epi, class Sched, bool ALIGN_EPI = false, bool SP2 = false>
__device__ __forceinline__ void gemm_phase(PG8_LAS unsigned char* lds, const Gemm g, const Sched& S, const Epi& E) {
    const int tid = threadIdx.x, wid = __builtin_amdgcn_readfirstlane(tid >> 6), lane = tid & 63, wr = wid >> 2, wc = wid & 3, fr = lane & 15, fq = lane >> 4;
    const int K = g.K, nt = K / BK;
    unsigned voffA[2], voffB[2];
#pragma unroll
    for (int i = 0; i < 2; ++i) { int R, C; stage_rc(tid * 16 + i * 8192, R, C); const int Rb = Epi::PERM ? ((R & ~31) + perm32(R & 31)) : R;
        voffA[i] = (unsigned)(R * K + C) * 2u; voffB[i] = (unsigned)(Rb * K + C) * 2u; }
    const size_t kstep = (size_t)(BK * 2);
    const size_t hstep = (size_t)HALF * K * 2;
    const size_t tstep = 2 * hstep;
    const unsigned ldsw = (unsigned)wid * 1024u;
    const int aoff = lds_byte(wr * 64 + fr, fq * 8), boff = lds_byte(wc * 32 + fr, fq * 8);
#define PG8_SA(b, h) (((b) * 2 + (h)) * HTB)
#define PG8_SB(b, h) ((4 + (b) * 2 + (h)) * HTB)
#define PG8_STAGE(bufoff, gbase, voff) do { _Pragma("unroll") for (int _i = 0; _i < 2; ++_i) \
        __builtin_amdgcn_global_load_lds((const unsigned*)((const char*)(gbase) + (voff)[_i]), (PG8_LAS unsigned*)(lds + (bufoff) + ldsw + _i * 8192), 16, 0, 0); } while (0)
#define PG8_LDA(dst, b, h) do { _Pragma("unroll") for (int m = 0; m < 4; ++m) _Pragma("unroll") for (int k = 0; k < 2; ++k) dst[m][k] = *(const PG8_LAS bf16x8*)(lds + PG8_SA(b, h) + aoff + m * 2048 + k * 1024); } while (0)
#define PG8_LDB(dst, b, h) do { _Pragma("unroll") for (int n = 0; n < 2; ++n) _Pragma("unroll") for (int k = 0; k < 2; ++k) dst[n][k] = *(const PG8_LAS bf16x8*)(lds + PG8_SB(b, h) + boff + n * 2048 + k * 1024); } while (0)
#define PG8_MMA(ai, bj, At, Bt) do { __builtin_amdgcn_s_setprio(1); _Pragma("unroll") for (int m = 0; m < 4; ++m) _Pragma("unroll") for (int n = 0; n < 2; ++n) _Pragma("unroll") for (int k = 0; k < 2; ++k) \
        acc[ai][bj][m][n] = __builtin_amdgcn_mfma_f32_16x16x32_f16(Bt[n][k], At[m][k], acc[ai][bj][m][n], 0, 0, 0); __builtin_amdgcn_s_setprio(0); } while (0)
#define PG8_WAIT_V(n) asm volatile("s_waitcnt vmcnt(" #n ")" ::: "memory")
#define PG8_WAIT_L(n) asm volatile("s_waitcnt lgkmcnt(" #n ")" ::: "memory")
#define PG8_BAR __builtin_amdgcn_s_barrier()
#define PG8_SCHED __builtin_amdgcn_sched_barrier(0)
    Unit cur, nxt; int ui = 0;
    if (!S.next(0, cur)) return;
    f32x4 acc[2][2][4][2];
#pragma unroll
    for (int a = 0; a < 2; ++a)
#pragma unroll
        for (int b = 0; b < 2; ++b)
#pragma unroll
            for (int m = 0; m < 4; ++m)
#pragma unroll
                for (int n = 0; n < 2; ++n) acc[a][b][m][n] = (f32x4){0.f, 0.f, 0.f, 0.f};
    bf16x8 At[4][2], B0[2][2], B1[2][2];
    const char* cA = (const char*)g.A + (size_t)cur.pm * tstep; const char* cB = (const char*)g.Bt + (size_t)cur.pn * tstep;
    S.a_ready(cur);
    if constexpr (SP2) {
        PG8_STAGE(PG8_SB(0, 0), cB, voffB); PG8_STAGE(PG8_SB(0, 1), cB + hstep, voffB); PG8_STAGE(PG8_SA(0, 0), cA, voffA); PG8_STAGE(PG8_SA(0, 1), cA + hstep, voffA);
        if (wr == 1) PG8_BAR;
        PG8_WAIT_V(2); PG8_BAR;
        PG8_STAGE(PG8_SB(1, 0), cB + kstep, voffB); PG8_STAGE(PG8_SA(1, 0), cA + kstep, voffA); PG8_STAGE(PG8_SB(1, 1), cB + hstep + kstep, voffB);
        PG8_WAIT_V(6); PG8_BAR;
    } else {
        PG8_STAGE(PG8_SB(0, 0), cB, voffB); PG8_STAGE(PG8_SA(0, 0), cA, voffA); PG8_STAGE(PG8_SB(0, 1), cB + hstep, voffB); PG8_STAGE(PG8_SA(0, 1), cA + hstep, voffA);
        if (wr == 1) PG8_BAR;
        PG8_WAIT_V(4); PG8_BAR;
        PG8_STAGE(PG8_SB(1, 0), cB + kstep, voffB); PG8_STAGE(PG8_SA(1, 0), cA + kstep, voffA); PG8_STAGE(PG8_SB(1, 1), cB + hstep + kstep, voffB);
        PG8_WAIT_V(6); PG8_BAR;
    }
    for (;;) {
        const bool has_next = S.next(ui + 1, nxt);
        const char* nA = has_next ? (const char*)g.A + (size_t)nxt.pm * tstep : cA; const char* nB = has_next ? (const char*)g.Bt + (size_t)nxt.pn * tstep : cB;
        for (int t = 0; t < nt; t += 2) {
            const bool last = (t == nt - 2);
            const char* a1 = cA + (size_t)(t + 1) * kstep;
            const char* a2 = last ? nA : cA + (size_t)(t + 2) * kstep; const char* b2 = last ? nB : cB + (size_t)(t + 2) * kstep;
            const char* a3 = a2 + kstep; const char* b3 = b2 + kstep;
            if (last && has_next) S.a_ready(nxt);
            if constexpr (SP2) {
            PG8_LDB(B0, 0, 0); PG8_LDB(B1, 0, 1); PG8_SCHED; PG8_LDA(At, 0, 0); PG8_STAGE(PG8_SA(1, 1), a1 + hstep, voffA);
            PG8_WAIT_V(8); PG8_WAIT_L(0); PG8_BAR; PG8_MMA(0, 0, At, B0); PG8_MMA(0, 1, At, B1); PG8_BAR; PG8_SCHED;
            PG8_LDA(At, 0, 1); PG8_STAGE(PG8_SB(0, 0), b2, voffB); PG8_STAGE(PG8_SB(0, 1), b2 + hstep, voffB); PG8_STAGE(PG8_SA(0, 0), a2, voffA);
            PG8_WAIT_V(8); PG8_WAIT_L(0); PG8_BAR; PG8_MMA(1, 0, At, B0); PG8_MMA(1, 1, At, B1); PG8_BAR; PG8_SCHED;
            PG8_LDB(B0, 1, 0); PG8_LDB(B1, 1, 1); PG8_SCHED; PG8_LDA(At, 1, 0); PG8_STAGE(PG8_SA(0, 1), a2 + hstep, voffA);
            PG8_WAIT_V(8); PG8_WAIT_L(0); PG8_BAR; PG8_MMA(0, 0, At, B0); PG8_MMA(0, 1, At, B1); PG8_BAR; PG8_SCHED;
            PG8_LDA(At, 1, 1); PG8_STAGE(PG8_SB(1, 0), b3, voffB); PG8_STAGE(PG8_SB(1, 1), b3 + hstep, voffB); PG8_STAGE(PG8_SA(1, 0), a3, voffA);
            PG8_WAIT_V(8); PG8_WAIT_L(0); PG8_BAR; PG8_MMA(1, 0, At, B0); PG8_MMA(1, 1, At, B1); PG8_BAR; PG8_SCHED;
            } else {
            PG8_LDB(B0, 0, 0); PG8_SCHED; PG8_LDA(At, 0, 0); PG8_STAGE(PG8_SA(1, 1), a1 + hstep, voffA);
            PG8_WAIT_L(8); PG8_BAR; PG8_WAIT_L(0); PG8_MMA(0, 0, At, B0); PG8_BAR; PG8_SCHED;
            PG8_LDB(B1, 0, 1); PG8_STAGE(PG8_SB(0, 0), b2, voffB);
            PG8_BAR; PG8_WAIT_L(0); PG8_MMA(0, 1, At, B1); PG8_BAR;
            PG8_LDA(At, 0, 1); PG8_STAGE(PG8_SA(0, 0), a2, voffA);
            PG8_BAR; PG8_WAIT_L(0); PG8_MMA(1, 0, At, B0); PG8_BAR; PG8_SCHED;
            PG8_STAGE(PG8_SB(0, 1), b2 + hstep, voffB);
            PG8_WAIT_V(6); PG8_BAR; PG8_MMA(1, 1, At, B1); PG8_BAR;
            PG8_LDB(B0, 1, 0); PG8_SCHED; PG8_LDA(At, 1, 0); PG8_STAGE(PG8_SA(0, 1), a2 + hstep, voffA);
            PG8_WAIT_L(8); PG8_BAR; PG8_WAIT_L(0); PG8_MMA(0, 0, At, B0); PG8_BAR; PG8_SCHED;
            PG8_LDB(B1, 1, 1); PG8_STAGE(PG8_SB(1, 0), b3, voffB);
            PG8_BAR; PG8_WAIT_L(0); PG8_MMA(0, 1, At, B1); PG8_BAR;
            PG8_LDA(At, 1, 1); PG8_STAGE(PG8_SA(1, 0), a3, voffA);
            PG8_BAR; PG8_WAIT_L(0); PG8_MMA(1, 0, At, B0); PG8_BAR; PG8_SCHED;
            PG8_STAGE(PG8_SB(1, 1), b3 + hstep, voffB);
            PG8_WAIT_V(6); PG8_BAR; PG8_MMA(1, 1, At, B1); PG8_BAR;
            }
        }
        if constexpr (ALIGN_EPI) { if (wr == 0) PG8_BAR; }
        if constexpr (!Epi::AFTER_DRAIN) { E(acc, cur, wr, wc, fr, fq); S.done(cur); }
        if (!has_next) break;
#pragma unroll
        for (int a = 0; a < 2; ++a)
#pragma unroll
            for (int b = 0; b < 2; ++b)
#pragma unroll
                for (int m = 0; m < 4; ++m)
#pragma unroll
                    for (int n = 0; n < 2; ++n) acc[a][b][m][n] = (f32x4){0.f, 0.f, 0.f, 0.f};
        cur = nxt; cA = nA; cB = nB; ++ui;
        if constexpr (ALIGN_EPI) { if (wr == 1) PG8_BAR; }
    }
    PG8_WAIT_V(0);
    if constexpr (!ALIGN_EPI) { if (wr == 0) PG8_BAR; }
    PG8_BAR;
    if constexpr (Epi::AFTER_DRAIN) { E.fused(acc, cur, wr, wc, fr, fq, lds, wid, lane); S.done(cur); }
#undef PG8_SA
#undef PG8_SB
#undef PG8_STAGE
#undef PG8_LDA
#undef PG8_LDB
#undef PG8_MMA
#undef PG8_WAIT_V
#undef PG8_WAIT_L
#undef PG8_BAR
#undef PG8_SCHED
}
}


__device__ __forceinline__ unsigned pk2h(float lo, float hi) { typedef _Float16 h2 __attribute__((ext_vector_type(2))); h2 v; v.x = (_Float16)lo; v.y = (_Float16)hi; return __builtin_bit_cast(unsigned, v); }

struct EpiP1 {
    static constexpr bool PERM = true, AFTER_DRAIN = false;
    u16 *U, *SG, *Q, *GA, *QI, *K, *V, *KI; float* WI; const float *qnw, *knw; const float2* rope;
    __device__ __forceinline__ void operator()(const f32x4 (&acc)[2][2][4][2], const pg8::Unit& u, int wr, int wc, int fr, int fq) const {
        const int g = u.pn * 4 + wc;
        if (g > 45) return;
        int mode, ld; u16* dst; const float* nwp = qnw; float osc = 1.f;
        if (g < 8) { mode = 0; dst = U + g * 64; ld = 512; }
        else if (g < 16) { mode = 1; dst = SG + (g - 8) * 64; ld = 512; }
        else if (g < 24) { mode = 2; dst = Q + (g - 16) * 64; ld = 512; osc = QSCALE; }
        else if (g < 26) { mode = 2; dst = K + (g - 24) * 64; ld = 128; nwp = knw; }
        else if (g < 28) { mode = 0; dst = V + (g - 26) * 64; ld = 128; }
        else if (g < 36) { mode = 1; dst = GA + (g - 28) * 64; ld = 512; }
        else if (g < 44) { mode = 3; dst = QI + (g - 36) * 64; ld = 512; }
        else if (g == 44) { mode = 3; dst = KI; ld = 64; }
        else { mode = 4; dst = KI; ld = 64; }
        const int row0 = u.pm * 256 + wr * 64 + fr;
        if (mode == 4) {
            if (fq == 0) {
#pragma unroll
                for (int ai = 0; ai < 2; ++ai)
#pragma unroll
                    for (int m = 0; m < 4; ++m) { float* wp = WI + (size_t)(row0 + ai * 128 + m * 16) * 8; *(f32x4*)wp = acc[ai][0][m][0]; *(f32x4*)(wp + 4) = acc[ai][0][m][1]; }
            }
            return;
        }
        f32x4 nlo0 = {1.f, 1.f, 1.f, 1.f}, nlo1 = nlo0, nhi0 = nlo0, nhi1 = nlo0;
        if (mode == 2) { nlo0 = *(const f32x4*)(nwp + 8 * fq); nlo1 = *(const f32x4*)(nwp + 8 * fq + 4); nhi0 = *(const f32x4*)(nwp + 32 + 8 * fq); nhi1 = *(const f32x4*)(nwp + 36 + 8 * fq); }
#pragma unroll
        for (int ai = 0; ai < 2; ++ai)
#pragma unroll
            for (int m = 0; m < 4; ++m) {
                const int t = row0 + ai * 128 + m * 16;
                f32x4 a0 = acc[ai][0][m][0], a1 = acc[ai][0][m][1], b0 = acc[ai][1][m][0], b1 = acc[ai][1][m][1];
                if (mode == 1) {
#pragma unroll
                    for (int j = 0; j < 4; ++j) { a0[j] = silu_f(a0[j]); a1[j] = silu_f(a1[j]); b0[j] = silu_f(b0[j]); b1[j] = silu_f(b1[j]); }
                } else if (mode >= 2) {
                    if (mode == 2) {
                        float ss = 0.f;
#pragma unroll
                        for (int j = 0; j < 4; ++j) ss += a0[j] * a0[j] + a1[j] * a1[j] + b0[j] * b0[j] + b1[j] * b1[j];
                        ss += __shfl_xor(ss, 16); ss += __shfl_xor(ss, 32);
                        const float rinv = rsqrtf(ss * (1.f / 64.f) + EPS);
                        a0 = a0 * rinv * nlo0; a1 = a1 * rinv * nlo1; b0 = b0 * rinv * nhi0; b1 = b1 * rinv * nhi1;
                    }
                    const f32x4* rp = (const f32x4*)(rope + (size_t)(t & (SEQ - 1)) * 32 + 8 * fq);
                    const f32x4 r0 = rp[0], r1 = rp[1], r2 = rp[2], r3 = rp[3];
                    f32x4 o0, o1, p0, p1;
                    o0[0] = a0[0] * r0[0] - b0[0] * r0[1]; p0[0] = b0[0] * r0[0] + a0[0] * r0[1];
                    o0[1] = a0[1] * r0[2] - b0[1] * r0[3]; p0[1] = b0[1] * r0[2] + a0[1] * r0[3];
                    o0[2] = a0[2] * r1[0] - b0[2] * r1[1]; p0[2] = b0[2] * r1[0] + a0[2] * r1[1];
                    o0[3] = a0[3] * r1[2] - b0[3] * r1[3]; p0[3] = b0[3] * r1[2] + a0[3] * r1[3];
                    o1[0] = a1[0] * r2[0] - b1[0] * r2[1]; p1[0] = b1[0] * r2[0] + a1[0] * r2[1];
                    o1[1] = a1[1] * r2[2] - b1[1] * r2[3]; p1[1] = b1[1] * r2[2] + a1[1] * r2[3];
                    o1[2] = a1[2] * r3[0] - b1[2] * r3[1]; p1[2] = b1[2] * r3[0] + a1[2] * r3[1];
                    o1[3] = a1[3] * r3[2] - b1[3] * r3[3]; p1[3] = b1[3] * r3[2] + a1[3] * r3[3];
                    a0 = o0 * osc; a1 = o1 * osc; b0 = p0 * osc; b1 = p1 * osc;
                }
                u16* dp = dst + (size_t)t * ld + 8 * fq;
                v4u lo, hi; lo.x = pk2h(a0[0], a0[1]); lo.y = pk2h(a0[2], a0[3]); lo.z = pk2h(a1[0], a1[1]); lo.w = pk2h(a1[2], a1[3]);
                hi.x = pk2h(b0[0], b0[1]); hi.y = pk2h(b0[2], b0[3]); hi.z = pk2h(b1[0], b1[1]); hi.w = pk2h(b1[2], b1[3]);
                *(v4u*)dp = lo; *(v4u*)(dp + 32) = hi;
                if (m & 1) asm volatile("" ::: "memory");
            }
    }
};
struct EpiOut {
    static constexpr bool PERM = true, AFTER_DRAIN = false;
    const float* x; const float* gate; float* out;
    __device__ __forceinline__ void operator()(const f32x4 (&acc)[2][2][4][2], const pg8::Unit& u, int wr, int wc, int fr, int fq) const {
        const int row0 = u.pm * 256 + wr * 64 + fr, col0 = u.pn * 256 + wc * 32 + 8 * fq, b = (u.pm * 256) >> 11;
        f32x4 gv[2][2];
#pragma unroll
        for (int bj = 0; bj < 2; ++bj)
#pragma unroll
            for (int n = 0; n < 2; ++n) gv[bj][n] = *(const f32x4*)(gate + b * 3072 + col0 + bj * 128 + 4 * n);
#pragma unroll
        for (int ai = 0; ai < 2; ++ai)
#pragma unroll
            for (int m = 0; m < 4; ++m) {
                const size_t off = (size_t)(row0 + ai * 128 + m * 16) * DM + col0;
#pragma unroll
                for (int bj = 0; bj < 2; ++bj)
#pragma unroll
                    for (int n = 0; n < 2; ++n) { const f32x4 xv = *(const f32x4*)(x + off + bj * 128 + 4 * n); *(f32x4*)(out + off + bj * 128 + 4 * n) = xv + gv[bj][n] * acc[ai][bj][m][n]; }
                if (m & 1) asm volatile("" ::: "memory");
            }
    }
};

__device__ __forceinline__ void p1_epilogue_row(const Ctx& C, int g, int t, int sub, const LAS float* tr) {
    const int pos = t & (SEQ - 1);
    if (g < 8) {
        for (int c = 16 * sub; c < 16 * sub + 16; ++c) C.U[(size_t)t * 512 + g * 64 + c] = f2h(tr[c]);
    } else if (g < 16) {
        for (int c = 16 * sub; c < 16 * sub + 16; ++c) C.SG[(size_t)t * 512 + (g - 8) * 64 + c] = f2h(silu_f(tr[c]));
    } else if (g < 26) {
        float ss = 0.f;
        for (int c = 16 * sub; c < 16 * sub + 16; ++c) ss += tr[c] * tr[c];
        ss += __shfl_xor(ss, 1); ss += __shfl_xor(ss, 2);
        const float rinv = rsqrtf(ss * (1.f / 64.f) + EPS);
        const bool isq = g < 24; const float* nwp = isq ? C.qnw : C.knw; const float osc = isq ? QSCALE : 1.f;
        u16* dst = isq ? C.Q + (size_t)t * 512 + (g - 16) * 64 : C.K + (size_t)t * 128 + (g - 24) * 64;
        for (int i = 8 * sub; i < 8 * sub + 8; ++i) {
            const float x1 = tr[i] * rinv * nwp[i], x2 = tr[i + 32] * rinv * nwp[i + 32];
            const float2 cs = C.rope[pos * 32 + i];
            dst[i] = f2h((x1 * cs.x - x2 * cs.y) * osc); dst[i + 32] = f2h((x2 * cs.x + x1 * cs.y) * osc);
        }
    } else if (g < 28) {
        for (int c = 16 * sub; c < 16 * sub + 16; ++c) C.V[(size_t)t * 128 + (g - 26) * 64 + c] = f2h(tr[c]);
    } else if (g < 36) {
        for (int c = 16 * sub; c < 16 * sub + 16; ++c) C.GA[(size_t)t * 512 + (g - 28) * 64 + c] = f2h(silu_f(tr[c]));
    } else if (g < 45) {
        u16* dst = g < 44 ? C.QI + (size_t)t * 512 + (g - 36) * 64 : C.KI + (size_t)t * 64;
        for (int i = 8 * sub; i < 8 * sub + 8; ++i) {
            const float x1 = tr[i], x2 = tr[i + 32];
            const float2 cs = C.rope[pos * 32 + i];
            dst[i] = f2h(x1 * cs.x - x2 * cs.y); dst[i + 32] = f2h(x2 * cs.x + x1 * cs.y);
        }
    } else {
        if (sub == 0) for (int c = 0; c < 8; ++c) C.WI[(size_t)t * 8 + c] = tr[c];
    }
}
__device__ __forceinline__ void phase1_naive(const Ctx& C) {
    LAS float* tile = (LAS float*)C.lds;
    for (int u = C.bid; u < 46 * 128; u += C.G) {
        const int g = u % 46, r0 = (u / 46) * 128, w = C.wave, lane = C.lane, wr = w & 3, wcn = w >> 2;
        const u16* ap = C.XN + (size_t)(r0 + wr * 32 + (lane & 31)) * DM + 8 * (lane >> 5);
        const u16* bp = C.WinT + (size_t)(g * 64 + wcn * 32 + (lane & 31)) * DM + 8 * (lane >> 5);
        f32x16 acc;
#pragma unroll
        for (int r = 0; r < 16; ++r) acc[r] = 0.f;
        for (int k0 = 0; k0 < DM; k0 += 16) {
            const h16x8 a = *(const h16x8*)(ap + k0), bb = *(const h16x8*)(bp + k0);
            acc = __builtin_amdgcn_mfma_f32_32x32x16_f16(a, bb, acc, 0, 0, 0);
        }
        __syncthreads();
#pragma unroll
        for (int r = 0; r < 16; ++r) tile[(wr * 32 + (r & 3) + 8 * (r >> 2) + 4 * (lane >> 5)) * 65 + wcn * 32 + (lane & 31)] = acc[r];
        __syncthreads();
        const int row = C.tid >> 2, sub = C.tid & 3;
        p1_epilogue_row(C, g, r0 + row, sub, tile + row * 65);
    }
}

__device__ __forceinline__ void pool_unit_naive(const Ctx& C, int u) {
    LAS float* pl = (LAS float*)C.lds;
    const int t0 = (u >> 2) * 64, g = u & 3, tid = C.tid, win = 2 << g;
    __syncthreads();
    for (int idx = tid; idx < 64 * 128; idx += NTH) {
        const int tl = idx >> 7, c = idx & 127, t = t0 + tl, pos = t & (SEQ - 1);
        const int cnt = (pos + 1 < win) ? pos + 1 : win;
        float s = 0.f;
        for (int j = 0; j < cnt; ++j) s += h2f(C.U[(size_t)(t - j) * 512 + g * 128 + c]);
        pl[tl * 128 + c] = s / (float)cnt - h2f(C.U[(size_t)t * 512 + g * 128 + c]);
    }
    __syncthreads();
    const int d = tid & 127, rh = tid >> 7;
    float acc[16];
#pragma unroll
    for (int i = 0; i < 16; ++i) acc[i] = 0.f;
    const float* wp = C.w_pool + (size_t)g * 128 * 128 + d;
    for (int c = 0; c < 128; ++c) {
        const float wv = wp[(size_t)c * 128];
#pragma unroll
        for (int i = 0; i < 16; ++i) acc[i] += pl[(rh * 16 + i) * 128 + c] * wv;
    }
    const float ps = C.pool_scale[g * 128 + d];
#pragma unroll
    for (int i = 0; i < 16; ++i) {
        const int t = t0 + rh * 16 + i;
        C.MIX[(size_t)t * 1024 + g * 128 + d] = f2h(acc[i] * ps * h2f(C.SG[(size_t)t * 512 + g * 128 + d]));
    }
}

__device__ __forceinline__ unsigned fkey(float f) { const unsigned u = __float_as_uint(f); return (u & 0x80000000u) ? ~u : (u | 0x80000000u); }
__device__ __forceinline__ int block_sum_int(int v, LAS int* red) {
#pragma unroll
    for (int o = 1; o < 64; o <<= 1) v += __shfl_xor(v, o);
    __syncthreads();
    if ((threadIdx.x & 63) == 0) red[threadIdx.x >> 6] = v;
    __syncthreads();
    return red[0] + red[1] + red[2] + red[3] + red[4] + red[5] + red[6] + red[7];
}
__device__ __forceinline__ void selattn_row_naive(const Ctx& C, int t) {
    LAS float* qs = (LAS float*)C.lds;
    LAS unsigned* keys = (LAS unsigned*)(C.lds + 2048);
    LAS unsigned* mk = (LAS unsigned*)(C.lds + 10240);
    LAS int* wpre = (LAS int*)(C.lds + 10496);
    LAS int* red = (LAS int*)(C.lds + 10816);
    LAS int* sel = (LAS int*)(C.lds + 10880);
    LAS float* p = (LAS float*)(C.lds + 11904);
    LAS float* hl = (LAS float*)(C.lds + 21120);
    const int b = t >> 11, pos = t & (SEQ - 1), n = pos + 1, tid = C.tid;
    __syncthreads();
    for (int i = tid; i < 512; i += NTH) qs[i] = h2f(C.QI[(size_t)t * 512 + i]);
    if (tid < 64) mk[tid] = 0u;
    float wi[8];
#pragma unroll
    for (int h = 0; h < 8; ++h) wi[h] = C.WI[(size_t)t * 8 + h];
    __syncthreads();
    for (int s = tid; s < n; s += NTH) {
        const u16* kp = C.KI + (size_t)(b * SEQ + s) * 64;
        float dh[8];
#pragma unroll
        for (int h = 0; h < 8; ++h) dh[h] = 0.f;
#pragma unroll 1
        for (int i = 0; i < 8; ++i) { const h16x8 v8 = *(const h16x8*)(kp + 8 * i);
#pragma unroll
            for (int h = 0; h < 8; ++h) {
#pragma unroll
                for (int j = 0; j < 8; ++j) dh[h] += qs[h * 64 + 8 * i + j] * (float)v8[j]; } }
        float sc = 0.f;
#pragma unroll
        for (int h = 0; h < 8; ++h) sc += wi[h] * fmaxf(dh[h], 0.f);
        keys[s] = fkey(sc);
    }
    __syncthreads();
    if (n <= 256) {
        for (int s = tid; s < n; s += NTH) atomicOr((unsigned*)&mk[s >> 5], 1u << (s & 31));
    } else {
        unsigned T = 0u;
        for (int bit = 31; bit >= 0; --bit) {
            const unsigned cand = T | (1u << bit);
            int c = 0;
            for (int s = tid; s < n; s += NTH) c += keys[s] >= cand;
            if (block_sum_int(c, red) >= 256) T = cand;
        }
        int c = 0;
        for (int s = tid; s < n; s += NTH) c += keys[s] > T;
        const int cgt = block_sum_int(c, red);
        for (int s = tid; s < n; s += NTH) if (keys[s] > T) atomicOr((unsigned*)&mk[s >> 5], 1u << (s & 31));
        __syncthreads();
        if (tid == 0) { int need = 256 - cgt; for (int s = 0; s < n && need > 0; ++s) if (keys[s] == T) { mk[s >> 5] |= 1u << (s & 31); --need; } }
    }
    __syncthreads();
    if (tid < 64) C.MASK[(size_t)t * 64 + tid] = mk[tid];
    if (tid == 0) { int a = 0; for (int i = 0; i < 64; ++i) { wpre[i] = a; a += __popc(mk[i]); } wpre[64] = a; }
    __syncthreads();
    const int nsel = wpre[64];
    for (int s = tid; s < n; s += NTH) { const unsigned wv = mk[s >> 5]; if ((wv >> (s & 31)) & 1u) sel[wpre[s >> 5] + __popc(wv & ((1u << (s & 31)) - 1u))] = s; }
    for (int i = tid; i < 512; i += NTH) qs[i] = h2f(C.Q[(size_t)t * 512 + i]);
    __syncthreads();
    if (tid < 256) {
        if (tid < nsel) {
            const int s = sel[tid];
#pragma unroll
            for (int kvh = 0; kvh < 2; ++kvh) {
                const u16* kp = C.K + (size_t)(b * SEQ + s) * 128 + kvh * 64;
                float dq[4] = {0.f, 0.f, 0.f, 0.f};
#pragma unroll 1
                for (int i = 0; i < 8; ++i) { const h16x8 v8 = *(const h16x8*)(kp + 8 * i);
#pragma unroll
                    for (int gq = 0; gq < 4; ++gq) {
#pragma unroll
                        for (int j = 0; j < 8; ++j) dq[gq] += qs[(kvh * 4 + gq) * 64 + 8 * i + j] * (float)v8[j]; } }
#pragma unroll
                for (int gq = 0; gq < 4; ++gq) p[tid * 9 + kvh * 4 + gq] = dq[gq];
            }
        } else {
#pragma unroll
            for (int h = 0; h < 8; ++h) p[tid * 9 + h] = -INFINITY;
        }
    }
    __syncthreads();
    {
        const int h = C.wave, lane = C.lane;
        float m = -INFINITY;
        for (int j = lane; j < 256; j += 64) m = fmaxf(m, p[j * 9 + h]);
#pragma unroll
        for (int o2 = 1; o2 < 64; o2 <<= 1) m = fmaxf(m, __shfl_xor(m, o2));
        float l = 0.f;
        for (int j = lane; j < 256; j += 64) { const float e = exp2f(p[j * 9 + h] - m); p[j * 9 + h] = e; l += e; }
        l = wave_sum(l);
        if (lane == 0) hl[h] = l;
    }
    __syncthreads();
    {
        const int h = tid >> 6, d = tid & 63, kvh = h >> 2;
        float a0 = 0.f;
        for (int j = 0; j < nsel; ++j) a0 += p[j * 9 + h] * h2f(C.V[(size_t)(b * SEQ + sel[j]) * 128 + kvh * 64 + d]);
        C.MIX[(size_t)t * 1024 + 512 + h * 64 + d] = f2h(a0 / hl[h] * h2f(C.GA[(size_t)t * 512 + h * 64 + d]));
    }
}

__device__ __forceinline__ void phase3_naive(const Ctx& C) {
    for (int u = C.bid; u < 16 * 128; u += C.G) {
        const int c0 = (u & 15) * 64, r0 = (u >> 4) * 128, w = C.wave, lane = C.lane, wr = w & 3, wcn = w >> 2;
        const u16* ap = C.MIX + (size_t)(r0 + wr * 32 + (lane & 31)) * DM + 8 * (lane >> 5);
        const u16* bp = C.WoutT + (size_t)(c0 + wcn * 32 + (lane & 31)) * DM + 8 * (lane >> 5);
        f32x16 acc;
#pragma unroll
        for (int r = 0; r < 16; ++r) acc[r] = 0.f;
        for (int k0 = 0; k0 < DM; k0 += 16) {
            const h16x8 a = *(const h16x8*)(ap + k0), bb = *(const h16x8*)(bp + k0);
            acc = __builtin_amdgcn_mfma_f32_32x32x16_f16(a, bb, acc, 0, 0, 0);
        }
        const int col = c0 + wcn * 32 + (lane & 31), b = r0 >> 11;
        const float gate = C.mod[b * 3072 + 2048 + col];
#pragma unroll
        for (int r = 0; r < 16; ++r) {
            const int row = r0 + wr * 32 + (r & 3) + 8 * (r >> 2) + 4 * (lane >> 5);
            C.out[(size_t)row * DM + col] = C.x[(size_t)row * DM + col] + gate * acc[r];
        }
    }
}

struct Args { const float* in[11]; float* out; unsigned char* ws; };
__global__ void __launch_bounds__(NTH, 2) mk_fwd(Args a) {
    extern __shared__ __attribute__((aligned(16))) unsigned char lds_raw[];
    Ctx C;
    C.lds = (LAS unsigned char*)lds_raw;
    C.tid = threadIdx.x; C.lane = C.tid & 63; C.wave = __builtin_amdgcn_readfirstlane(C.tid >> 6); C.bid = blockIdx.x; C.G = gridDim.x;
    C.x = a.in[0]; C.c = a.in[1]; C.norm_w = a.in[2]; C.w_ada = a.in[3]; C.b_ada = a.in[4]; C.w_in = a.in[5]; C.qnw = a.in[6]; C.knw = a.in[7];
    C.w_pool = a.in[8]; C.pool_scale = a.in[9]; C.w_out = a.in[10]; C.out = a.out;
    unsigned char* ws = a.ws;
    C.mod = (float*)(ws + WS_MOD); C.rope = (float2*)(ws + WS_ROPE); C.WinT = (u16*)(ws + WS_WINT); C.WoutT = (u16*)(ws + WS_WOUTT); C.XN = (u16*)(ws + WS_XN);
    C.U = (u16*)(ws + WS_U); C.SG = (u16*)(ws + WS_SG); C.Q = (u16*)(ws + WS_Q); C.GA = (u16*)(ws + WS_GA); C.QI = (u16*)(ws + WS_QI);
    C.K = (u16*)(ws + WS_K); C.V = (u16*)(ws + WS_V); C.KI = (u16*)(ws + WS_KI); C.WI = (float*)(ws + WS_WI); C.MASK = (unsigned*)(ws + WS_MASK); C.MIX = (u16*)(ws + WS_MIX);
    volatile LAS unsigned* MISC = (volatile LAS unsigned*)(C.lds + MISC_OFF);
    for (int u = C.tid; u < (LDS_BYTES - LDSCTL_OFF) / 4; u += NTH) ((LAS unsigned*)(C.lds + LDSCTL_OFF))[u] = 0u;
    __syncthreads();
    XcdBarrier bar = xcd_barrier_post((unsigned*)(ws + WS_CTL) + CW_BAR, MISC + 8);

    phase0(C);
    xcd_barrier(bar);
    phase0b(C);
    xcd_barrier(bar);
    {
        pg8::Gemm g{C.XN, C.WinT, MT, NPAD, DM}; pg8::StaticOrder S; S.init(MT, NPAD, C.G, C.bid);
        EpiP1 E{C.U, C.SG, C.Q, C.GA, C.QI, C.K, C.V, C.KI, C.WI, C.qnw, C.knw, C.rope};
        pg8::gemm_phase<EpiP1, pg8::StaticOrder, true, true>(C.lds, g, S, E);
    }
    xcd_barrier(bar);
    for (int u = C.bid; u < 1024; u += C.G) pool_unit_naive(C, u);
    for (int t = C.bid; t < MT; t += C.G) selattn_row_naive(C, t);
    xcd_barrier(bar);
    {
        pg8::Gemm g{C.MIX, C.WoutT, MT, DM, DM}; pg8::StaticOrder S; S.init(MT, DM, C.G, C.bid);
        EpiOut E{C.x, C.mod + 2048, C.out};
        pg8::gemm_phase<EpiOut, pg8::StaticOrder, true, true>(C.lds, g, S, E);
    }
}

extern "C" void kernel_launch(void* const* d_in, const int* in_sizes, int n_in, void* d_out, int out_size, void* d_ws, size_t ws_size, hipStream_t stream) {
    (void)in_sizes; (void)out_size;
    static int grid = 0;
    if (grid == 0) {
        if (n_in != 11 || ws_size < WS_END) { fprintf(stderr, "kernel_launch: unexpected inputs / workspace (%d, %zu)\n", n_in, ws_size); grid = -1; return; }
        int dev = 0, cus = 0, per_cu = 0;
        hipGetDevice(&dev); hipDeviceGetAttribute(&cus, hipDeviceAttributeMultiprocessorCount, dev);
        hipFuncSetAttribute((const void*)mk_fwd, hipFuncAttributeMaxDynamicSharedMemorySize, LDS_BYTES);
        hipOccupancyMaxActiveBlocksPerMultiprocessor(&per_cu, (const void*)mk_fwd, NTH, LDS_BYTES);
        (void)hipGetLastError();
        if (per_cu < 1) { fprintf(stderr, "kernel_launch: occupancy query says %d blocks per CU\n", per_cu); per_cu = 1; }
        grid = cus;
    }
    if (grid < 0) return;
    hipMemsetAsync((char*)d_ws + WS_CTL, 0, CTL_ZERO_BYTES, stream);
    Args a{};
    for (int i = 0; i < 11; ++i) a.in[i] = (const float*)d_in[i];
    a.out = (float*)d_out; a.ws = (unsigned char*)d_ws;
    void* kargs[] = {&a};
    hipError_t e = hipLaunchCooperativeKernel((const void*)mk_fwd, dim3(grid), dim3(NTH), kargs, LDS_BYTES, stream);
    if (e != hipSuccess) fprintf(stderr, "kernel_launch: cooperative launch failed: %s (grid %d)\n", hipGetErrorString(e), grid);
}
```

```cpp
#include <hip/hip_runtime.h>
#include <stdint.h>
#include <cstdio>

typedef unsigned short u16;
typedef _Float16 h16x8 __attribute__((ext_vector_type(8)));
typedef float f32x16 __attribute__((ext_vector_type(16)));
typedef float f32x4 __attribute__((ext_vector_type(4)));
typedef unsigned v4u __attribute__((ext_vector_type(4)));
#define LAS __attribute__((address_space(3)))
#define GAS __attribute__((address_space(1)))

constexpr int NB = 8, SEQ = 2048, DM = 1024, MT = NB * SEQ;
constexpr int NPROJ = 2888, NPAD = 3072;
constexpr int NTH = 512, NWAVES = 8;
constexpr float QSCALE = 0.18033688011112042f;
constexpr float EPS = 1e-6f;

constexpr size_t WS_CTL = 0, CTL_ZERO_BYTES = 65536;
constexpr size_t WS_MOD = 65536;
constexpr size_t WS_ROPE = WS_MOD + (size_t)NB * 3072 * 4;
constexpr size_t WS_WINT = WS_ROPE + (size_t)SEQ * 32 * 8;
constexpr size_t WS_WOUTT = WS_WINT + (size_t)NPAD * DM * 2;
constexpr size_t WS_XN = WS_WOUTT + (size_t)DM * DM * 2;
constexpr size_t WS_U = WS_XN + (size_t)MT * DM * 2;
constexpr size_t WS_SG = WS_U + (size_t)MT * 512 * 2;
constexpr size_t WS_Q = WS_SG + (size_t)MT * 512 * 2;
constexpr size_t WS_GA = WS_Q + (size_t)MT * 512 * 2;
constexpr size_t WS_QI = WS_GA + (size_t)MT * 512 * 2;
constexpr size_t WS_K = WS_QI + (size_t)MT * 512 * 2;
constexpr size_t WS_V = WS_K + (size_t)MT * 128 * 2;
constexpr size_t WS_KI = WS_V + (size_t)MT * 128 * 2;
constexpr size_t WS_WI = WS_KI + (size_t)MT * 64 * 2;
constexpr size_t WS_MASK = WS_WI + (size_t)MT * 8 * 4;
constexpr size_t WS_MIX = WS_MASK + (size_t)MT * 64 * 4;
constexpr size_t WS_END = WS_MIX + (size_t)MT * DM * 2;
constexpr int CW_BAR = 1024;

constexpr int RING_BYTES = 131072;
constexpr int LDSCTL_OFF = RING_BYTES, MISC_OFF = LDSCTL_OFF + 320;
constexpr int LDS_BYTES = 147456;

__device__ __forceinline__ u16 f2h(float f) { return __builtin_bit_cast(u16, (_Float16)f); }
__device__ __forceinline__ float h2f(u16 h) { return (float)__builtin_bit_cast(_Float16, h); }
__device__ __forceinline__ float silu_f(float v) { return v / (1.f + __expf(-v)); }
__device__ __forceinline__ float wave_sum(float v) {
#pragma unroll
    for (int o = 1; o < 64; o <<= 1) v += __shfl_xor(v, o);
    return v;
}

__constant__ double ROPE_FREQ[32] = {1.0,0.7498942093324559,0.5623413251903491,0.4216965034285822,0.31622776601683794,0.23713737056616552,0.1778279410038923,0.1333521432163324,0.1,0.07498942093324558,0.05623413251903491,0.042169650342858224,0.03162277660168379,0.023713737056616554,0.01778279410038923,0.01333521432163324,0.01,0.007498942093324558,0.005623413251903491,0.004216965034285823,0.0031622776601683794,0.0023713737056616554,0.0017782794100389228,0.001333521432163324,0.001,0.0007498942093324559,0.0005623413251903491,0.00042169650342858224,0.00031622776601683794,0.00023713737056616554,0.00017782794100389227,0.0001333521432163324};

#define XB_TMO      128
#define XB_XCNT(j)  (256  + 64 * (j))
#define XB_XSUB(j)  (1280 + 64 * (j))
#define XB_XGEN(j)  (2304 + 64 * (j))
#define XB_TOP      3328
#define XB_TOPGEN   3392
#define XCD_BAR_WORDS 3456
#define XB_SPIN_CAP (1u << 18)

__device__ __forceinline__ unsigned xb_ld(unsigned* p)              { return __hip_atomic_load(p, __ATOMIC_RELAXED, __HIP_MEMORY_SCOPE_AGENT); }
__device__ __forceinline__ unsigned xb_add(unsigned* p, unsigned v) { return __hip_atomic_fetch_add(p, v, __ATOMIC_RELAXED, __HIP_MEMORY_SCOPE_AGENT); }
__device__ __forceinline__ unsigned xb_xcc_id() { return (unsigned)__builtin_amdgcn_s_getreg((3 << 11) | 20) & 0xFu; }
#define XB_SPIN(cond, bar) do { unsigned _sp = 0; while (cond) { __builtin_amdgcn_s_sleep(1); \
    if ((++_sp & 255u) == 0u) { if (xb_ld(&(bar)[XB_TMO])) break; if (_sp > XB_SPIN_CAP) { atomicAdd(&(bar)[XB_TMO], 1u); break; } } } } while (0)

struct XcdBarrier {
    unsigned* bar; unsigned x;
    volatile LAS unsigned* st;
};

__device__ __forceinline__ XcdBarrier xcd_barrier_post(unsigned* bar, volatile LAS unsigned* st) {
    XcdBarrier b; b.bar = bar; b.x = xb_xcc_id(); b.st = st;
    if (threadIdx.x == 0) (void)xb_add(&bar[XB_XCNT(b.x)], 1u);
    return b;
}
__device__ __forceinline__ void xcd_barrier_complete(unsigned* bar, unsigned x, unsigned& nloc, unsigned& nx) {
    const unsigned G = gridDim.x * gridDim.y * gridDim.z;
    unsigned sum, cnt, mine, sp = 0u;
    for (;;) {
        sum = 0u; cnt = 0u; mine = 0u;
#pragma unroll
        for (unsigned j = 0; j < 16; ++j) { const unsigned c = xb_ld(&bar[XB_XCNT(j)]); sum += c; cnt += (c > 0u) ? 1u : 0u; mine = (j == x) ? c : mine; }
        if (sum == G) break;
        __builtin_amdgcn_s_sleep(1);
        if ((++sp & 255u) == 0u) { if (xb_ld(&bar[XB_TMO])) break; if (sp > XB_SPIN_CAP) { atomicAdd(&bar[XB_TMO], 1u); break; } }
    }
    nloc = mine > 0u ? mine : 1u; nx = cnt > 0u ? cnt : 1u;
}

__device__ __forceinline__ void xcd_barrier(const XcdBarrier& b) {
    asm volatile("s_waitcnt vmcnt(0)" ::: "memory");
    __syncthreads();
    if (threadIdx.x == 0) {
        unsigned* bar = b.bar;
        __builtin_amdgcn_s_waitcnt(0);
        unsigned nloc = b.st[0], nx = b.st[1];
        if (nloc == 0u) { xcd_barrier_complete(bar, b.x, nloc, nx); b.st[0] = nloc; b.st[1] = nx; }
        const unsigned old = xb_add(&bar[XB_XSUB(b.x)], 1u);
        const unsigned gen = old / nloc;
        if (old + 1u == (gen + 1u) * nloc) {
            __builtin_amdgcn_fence(__ATOMIC_RELEASE, "agent");
            asm volatile("s_waitcnt vmcnt(0)" ::: "memory");
            const unsigned og = xb_add(&bar[XB_TOP], 1u);
            const unsigned tg = og / nx;
            if (og + 1u == (tg + 1u) * nx) xb_add(&bar[XB_TOPGEN], 1u);
            else XB_SPIN(xb_ld(&bar[XB_TOPGEN]) == tg, bar);
            __builtin_amdgcn_fence(__ATOMIC_ACQUIRE, "agent");
            xb_add(&bar[XB_XGEN(b.x)], 1u);
            asm volatile("s_waitcnt vmcnt(0)" ::: "memory");
        } else {
            XB_SPIN(xb_ld(&bar[XB_XGEN(b.x)]) == gen, bar);
            __builtin_amdgcn_fence(__ATOMIC_ACQUIRE, "agent");
            asm volatile("s_waitcnt vmcnt(0)" ::: "memory");
        }
    }
    __syncthreads();
}


struct Ctx {
    const float *x, *c, *norm_w, *w_ada, *b_ada, *w_in, *qnw, *knw, *w_pool, *pool_scale, *w_out;
    float* out;
    float* mod; float2* rope; u16 *WinT, *WoutT, *XN, *U, *SG, *Q, *GA, *QI, *K, *V, *KI; float* WI; unsigned* MASK; u16* MIX;
    LAS unsigned char* lds;
    int tid, lane, wave, bid, G;
};

__device__ __forceinline__ void p0_mod_unit(const Ctx& C, int u) {
    LAS float* sc = (LAS float*)C.lds;
    const int b = u / 6, e = (u % 6) * 512 + C.tid;
    __syncthreads();
    for (int i = C.tid; i < DM; i += NTH) sc[i] = silu_f(C.c[b * DM + i]);
    __syncthreads();
    float acc = C.b_ada[e];
    for (int d = 0; d < DM; ++d) acc += sc[d] * C.w_ada[(size_t)d * 3072 + e];
    C.mod[b * 3072 + e] = acc;
}
__device__ __forceinline__ void p0_rope_unit(const Ctx& C, int u) {
    const int idx = u * NTH + C.tid, pos = idx >> 5, i = idx & 31;
    const double ang = (double)pos * ROPE_FREQ[i];
    double t = ang * 0.15915494309189533576888;
    t -= floor(t + 0.5);
    const double x = t * 6.283185307179586476925287, x2 = x * x;
    double s = 0.0, cc = 0.0, ts = x, tc = 1.0;
#pragma unroll 1
    for (int n = 0; n < 14; ++n) { cc += tc; s += ts; tc *= -x2 / (double)((2 * n + 1) * (2 * n + 2)); ts *= -x2 / (double)((2 * n + 2) * (2 * n + 3)); }
    C.rope[idx] = make_float2((float)cc, (float)s);
}
__device__ __forceinline__ void p0_conv_unit(const Ctx& C, const float* W, int N, u16* WT, int u, bool perm) {
    LAS float* tl = (LAS float*)C.lds;
    const int nb = u >> 4, kb = u & 15, k0 = kb * 64, n0 = nb * 64;
    __syncthreads();
#pragma unroll
    for (int i = 0; i < 8; ++i) { const int kk = (C.tid >> 6) + 8 * i, nn = C.tid & 63, n = n0 + nn;
        tl[kk * 65 + nn] = n < N ? W[(size_t)(k0 + kk) * N + n] : 0.f; }
    __syncthreads();
    const int nn = C.tid >> 3, kc = (C.tid & 7) * 8;
    v4u o;
    o.x = (unsigned)f2h(tl[(kc + 0) * 65 + nn]) | ((unsigned)f2h(tl[(kc + 1) * 65 + nn]) << 16);
    o.y = (unsigned)f2h(tl[(kc + 2) * 65 + nn]) | ((unsigned)f2h(tl[(kc + 3) * 65 + nn]) << 16);
    o.z = (unsigned)f2h(tl[(kc + 4) * 65 + nn]) | ((unsigned)f2h(tl[(kc + 5) * 65 + nn]) << 16);
    o.w = (unsigned)f2h(tl[(kc + 6) * 65 + nn]) | ((unsigned)f2h(tl[(kc + 7) * 65 + nn]) << 16);
    const int nl = n0 + nn, np = perm ? ((nl & ~255) | (((nl >> 5) & 1) << 7) | (((nl >> 6) & 3) << 5) | (nl & 31)) : nl;
    *(v4u*)(WT + (size_t)np * DM + k0 + kc) = o;
}
__device__ __forceinline__ void phase0(const Ctx& C) {
    constexpr int U_MOD = 48, U_ROPE = 128, U_WIN = 48 * 16, U_WOUT = 16 * 16, U_ALL = U_MOD + U_ROPE + U_WIN + U_WOUT;
    for (int u = C.bid; u < U_ALL; u += C.G) {
        int r = u;
        if (r < U_MOD) { p0_mod_unit(C, r); continue; } r -= U_MOD;
        if (r < U_ROPE) { p0_rope_unit(C, r); continue; } r -= U_ROPE;
        if (r < U_WIN) { p0_conv_unit(C, C.w_in, NPROJ, C.WinT, r, true); continue; } r -= U_WIN;
        p0_conv_unit(C, C.w_out, DM, C.WoutT, r, false);
    }
}

__device__ __forceinline__ void phase0b(const Ctx& C) {
    for (int row = C.bid * NWAVES + C.wave; row < MT; row += C.G * NWAVES) {
        const int lane = C.lane, b = row >> 11;
        const float4* xr = (const float4*)(C.x + (size_t)row * DM) + lane;
        float4 v[4]; float s = 0.f;
#pragma unroll
        for (int j = 0; j < 4; ++j) { v[j] = xr[64 * j]; s += v[j].x * v[j].x + v[j].y * v[j].y + v[j].z * v[j].z + v[j].w * v[j].w; }
        const float rstd = rsqrtf(wave_sum(s) * (1.f / DM) + EPS);
        const float* shift = C.mod + b * 3072; const float* scale = shift + 1024;
#pragma unroll
        for (int j = 0; j < 4; ++j) {
            const int k = 4 * lane + 256 * j;
            const float4 w4 = *(const float4*)(C.norm_w + k), s4 = *(const float4*)(scale + k), h4 = *(const float4*)(shift + k);
            const float o0 = v[j].x * rstd * w4.x * (1.f + s4.x) + h4.x, o1 = v[j].y * rstd * w4.y * (1.f + s4.y) + h4.y;
            const float o2 = v[j].z * rstd * w4.z * (1.f + s4.z) + h4.z, o3 = v[j].w * rstd * w4.w * (1.f + s4.w) + h4.w;
            ushort4 o; o.x = f2h(o0); o.y = f2h(o1); o.z = f2h(o2); o.w = f2h(o3);
            *(ushort4*)(C.XN + (size_t)row * DM + k) = o;
        }
    }
}


namespace pg8 {
#define PG8_LAS __attribute__((address_space(3)))
typedef unsigned short bf16_t;
typedef _Float16 bf16x8 __attribute__((ext_vector_type(8)));
typedef float f32x4 __attribute__((ext_vector_type(4)));
typedef unsigned u32x4 __attribute__((ext_vector_type(4)));
constexpr int BM = 256, BK = 64, HALF = 128, HTB = HALF * BK * 2  , STAGE_BYTES = 8 * HTB, NXCD = 8, WGM = 8;

__host__ __device__ __forceinline__ int lds_byte(int r, int c) { const int st = (r >> 4) * 2 + (c >> 5), rr = r & 15, cc = c & 31, ob = rr * 64 + cc * 2; return st * 1024 + (ob ^ (((ob >> 9) & 1) << 5)); }
__host__ __device__ __forceinline__ void stage_rc(int b, int& R, int& C) { const int st = b / 1024, sb = b % 1024, swz = sb ^ (((sb >> 9) & 1) << 5); R = (st >> 1) * 16 + swz / 64; C = (st & 1) * 32 + (swz % 64) / 2; }
__host__ __device__ __forceinline__ int perm32(int rho) { const int n = rho >> 4, i = rho & 15; return 8 * (i >> 2) + 4 * n + (i & 3); }

struct Unit { int pm, pn; };
struct Gemm { const bf16_t* A; const bf16_t* Bt; int M, N, K; };

struct StaticOrder {
    int nM, nN, nwg, G, c;
    __host__ __device__ void init(int M, int N, int G_, int c_) { nM = M / BM; nN = N / BM; nwg = nM * nN; G = G_; c = c_; }
    __host__ __device__ bool next(int i, Unit& u) const {
        const long L = (long)i * G + c; if (L >= nwg) return false;
        int wgid = (int)L; { const int q = nwg / NXCD, r = nwg % NXCD, xcd = wgid % NXCD, off = wgid / NXCD; wgid = (xcd < r ? xcd * (q + 1) : r * (q + 1) + (xcd - r) * q) + off; }
        const int nig = WGM * nN, gid = wgid / nig, fm = gid * WGM, gsz = (nM - fm) < WGM ? (nM - fm) : WGM;
        u.pm = fm + ((wgid % nig) % gsz); u.pn = (wgid % nig) / gsz; return true;
    }
    __device__ __forceinline__ void a_ready(const Unit&) const {}
    __device__ __forceinline__ void done(const Unit&) const {}
};

template <class Epi, class Sched, bool ALIGN_EPI = false, bool SP2 = false>
__device__ __forceinline__ void gemm_phase(PG8_LAS unsigned char* lds, const Gemm g, const Sched& S, const Epi& E) {
    const int tid = threadIdx.x, wid = __builtin_amdgcn_readfirstlane(tid >> 6), lane = tid & 63, wr = wid >> 2, wc = wid & 3, fr = lane & 15, fq = lane >> 4;
    const int K = g.K, nt = K / BK;
    unsigned voffA[2], voffB[2];
#pragma unroll
    for (int i = 0; i < 2; ++i) { int R, C; stage_rc(tid * 16 + i * 8192, R, C); const int Rb = Epi::PERM ? ((R & ~31) + perm32(R & 31)) : R;
        voffA[i] = (unsigned)(R * K + C) * 2u; voffB[i] = (unsigned)(Rb * K + C) * 2u; }
    const size_t kstep = (size_t)(BK * 2);
    const size_t hstep = (size_t)HALF * K * 2;
    const size_t tstep = 2 * hstep;
    const unsigned ldsw = (unsigned)wid * 1024u;
    const int aoff = lds_byte(wr * 64 + fr, fq * 8), boff = lds_byte(wc * 32 + fr, fq * 8);
#define PG8_SA(b, h) (((b) * 2 + (h)) * HTB)
#define PG8_SB(b, h) ((4 + (b) * 2 + (h)) * HTB)
#define PG8_STAGE(bufoff, gbase, voff) do { _Pragma("unroll") for (int _i = 0; _i < 2; ++_i) \
        __builtin_amdgcn_global_load_lds((const unsigned*)((const char*)(gbase) + (voff)[_i]), (PG8_LAS unsigned*)(lds + (bufoff) + ldsw + _i * 8192), 16, 0, 0); } while (0)
#define PG8_LDA(dst, b, h) do { _Pragma("unroll") for (int m = 0; m < 4; ++m) _Pragma("unroll") for (int k = 0; k < 2; ++k) dst[m][k] = *(const PG8_LAS bf16x8*)(lds + PG8_SA(b, h) + aoff + m * 2048 + k * 1024); } while (0)
#define PG8_LDB(dst, b, h) do { _Pragma("unroll") for (int n = 0; n < 2; ++n) _Pragma("unroll") for (int k = 0; k < 2; ++k) dst[n][k] = *(const PG8_LAS bf16x8*)(lds + PG8_SB(b, h) + boff + n * 2048 + k * 1024); } while (0)
#define PG8_MMA(ai, bj, At, Bt) do { __builtin_amdgcn_s_setprio(1); _Pragma("unroll") for (int m = 0; m < 4; ++m) _Pragma("unroll") for (int n = 0; n < 2; ++n) _Pragma("unroll") for (int k = 0; k < 2; ++k) \
        acc[ai][bj][m][n] = __builtin_amdgcn_mfma_f32_16x16x32_f16(Bt[n][k], At[m][k], acc[ai][bj][m][n], 0, 0, 0); __builtin_amdgcn_s_setprio(0); } while (0)
#define PG8_WAIT_V(n) asm volatile("s_waitcnt vmcnt(" #n ")" ::: "memory")
#define PG8_WAIT_L(n) asm volatile("s_waitcnt lgkmcnt(" #n ")" ::: "memory")
#define PG8_BAR __builtin_amdgcn_s_barrier()
#define PG8_SCHED __builtin_amdgcn_sched_barrier(0)
    Unit cur, nxt; int ui = 0;
    if (!S.next(0, cur)) return;
    f32x4 acc[2][2][4][2];
#pragma unroll
    for (int a = 0; a < 2; ++a)
#pragma unroll
        for (int b = 0; b < 2; ++b)
#pragma unroll
            for (int m = 0; m < 4; ++m)
#pragma unroll
                for (int n = 0; n < 2; ++n) acc[a][b][m][n] = (f32x4){0.f, 0.f, 0.f, 0.f};
    bf16x8 At[4][2], B0[2][2], B1[2][2];
    const char* cA = (const char*)g.A + (size_t)cur.pm * tstep; const char* cB = (const char*)g.Bt + (size_t)cur.pn * tstep;
    S.a_ready(cur);
    if constexpr (SP2) {
        PG8_STAGE(PG8_SB(0, 0), cB, voffB); PG8_STAGE(PG8_SB(0, 1), cB + hstep, voffB); PG8_STAGE(PG8_SA(0, 0), cA, voffA); PG8_STAGE(PG8_SA(0, 1), cA + hstep, voffA);
        if (wr == 1) PG8_BAR;
        PG8_WAIT_V(2); PG8_BAR;
        PG8_STAGE(PG8_SB(1, 0), cB + kstep, voffB); PG8_STAGE(PG8_SA(1, 0), cA + kstep, voffA); PG8_STAGE(PG8_SB(1, 1), cB + hstep + kstep, voffB);
        PG8_WAIT_V(6); PG8_BAR;
    } else {
        PG8_STAGE(PG8_SB(0, 0), cB, voffB); PG8_STAGE(PG8_SA(0, 0), cA, voffA); PG8_STAGE(PG8_SB(0, 1), cB + hstep, voffB); PG8_STAGE(PG8_SA(0, 1), cA + hstep, voffA);
        if (wr == 1) PG8_BAR;
        PG8_WAIT_V(4); PG8_BAR;
        PG8_STAGE(PG8_SB(1, 0), cB + kstep, voffB); PG8_STAGE(PG8_SA(1, 0), cA + kstep, voffA); PG8_STAGE(PG8_SB(1, 1), cB + hstep + kstep, voffB);
        PG8_WAIT_V(6); PG8_BAR;
    }
    for (;;) {
        const bool has_next = S.next(ui + 1, nxt);
        const char* nA = has_next ? (const char*)g.A + (size_t)nxt.pm * tstep : cA; const char* nB = has_next ? (const char*)g.Bt + (size_t)nxt.pn * tstep : cB;
        for (int t = 0; t < nt; t += 2) {
            const bool last = (t == nt - 2);
            const char* a1 = cA + (size_t)(t + 1) * kstep;
            const char* a2 = last ? nA : cA + (size_t)(t + 2) * kstep; const char* b2 = last ? nB : cB + (size_t)(t + 2) * kstep;
            const char* a3 = a2 + kstep; const char* b3 = b2 + kstep;
            if (last && has_next) S.a_ready(nxt);
            if constexpr (SP2) {
            PG8_LDB(B0, 0, 0); PG8_LDB(B1, 0, 1); PG8_SCHED; PG8_LDA(At, 0, 0); PG8_STAGE(PG8_SA(1, 1), a1 + hstep, voffA);
            PG8_WAIT_V(8); PG8_WAIT_L(0); PG8_BAR; PG8_MMA(0, 0, At, B0); PG8_MMA(0, 1, At, B1); PG8_BAR; PG8_SCHED;
            PG8_LDA(At, 0, 1); PG8_STAGE(PG8_SB(0, 0), b2, voffB); PG8_STAGE(PG8_SB(0, 1), b2 + hstep, voffB); PG8_STAGE(PG8_SA(0, 0), a2, voffA);
            PG8_WAIT_V(8); PG8_WAIT_L(0); PG8_BAR; PG8_MMA(1, 0, At, B0); PG8_MMA(1, 1, At, B1); PG8_BAR; PG8_SCHED;
            PG8_LDB(B0, 1, 0); PG8_LDB(B1, 1, 1); PG8_SCHED; PG8_LDA(At, 1, 0); PG8_STAGE(PG8_SA(0, 1), a2 + hstep, voffA);
            PG8_WAIT_V(8); PG8_WAIT_L(0); PG8_BAR; PG8_MMA(0, 0, At, B0); PG8_MMA(0, 1, At, B1); PG8_BAR; PG8_SCHED;
            PG8_LDA(At, 1, 1); PG8_STAGE(PG8_SB(1, 0), b3, voffB); PG8_STAGE(PG8_SB(1, 1), b3 + hstep, voffB); PG8_STAGE(PG8_SA(1, 0), a3, voffA);
            PG8_WAIT_V(8); PG8_WAIT_L(0); PG8_BAR; PG8_MMA(1, 0, At, B0); PG8_MMA(1, 1, At, B1); PG8_BAR; PG8_SCHED;
            } else {
            PG8_LDB(B0, 0, 0); PG8_SCHED; PG8_LDA(At, 0, 0); PG8_STAGE(PG8_SA(1, 1), a1 + hstep, voffA);
            PG8_WAIT_L(8); PG8_BAR; PG8_WAIT_L(0); PG8_MMA(0, 0, At, B0); PG8_BAR; PG8_SCHED;
            PG8_LDB(B1, 0, 1); PG8_STAGE(PG8_SB(0, 0), b2, voffB);
            PG8_BAR; PG8_WAIT_L(0); PG8_MMA(0, 1, At, B1); PG8_BAR;
            PG8_LDA(At, 0, 1); PG8_STAGE(PG8_SA(0, 0), a2, voffA);
            PG8_BAR; PG8_WAIT_L(0); PG8_MMA(1, 0, At, B0); PG8_BAR; PG8_SCHED;
            PG8_STAGE(PG8_SB(0, 1), b2 + hstep, voffB);
            PG8_WAIT_V(6); PG8_BAR; PG8_MMA(1, 1, At, B1); PG8_BAR;
            PG8_LDB(B0, 1, 0); PG8_SCHED; PG8_LDA(At, 1, 0); PG8_STAGE(PG8_SA(0, 1), a2 + hstep, voffA);
            PG8_WAIT_L(8); PG8_BAR; PG8_WAIT_L(0); PG8_MMA(0, 0, At, B0); PG8_BAR; PG8_SCHED;
            PG8_LDB(B1, 1, 1); PG8_STAGE(PG8_SB(1, 0), b3, voffB);
            PG8_BAR; PG8_WAIT_L(0); PG8_MMA(0, 1, At, B1); PG8_BAR;
            PG8_LDA(At, 1, 1); PG8_STAGE(PG8_SA(1, 0), a3, voffA);
            PG8_BAR; PG8_WAIT_L(0); PG8_MMA(1, 0, At, B0); PG8_BAR; PG8_SCHED;
            PG8_STAGE(PG8_SB(1, 1), b3 + hstep, voffB);
            PG8_WAIT_V(6); PG8_BAR; PG8_MMA(1, 1, At, B1); PG8_BAR;
            }
        }
        if constexpr (ALIGN_EPI) { if (wr == 0) PG8_BAR; }
        if constexpr (!Epi::AFTER_DRAIN) { E(acc, cur, wr, wc, fr, fq); S.done(cur); }
        if (!has_next) break;
#pragma unroll
        for (int a = 0; a < 2; ++a)
#pragma unroll
            for (int b = 0; b < 2; ++b)
#pragma unroll
                for (int m = 0; m < 4; ++m)
#pragma unroll
                    for (int n = 0; n < 2; ++n) acc[a][b][m][n] = (f32x4){0.f, 0.f, 0.f, 0.f};
        cur = nxt; cA = nA; cB = nB; ++ui;
        if constexpr (ALIGN_EPI) { if (wr == 1) PG8_BAR; }
    }
    PG8_WAIT_V(0);
    if constexpr (!ALIGN_EPI) { if (wr == 0) PG8_BAR; }
    PG8_BAR;
    if constexpr (Epi::AFTER_DRAIN) { E.fused(acc, cur, wr, wc, fr, fq, lds, wid, lane); S.done(cur); }
#undef PG8_SA
#undef PG8_SB
#undef PG8_STAGE
#undef PG8_LDA
#undef PG8_LDB
#undef PG8_MMA
#undef PG8_WAIT_V
#undef PG8_WAIT_L
#undef PG8_BAR
#undef PG8_SCHED
}
}


__device__ __forceinline__ unsigned pk2h(float lo, float hi) { typedef _Float16 h2 __attribute__((ext_vector_type(2))); h2 v; v.x = (_Float16)lo; v.y = (_Float16)hi; return __builtin_bit_cast(unsigned, v); }

struct EpiP1 {
    static constexpr bool PERM = true, AFTER_DRAIN = false;
    u16 *U, *SG, *Q, *GA, *QI, *K, *V, *KI; float* WI; const float *qnw, *knw; const float2* rope;
    __device__ __forceinline__ void operator()(const f32x4 (&acc)[2][2][4][2], const pg8::Unit& u, int wr, int wc, int fr, int fq) const {
        const int g = u.pn * 4 + wc;
        if (g > 45) return;
        int mode, ld; u16* dst; const float* nwp = qnw; float osc = 1.f;
        if (g < 8) { mode = 0; dst = U + g * 64; ld = 512; }
        else if (g < 16) { mode = 1; dst = SG + (g - 8) * 64; ld = 512; }
        else if (g < 24) { mode = 2; dst = Q + (g - 16) * 64; ld = 512; osc = QSCALE; }
        else if (g < 26) { mode = 2; dst = K + (g - 24) * 64; ld = 128; nwp = knw; }
        else if (g < 28) { mode = 0; dst = V + (g - 26) * 64; ld = 128; }
        else if (g < 36) { mode = 1; dst = GA + (g - 28) * 64; ld = 512; }
        else if (g < 44) { mode = 3; dst = QI + (g - 36) * 64; ld = 512; }
        else if (g == 44) { mode = 3; dst = KI; ld = 64; }
        else { mode = 4; dst = KI; ld = 64; }
        const int row0 = u.pm * 256 + wr * 64 + fr;
        if (mode == 4) {
            if (fq == 0) {
#pragma unroll
                for (int ai = 0; ai < 2; ++ai)
#pragma unroll
                    for (int m = 0; m < 4; ++m) { float* wp = WI + (size_t)(row0 + ai * 128 + m * 16) * 8; *(f32x4*)wp = acc[ai][0][m][0]; *(f32x4*)(wp + 4) = acc[ai][0][m][1]; }
            }
            return;
        }
        f32x4 nlo0 = {1.f, 1.f, 1.f, 1.f}, nlo1 = nlo0, nhi0 = nlo0, nhi1 = nlo0;
        if (mode == 2) { nlo0 = *(const f32x4*)(nwp + 8 * fq); nlo1 = *(const f32x4*)(nwp + 8 * fq + 4); nhi0 = *(const f32x4*)(nwp + 32 + 8 * fq); nhi1 = *(const f32x4*)(nwp + 36 + 8 * fq); }
#pragma unroll
        for (int ai = 0; ai < 2; ++ai)
#pragma unroll
            for (int m = 0; m < 4; ++m) {
                const int t = row0 + ai * 128 + m * 16;
                f32x4 a0 = acc[ai][0][m][0], a1 = acc[ai][0][m][1], b0 = acc[ai][1][m][0], b1 = acc[ai][1][m][1];
                if (mode == 1) {
#pragma unroll
                    for (int j = 0; j < 4; ++j) { a0[j] = silu_f(a0[j]); a1[j] = silu_f(a1[j]); b0[j] = silu_f(b0[j]); b1[j] = silu_f(b1[j]); }
                } else if (mode >= 2) {
                    if (mode == 2) {
                        float ss = 0.f;
#pragma unroll
                        for (int j = 0; j < 4; ++j) ss += a0[j] * a0[j] + a1[j] * a1[j] + b0[j] * b0[j] + b1[j] * b1[j];
                        ss += __shfl_xor(ss, 16); ss += __shfl_xor(ss, 32);
                        const float rinv = rsqrtf(ss * (1.f / 64.f) + EPS);
                        a0 = a0 * rinv * nlo0; a1 = a1 * rinv * nlo1; b0 = b0 * rinv * nhi0; b1 = b1 * rinv * nhi1;
                    }
                    const f32x4* rp = (const f32x4*)(rope + (size_t)(t & (SEQ - 1)) * 32 + 8 * fq);
                    const f32x4 r0 = rp[0], r1 = rp[1], r2 = rp[2], r3 = rp[3];
                    f32x4 o0, o1, p0, p1;
                    o0[0] = a0[0] * r0[0] - b0[0] * r0[1]; p0[0] = b0[0] * r0[0] + a0[0] * r0[1];
                    o0[1] = a0[1] * r0[2] - b0[1] * r0[3]; p0[1] = b0[1] * r0[2] + a0[1] * r0[3];
                    o0[2] = a0[2] * r1[0] - b0[2] * r1[1]; p0[2] = b0[2] * r1[0] + a0[2] * r1[1];
                    o0[3] = a0[3] * r1[2] - b0[3] * r1[3]; p0[3] = b0[3] * r1[2] + a0[3] * r1[3];
                    o1[0] = a1[0] * r2[0] - b1[0] * r2[1]; p1[0] = b1[0] * r2[0] + a1[0] * r2[1];
                    o1[1] = a1[1] * r2[2] - b1[1] * r2[3]; p1[1] = b1[1] * r2[2] + a1[1] * r2[3];
                    o1[2] = a1[2] * r3[0] - b1[2] * r3[1]; p1[2] = b1[2] * r3[0] + a1[2] * r3[1];
                    o1[3] = a1[3] * r3[2] - b1[3] * r3[3]; p1[3] = b1[3] * r3[2] + a1[3] * r3[3];
                    a0 = o0 * osc; a1 = o1 * osc; b0 = p0 * osc; b1 = p1 * osc;
                }
                u16* dp = dst + (size_t)t * ld + 8 * fq;
                v4u lo, hi; lo.x = pk2h(a0[0], a0[1]); lo.y = pk2h(a0[2], a0[3]); lo.z = pk2h(a1[0], a1[1]); lo.w = pk2h(a1[2], a1[3]);
                hi.x = pk2h(b0[0], b0[1]); hi.y = pk2h(b0[2], b0[3]); hi.z = pk2h(b1[0], b1[1]); hi.w = pk2h(b1[2], b1[3]);
                *(v4u*)dp = lo; *(v4u*)(dp + 32) = hi;
                if (m & 1) asm volatile("" ::: "memory");
            }
    }
};
struct EpiOut {
    static constexpr bool PERM = true, AFTER_DRAIN = false;
    const float* x; const float* gate; float* out;
    __device__ __forceinline__ void operator()(const f32x4 (&acc)[2][2][4][2], const pg8::Unit& u, int wr, int wc, int fr, int fq) const {
        const int row0 = u.pm * 256 + wr * 64 + fr, col0 = u.pn * 256 + wc * 32 + 8 * fq, b = (u.pm * 256) >> 11;
        f32x4 gv[2][2];
#pragma unroll
        for (int bj = 0; bj < 2; ++bj)
#pragma unroll
            for (int n = 0; n < 2; ++n) gv[bj][n] = *(const f32x4*)(gate + b * 3072 + col0 + bj * 128 + 4 * n);
#pragma unroll
        for (int ai = 0; ai < 2; ++ai)
#pragma unroll
            for (int m = 0; m < 4; ++m) {
                const size_t off = (size_t)(row0 + ai * 128 + m * 16) * DM + col0;
#pragma unroll
                for (int bj = 0; bj < 2; ++bj)
#pragma unroll
                    for (int n = 0; n < 2; ++n) { const f32x4 xv = *(const f32x4*)(x + off + bj * 128 + 4 * n); *(f32x4*)(out + off + bj * 128 + 4 * n) = xv + gv[bj][n] * acc[ai][bj][m][n]; }
                if (m & 1) asm volatile("" ::: "memory");
            }
    }
};

__device__ __forceinline__ void p1_epilogue_row(const Ctx& C, int g, int t, int sub, const LAS float* tr) {
    const int pos = t & (SEQ - 1);
    if (g < 8) {
        for (int c = 16 * sub; c < 16 * sub + 16; ++c) C.U[(size_t)t * 512 + g * 64 + c] = f2h(tr[c]);
    } else if (g < 16) {
        for (int c = 16 * sub; c < 16 * sub + 16; ++c) C.SG[(size_t)t * 512 + (g - 8) * 64 + c] = f2h(silu_f(tr[c]));
    } else if (g < 26) {
        float ss = 0.f;
        for (int c = 16 * sub; c < 16 * sub + 16; ++c) ss += tr[c] * tr[c];
        ss += __shfl_xor(ss, 1); ss += __shfl_xor(ss, 2);
        const float rinv = rsqrtf(ss * (1.f / 64.f) + EPS);
        const bool isq = g < 24; const float* nwp = isq ? C.qnw : C.knw; const float osc = isq ? QSCALE : 1.f;
        u16* dst = isq ? C.Q + (size_t)t * 512 + (g - 16) * 64 : C.K + (size_t)t * 128 + (g - 24) * 64;
        for (int i = 8 * sub; i < 8 * sub + 8; ++i) {
            const float x1 = tr[i] * rinv * nwp[i], x2 = tr[i + 32] * rinv * nwp[i + 32];
            const float2 cs = C.rope[pos * 32 + i];
            dst[i] = f2h((x1 * cs.x - x2 * cs.y) * osc); dst[i + 32] = f2h((x2 * cs.x + x1 * cs.y) * osc);
        }
    } else if (g < 28) {
        for (int c = 16 * sub; c < 16 * sub + 16; ++c) C.V[(size_t)t * 128 + (g - 26) * 64 + c] = f2h(tr[c]);
    } else if (g < 36) {
        for (int c = 16 * sub; c < 16 * sub + 16; ++c) C.GA[(size_t)t * 512 + (g - 28) * 64 + c] = f2h(silu_f(tr[c]));
    } else if (g < 45) {
        u16* dst = g < 44 ? C.QI + (size_t)t * 512 + (g - 36) * 64 : C.KI + (size_t)t * 64;
        for (int i = 8 * sub; i < 8 * sub + 8; ++i) {
            const float x1 = tr[i], x2 = tr[i + 32];
            const float2 cs = C.rope[pos * 32 + i];
            dst[i] = f2h(x1 * cs.x - x2 * cs.y); dst[i + 32] = f2h(x2 * cs.x + x1 * cs.y);
        }
    } else {
        if (sub == 0) for (int c = 0; c < 8; ++c) C.WI[(size_t)t * 8 + c] = tr[c];
    }
}
__device__ __forceinline__ void phase1_naive(const Ctx& C) {
    LAS float* tile = (LAS float*)C.lds;
    for (int u = C.bid; u < 46 * 128; u += C.G) {
        const int g = u % 46, r0 = (u / 46) * 128, w = C.wave, lane = C.lane, wr = w & 3, wcn = w >> 2;
        const u16* ap = C.XN + (size_t)(r0 + wr * 32 + (lane & 31)) * DM + 8 * (lane >> 5);
        const u16* bp = C.WinT + (size_t)(g * 64 + wcn * 32 + (lane & 31)) * DM + 8 * (lane >> 5);
        f32x16 acc;
#pragma unroll
        for (int r = 0; r < 16; ++r) acc[r] = 0.f;
        for (int k0 = 0; k0 < DM; k0 += 16) {
            const h16x8 a = *(const h16x8*)(ap + k0), bb = *(const h16x8*)(bp + k0);
            acc = __builtin_amdgcn_mfma_f32_32x32x16_f16(a, bb, acc, 0, 0, 0);
        }
        __syncthreads();
#pragma unroll
        for (int r = 0; r < 16; ++r) tile[(wr * 32 + (r & 3) + 8 * (r >> 2) + 4 * (lane >> 5)) * 65 + wcn * 32 + (lane & 31)] = acc[r];
        __syncthreads();
        const int row = C.tid >> 2, sub = C.tid & 3;
        p1_epilogue_row(C, g, r0 + row, sub, tile + row * 65);
    }
}

__device__ __forceinline__ void pool_unit_naive(const Ctx& C, int u) {
    LAS float* pl = (LAS float*)C.lds;
    const int t0 = (u >> 2) * 64, g = u & 3, tid = C.tid, win = 2 << g;
    __syncthreads();
    for (int idx = tid; idx < 64 * 128; idx += NTH) {
        const int tl = idx >> 7, c = idx & 127, t = t0 + tl, pos = t & (SEQ - 1);
        const int cnt = (pos + 1 < win) ? pos + 1 : win;
        float s = 0.f;
        for (int j = 0; j < cnt; ++j) s += h2f(C.U[(size_t)(t - j) * 512 + g * 128 + c]);
        pl[tl * 128 + c] = s / (float)cnt - h2f(C.U[(size_t)t * 512 + g * 128 + c]);
    }
    __syncthreads();
    const int d = tid & 127, rh = tid >> 7;
    float acc[16];
#pragma unroll
    for (int i = 0; i < 16; ++i) acc[i] = 0.f;
    const float* wp = C.w_pool + (size_t)g * 128 * 128 + d;
    for (int c = 0; c < 128; ++c) {
        const float wv = wp[(size_t)c * 128];
#pragma unroll
        for (int i = 0; i < 16; ++i) acc[i] += pl[(rh * 16 + i) * 128 + c] * wv;
    }
    const float ps = C.pool_scale[g * 128 + d];
#pragma unroll
    for (int i = 0; i < 16; ++i) {
        const int t = t0 + rh * 16 + i;
        C.MIX[(size_t)t * 1024 + g * 128 + d] = f2h(acc[i] * ps * h2f(C.SG[(size_t)t * 512 + g * 128 + d]));
    }
}

__device__ __forceinline__ unsigned fkey(float f) { const unsigned u = __float_as_uint(f); return (u & 0x80000000u) ? ~u : (u | 0x80000000u); }
__device__ __forceinline__ int block_sum_int(int v, LAS int* red) {
#pragma unroll
    for (int o = 1; o < 64; o <<= 1) v += __shfl_xor(v, o);
    __syncthreads();
    if ((threadIdx.x & 63) == 0) red[threadIdx.x >> 6] = v;
    __syncthreads();
    return red[0] + red[1] + red[2] + red[3] + red[4] + red[5] + red[6] + red[7];
}

typedef _Float16 h16x8_t __attribute__((ext_vector_type(8)));
__device__ __forceinline__ int stageA_total(LAS int* part, int pp, int w, int fr, int fq, int cnt) {
    cnt += __shfl_xor(cnt, 16); cnt += __shfl_xor(cnt, 32);
    if (fq == 0) part[(pp * 8 + w) * 16 + fr] = cnt;
    __syncthreads();
    int tot = 0;
#pragma unroll
    for (int ww = 0; ww < 8; ++ww) tot += part[(pp * 8 + ww) * 16 + fr];
    return tot;
}
__device__ __forceinline__ void stageA_unit(const Ctx& C, int b, int qb) {
    LAS int* part = (LAS int*)C.lds;
    const int w = C.wave, lane = C.lane, fr = lane & 15, fq = lane >> 4;
    const int pos = 16 * qb + fr, t = b * SEQ + pos;
    __syncthreads();
    h16x8 qf[8][2];
#pragma unroll
    for (int h = 0; h < 8; ++h)
#pragma unroll
        for (int ks = 0; ks < 2; ++ks) qf[h][ks] = *(const h16x8*)(C.QI + (size_t)t * 512 + h * 64 + 32 * ks + 8 * fq);
    float wi[8];
    { const f32x4 w0 = *(const f32x4*)(C.WI + (size_t)t * 8), w1 = *(const f32x4*)(C.WI + (size_t)t * 8 + 4);
      wi[0] = w0[0]; wi[1] = w0[1]; wi[2] = w0[2]; wi[3] = w0[3]; wi[4] = w1[0]; wi[5] = w1[1]; wi[6] = w1[2]; wi[7] = w1[3]; }
    const int nst = (qb >> 1) + 1;
    unsigned key[8][2][4];
#pragma unroll
    for (int i = 0; i < 8; ++i) {
        const int st = w + 8 * i;
#pragma unroll
        for (int tt = 0; tt < 2; ++tt) {
            const int kt = 2 * st + tt;
            if (st < nst && kt <= qb) {
                const u16* kp = C.KI + (size_t)(b * SEQ + 16 * kt + fr) * 64 + 8 * fq;
                const h16x8 a0 = *(const h16x8*)kp, a1 = *(const h16x8*)(kp + 32);
                f32x4 sc = {0.f, 0.f, 0.f, 0.f};
#pragma unroll
                for (int h = 0; h < 8; ++h) {
                    f32x4 acc = {0.f, 0.f, 0.f, 0.f};
                    acc = __builtin_amdgcn_mfma_f32_16x16x32_f16(a0, qf[h][0], acc, 0, 0, 0);
                    acc = __builtin_amdgcn_mfma_f32_16x16x32_f16(a1, qf[h][1], acc, 0, 0, 0);
#pragma unroll
                    for (int r = 0; r < 4; ++r) sc[r] += wi[h] * fmaxf(acc[r], 0.f);
                }
#pragma unroll
                for (int r = 0; r < 4; ++r) key[i][tt][r] = (16 * kt + r <= pos - 4 * fq) ? fkey(sc[r]) : 0u;
            } else {
#pragma unroll
                for (int r = 0; r < 4; ++r) key[i][tt][r] = 0u;
            }
        }
        asm volatile("" ::: "memory");
    }
    bool done = pos < 256; unsigned T = done ? 1u : 0u; int pp = 0;
    for (int bit = 31; bit >= 0; --bit) {
        const unsigned cand = done ? T : (T | (1u << bit));
        int cnt = 0;
#pragma unroll
        for (int i = 0; i < 8; ++i) if (w + 8 * i < nst) {
#pragma unroll
            for (int tt = 0; tt < 2; ++tt)
#pragma unroll
                for (int r = 0; r < 4; ++r) cnt += key[i][tt][r] >= cand ? 1 : 0; }
        const int tot = stageA_total(part, pp, w, fr, fq, cnt); pp ^= 1;
        if (!done && tot >= 256) { T = cand; if (tot == 256) done = true; }
        if (__all(done)) break;
    }
    unsigned J = 2047u;
    if (__any(!done)) {
        int cnt = 0;
#pragma unroll
        for (int i = 0; i < 8; ++i) if (w + 8 * i < nst) {
#pragma unroll
            for (int tt = 0; tt < 2; ++tt)
#pragma unroll
                for (int r = 0; r < 4; ++r) cnt += key[i][tt][r] > T ? 1 : 0; }
        const int need = 256 - stageA_total(part, pp, w, fr, fq, cnt); pp ^= 1;
        unsigned Jt = 0u;
        for (int bit = 10; bit >= 0; --bit) {
            const unsigned cj = Jt | (1u << bit);
            const int cjl = (int)cj - 4 * fq;
            int c2 = 0;
#pragma unroll
            for (int i = 0; i < 8; ++i) if (w + 8 * i < nst) {
#pragma unroll
                for (int tt = 0; tt < 2; ++tt)
#pragma unroll
                    for (int r = 0; r < 4; ++r) c2 += (key[i][tt][r] == T && (32 * (w + 8 * i) + 16 * tt + r) < cjl) ? 1 : 0; }
            const int tot = stageA_total(part, pp, w, fr, fq, c2); pp ^= 1;
            if (tot < need) Jt = cj;
        }
        if (!done) J = Jt;
    }
    const int Jl = (int)J - 4 * fq;
#pragma unroll
    for (int i = 0; i < 8; ++i) {
        const int st = w + 8 * i; unsigned loc = 0u;
        if (st < nst) {
#pragma unroll
            for (int tt = 0; tt < 2; ++tt)
#pragma unroll
                for (int r = 0; r < 4; ++r) { const unsigned k = key[i][tt][r];
                    if (k > T || (k == T && (32 * st + 16 * tt + r) <= Jl)) loc |= 1u << (4 * tt + r); }
        }
        unsigned bits = ((loc & 15u) << (4 * fq)) | ((loc >> 4) << (16 + 4 * fq));
        bits |= __shfl_xor(bits, 16); bits |= __shfl_xor(bits, 32);
        if (fq == 0) C.MASK[(size_t)t * 64 + st] = bits;
    }
}
__device__ __forceinline__ void stageA_phase(const Ctx& C) {
    for (int bb = C.bid; bb < 256; bb += C.G) {
        const int b = bb >> 5, s = bb & 31;
#pragma unroll 1
        for (int j = 0; j < 4; ++j) stageA_unit(C, b, (j & 1) ? (j * 32 + 31 - s) : (j * 32 + s));
    }
}
__device__ __forceinline__ void selattn_row_naive(const Ctx& C, int t) {
    LAS float* qs = (LAS float*)C.lds;
    LAS unsigned* keys = (LAS unsigned*)(C.lds + 2048);
    LAS unsigned* mk = (LAS unsigned*)(C.lds + 10240);
    LAS int* wpre = (LAS int*)(C.lds + 10496);
    LAS int* red = (LAS int*)(C.lds + 10816);
    LAS int* sel = (LAS int*)(C.lds + 10880);
    LAS float* p = (LAS float*)(C.lds + 11904);
    LAS float* hl = (LAS float*)(C.lds + 21120);
    const int b = t >> 11, pos = t & (SEQ - 1), n = pos + 1, tid = C.tid;
    __syncthreads();
    if (tid < 64) mk[tid] = C.MASK[(size_t)t * 64 + tid];
    __syncthreads();
    if (tid == 0) { int a = 0; for (int i = 0; i < 64; ++i) { wpre[i] = a; a += __popc(mk[i]); } wpre[64] = a; }
    __syncthreads();
    const int nsel = wpre[64];
    for (int s = tid; s < n; s += NTH) { const unsigned wv = mk[s >> 5]; if ((wv >> (s & 31)) & 1u) sel[wpre[s >> 5] + __popc(wv & ((1u << (s & 31)) - 1u))] = s; }
    for (int i = tid; i < 512; i += NTH) qs[i] = h2f(C.Q[(size_t)t * 512 + i]);
    __syncthreads();
    if (tid < 256) {
        if (tid < nsel) {
            const int s = sel[tid];
#pragma unroll
            for (int kvh = 0; kvh < 2; ++kvh) {
                const u16* kp = C.K + (size_t)(b * SEQ + s) * 128 + kvh * 64;
                float dq[4] = {0.f, 0.f, 0.f, 0.f};
#pragma unroll 1
                for (int i = 0; i < 8; ++i) { const h16x8 v8 = *(const h16x8*)(kp + 8 * i);
#pragma unroll
                    for (int gq = 0; gq < 4; ++gq) {
#pragma unroll
                        for (int j = 0; j < 8; ++j) dq[gq] += qs[(kvh * 4 + gq) * 64 + 8 * i + j] * (float)v8[j]; } }
#pragma unroll
                for (int gq = 0; gq < 4; ++gq) p[tid * 9 + kvh * 4 + gq] = dq[gq];
            }
        } else {
#pragma unroll
            for (int h = 0; h < 8; ++h) p[tid * 9 + h] = -INFINITY;
        }
    }
    __syncthreads();
    {
        const int h = C.wave, lane = C.lane;
        float m = -INFINITY;
        for (int j = lane; j < 256; j += 64) m = fmaxf(m, p[j * 9 + h]);
#pragma unroll
        for (int o2 = 1; o2 < 64; o2 <<= 1) m = fmaxf(m, __shfl_xor(m, o2));
        float l = 0.f;
        for (int j = lane; j < 256; j += 64) { const float e = exp2f(p[j * 9 + h] - m); p[j * 9 + h] = e; l += e; }
        l = wave_sum(l);
        if (lane == 0) hl[h] = l;
    }
    __syncthreads();
    {
        const int h = tid >> 6, d = tid & 63, kvh = h >> 2;
        float a0 = 0.f;
        for (int j = 0; j < nsel; ++j) a0 += p[j * 9 + h] * h2f(C.V[(size_t)(b * SEQ + sel[j]) * 128 + kvh * 64 + d]);
        C.MIX[(size_t)t * 1024 + 512 + h * 64 + d] = f2h(a0 / hl[h] * h2f(C.GA[(size_t)t * 512 + h * 64 + d]));
    }
}

__device__ __forceinline__ void phase3_naive(const Ctx& C) {
    for (int u = C.bid; u < 16 * 128; u += C.G) {
        const int c0 = (u & 15) * 64, r0 = (u >> 4) * 128, w = C.wave, lane = C.lane, wr = w & 3, wcn = w >> 2;
        const u16* ap = C.MIX + (size_t)(r0 + wr * 32 + (lane & 31)) * DM + 8 * (lane >> 5);
        const u16* bp = C.WoutT + (size_t)(c0 + wcn * 32 + (lane & 31)) * DM + 8 * (lane >> 5);
        f32x16 acc;
#pragma unroll
        for (int r = 0; r < 16; ++r) acc[r] = 0.f;
        for (int k0 = 0; k0 < DM; k0 += 16) {
            const h16x8 a = *(const h16x8*)(ap + k0), bb = *(const h16x8*)(bp + k0);
            acc = __builtin_amdgcn_mfma_f32_32x32x16_f16(a, bb, acc, 0, 0, 0);
        }
        const int col = c0 + wcn * 32 + (lane & 31), b = r0 >> 11;
        const float gate = C.mod[b * 3072 + 2048 + col];
#pragma unroll
        for (int r = 0; r < 16; ++r) {
            const int row = r0 + wr * 32 + (r & 3) + 8 * (r >> 2) + 4 * (lane >> 5);
            C.out[(size_t)row * DM + col] = C.x[(size_t)row * DM + col] + gate * acc[r];
        }
    }
}

struct Args { const float* in[11]; float* out; unsigned char* ws; };
__global__ void __launch_bounds__(NTH, 2) mk_fwd(Args a) {
    extern __shared__ __attribute__((aligned(16))) unsigned char lds_raw[];
    Ctx C;
    C.lds = (LAS unsigned char*)lds_raw;
    C.tid = threadIdx.x; C.lane = C.tid & 63; C.wave = __builtin_amdgcn_readfirstlane(C.tid >> 6); C.bid = blockIdx.x; C.G = gridDim.x;
    C.x = a.in[0]; C.c = a.in[1]; C.norm_w = a.in[2]; C.w_ada = a.in[3]; C.b_ada = a.in[4]; C.w_in = a.in[5]; C.qnw = a.in[6]; C.knw = a.in[7];
    C.w_pool = a.in[8]; C.pool_scale = a.in[9]; C.w_out = a.in[10]; C.out = a.out;
    unsigned char* ws = a.ws;
    C.mod = (float*)(ws + WS_MOD); C.rope = (float2*)(ws + WS_ROPE); C.WinT = (u16*)(ws + WS_WINT); C.WoutT = (u16*)(ws + WS_WOUTT); C.XN = (u16*)(ws + WS_XN);
    C.U = (u16*)(ws + WS_U); C.SG = (u16*)(ws + WS_SG); C.Q = (u16*)(ws + WS_Q); C.GA = (u16*)(ws + WS_GA); C.QI = (u16*)(ws + WS_QI);
    C.K = (u16*)(ws + WS_K); C.V = (u16*)(ws + WS_V); C.KI = (u16*)(ws + WS_KI); C.WI = (float*)(ws + WS_WI); C.MASK = (unsigned*)(ws + WS_MASK); C.MIX = (u16*)(ws + WS_MIX);
    volatile LAS unsigned* MISC = (volatile LAS unsigned*)(C.lds + MISC_OFF);
    for (int u = C.tid; u < (LDS_BYTES - LDSCTL_OFF) / 4; u += NTH) ((LAS unsigned*)(C.lds + LDSCTL_OFF))[u] = 0u;
    __syncthreads();
    XcdBarrier bar = xcd_barrier_post((unsigned*)(ws + WS_CTL) + CW_BAR, MISC + 8);

    phase0(C);
    xcd_barrier(bar);
    phase0b(C);
    xcd_barrier(bar);
    {
        pg8::Gemm g{C.XN, C.WinT, MT, NPAD, DM}; pg8::StaticOrder S; S.init(MT, NPAD, C.G, C.bid);
        EpiP1 E{C.U, C.SG, C.Q, C.GA, C.QI, C.K, C.V, C.KI, C.WI, C.qnw, C.knw, C.rope};
        pg8::gemm_phase<EpiP1, pg8::StaticOrder, true, true>(C.lds, g, S, E);
    }
    xcd_barrier(bar);
    stageA_phase(C);
    for (int u = C.bid; u < 1024; u += C.G) pool_unit_naive(C, u);
    xcd_barrier(bar);
    for (int t = C.bid; t < MT; t += C.G) selattn_row_naive(C, t);
    xcd_barrier(bar);
    {
        pg8::Gemm g{C.MIX, C.WoutT, MT, DM, DM}; pg8::StaticOrder S; S.init(MT, DM, C.G, C.bid);
        EpiOut E{C.x, C.mod + 2048, C.out};
        pg8::gemm_phase<EpiOut, pg8::StaticOrder, true, true>(C.lds, g, S, E);
    }
}

extern "C" void kernel_launch(void* const* d_in, const int* in_sizes, int n_in, void* d_out, int out_size, void* d_ws, size_t ws_size, hipStream_t stream) {
    (void)in_sizes; (void)out_size;
    static int grid = 0;
    if (grid == 0) {
        if (n_in != 11 || ws_size < WS_END) { fprintf(stderr, "kernel_launch: unexpected inputs / workspace (%d, %zu)\n", n_in, ws_size); grid = -1; return; }
        int dev = 0, cus = 0, per_cu = 0;
        hipGetDevice(&dev); hipDeviceGetAttribute(&cus, hipDeviceAttributeMultiprocessorCount, dev);
        hipFuncSetAttribute((const void*)mk_fwd, hipFuncAttributeMaxDynamicSharedMemorySize, LDS_BYTES);
        hipOccupancyMaxActiveBlocksPerMultiprocessor(&per_cu, (const void*)mk_fwd, NTH, LDS_BYTES);
        (void)hipGetLastError();
        if (per_cu < 1) { fprintf(stderr, "kernel_launch: occupancy query says %d blocks per CU\n", per_cu); per_cu = 1; }
        grid = cus;
    }
    if (grid < 0) return;
    hipMemsetAsync((char*)d_ws + WS_CTL, 0, CTL_ZERO_BYTES, stream);
    Args a{};
    for (int i = 0; i < 11; ++i) a.in[i] = (const float*)d_in[i];
    a.out = (float*)d_out; a.ws = (unsigned char*)d_ws;
    void* kargs[] = {&a};
    hipError_t e = hipLaunchCooperativeKernel((const void*)mk_fwd, dim3(grid), dim3(NTH), kargs, LDS_BYTES, stream);
    if (e != hipSuccess) fprintf(stderr, "kernel_launch: cooperative launch failed: %s (grid %d)\n", hipGetErrorString(e), grid);
}
```

```cpp
#include <hip/hip_runtime.h>
#include <stdint.h>
#include <cstdio>

typedef unsigned short u16;
typedef _Float16 h16x8 __attribute__((ext_vector_type(8)));
typedef float f32x16 __attribute__((ext_vector_type(16)));
typedef float f32x4 __attribute__((ext_vector_type(4)));
typedef unsigned v4u __attribute__((ext_vector_type(4)));
#define LAS __attribute__((address_space(3)))
#define GAS __attribute__((address_space(1)))

constexpr int NB = 8, SEQ = 2048, DM = 1024, MT = NB * SEQ;
constexpr int NPROJ = 2888, NPAD = 3072;
constexpr int NTH = 512, NWAVES = 8;
constexpr float QSCALE = 0.18033688011112042f;
constexpr float EPS = 1e-6f;

constexpr size_t WS_CTL = 0, CTL_ZERO_BYTES = 65536;
constexpr size_t WS_MOD = 65536;
constexpr size_t WS_ROPE = WS_MOD + (size_t)NB * 3072 * 4;
constexpr size_t WS_WINT = WS_ROPE + (size_t)SEQ * 32 * 8;
constexpr size_t WS_WOUTT = WS_WINT + (size_t)NPAD * DM * 2;
constexpr size_t WS_XN = WS_WOUTT + (size_t)DM * DM * 2;
constexpr size_t WS_U = WS_XN + (size_t)MT * DM * 2;
constexpr size_t WS_SG = WS_U + (size_t)MT * 512 * 2;
constexpr size_t WS_Q = WS_SG + (size_t)MT * 512 * 2;
constexpr size_t WS_GA = WS_Q + (size_t)MT * 512 * 2;
constexpr size_t WS_QI = WS_GA + (size_t)MT * 512 * 2;
constexpr size_t WS_K = WS_QI + (size_t)MT * 512 * 2;
constexpr size_t WS_V = WS_K + (size_t)MT * 128 * 2;
constexpr size_t WS_KI = WS_V + (size_t)MT * 128 * 2;
constexpr size_t WS_WI = WS_KI + (size_t)MT * 64 * 2;
constexpr size_t WS_MASK = WS_WI + (size_t)MT * 8 * 4;
constexpr size_t WS_MIX = WS_MASK + (size_t)MT * 64 * 4;
constexpr size_t WS_END = WS_MIX + (size_t)MT * DM * 2;
constexpr int CW_BAR = 1024;

constexpr int RING_BYTES = 131072;
constexpr int LDSCTL_OFF = RING_BYTES, MISC_OFF = LDSCTL_OFF + 320;
constexpr int LDS_BYTES = 147456;

__device__ __forceinline__ u16 f2h(float f) { return __builtin_bit_cast(u16, (_Float16)f); }
__device__ __forceinline__ float h2f(u16 h) { return (float)__builtin_bit_cast(_Float16, h); }
__device__ __forceinline__ float silu_f(float v) { return v / (1.f + __expf(-v)); }
__device__ __forceinline__ float wave_sum(float v) {
#pragma unroll
    for (int o = 1; o < 64; o <<= 1) v += __shfl_xor(v, o);
    return v;
}

__constant__ double ROPE_FREQ[32] = {1.0,0.7498942093324559,0.5623413251903491,0.4216965034285822,0.31622776601683794,0.23713737056616552,0.1778279410038923,0.1333521432163324,0.1,0.07498942093324558,0.05623413251903491,0.042169650342858224,0.03162277660168379,0.023713737056616554,0.01778279410038923,0.01333521432163324,0.01,0.007498942093324558,0.005623413251903491,0.004216965034285823,0.0031622776601683794,0.0023713737056616554,0.0017782794100389228,0.001333521432163324,0.001,0.0007498942093324559,0.0005623413251903491,0.00042169650342858224,0.00031622776601683794,0.00023713737056616554,0.00017782794100389227,0.0001333521432163324};

#define XB_TMO      128
#define XB_XCNT(j)  (256  + 64 * (j))
#define XB_XSUB(j)  (1280 + 64 * (j))
#define XB_XGEN(j)  (2304 + 64 * (j))
#define XB_TOP      3328
#define XB_TOPGEN   3392
#define XCD_BAR_WORDS 3456
#define XB_SPIN_CAP (1u << 18)

__device__ __forceinline__ unsigned xb_ld(unsigned* p)              { return __hip_atomic_load(p, __ATOMIC_RELAXED, __HIP_MEMORY_SCOPE_AGENT); }
__device__ __forceinline__ unsigned xb_add(unsigned* p, unsigned v) { return __hip_atomic_fetch_add(p, v, __ATOMIC_RELAXED, __HIP_MEMORY_SCOPE_AGENT); }
__device__ __forceinline__ unsigned xb_xcc_id() { return (unsigned)__builtin_amdgcn_s_getreg((3 << 11) | 20) & 0xFu; }
#define XB_SPIN(cond, bar) do { unsigned _sp = 0; while (cond) { __builtin_amdgcn_s_sleep(1); \
    if ((++_sp & 255u) == 0u) { if (xb_ld(&(bar)[XB_TMO])) break; if (_sp > XB_SPIN_CAP) { atomicAdd(&(bar)[XB_TMO], 1u); break; } } } } while (0)

struct XcdBarrier {
    unsigned* bar; unsigned x;
    volatile LAS unsigned* st;
};

__device__ __forceinline__ XcdBarrier xcd_barrier_post(unsigned* bar, volatile LAS unsigned* st) {
    XcdBarrier b; b.bar = bar; b.x = xb_xcc_id(); b.st = st;
    if (threadIdx.x == 0) (void)xb_add(&bar[XB_XCNT(b.x)], 1u);
    return b;
}
__device__ __forceinline__ void xcd_barrier_complete(unsigned* bar, unsigned x, unsigned& nloc, unsigned& nx) {
    const unsigned G = gridDim.x * gridDim.y * gridDim.z;
    unsigned sum, cnt, mine, sp = 0u;
    for (;;) {
        sum = 0u; cnt = 0u; mine = 0u;
#pragma unroll
        for (unsigned j = 0; j < 16; ++j) { const unsigned c = xb_ld(&bar[XB_XCNT(j)]); sum += c; cnt += (c > 0u) ? 1u : 0u; mine = (j == x) ? c : mine; }
        if (sum == G) break;
        __builtin_amdgcn_s_sleep(1);
        if ((++sp & 255u) == 0u) { if (xb_ld(&bar[XB_TMO])) break; if (sp > XB_SPIN_CAP) { atomicAdd(&bar[XB_TMO], 1u); break; } }
    }
    nloc = mine > 0u ? mine : 1u; nx = cnt > 0u ? cnt : 1u;
}

__device__ __forceinline__ void xcd_barrier(const XcdBarrier& b) {
    asm volatile("s_waitcnt vmcnt(0)" ::: "memory");
    __syncthreads();
    if (threadIdx.x == 0) {
        unsigned* bar = b.bar;
        __builtin_amdgcn_s_waitcnt(0);
        unsigned nloc = b.st[0], nx = b.st[1];
        if (nloc == 0u) { xcd_barrier_complete(bar, b.x, nloc, nx); b.st[0] = nloc; b.st[1] = nx; }
        const unsigned old = xb_add(&bar[XB_XSUB(b.x)], 1u);
        const unsigned gen = old / nloc;
        if (old + 1u == (gen + 1u) * nloc) {
            __builtin_amdgcn_fence(__ATOMIC_RELEASE, "agent");
            asm volatile("s_waitcnt vmcnt(0)" ::: "memory");
            const unsigned og = xb_add(&bar[XB_TOP], 1u);
            const unsigned tg = og / nx;
            if (og + 1u == (tg + 1u) * nx) xb_add(&bar[XB_TOPGEN], 1u);
            else XB_SPIN(xb_ld(&bar[XB_TOPGEN]) == tg, bar);
            __builtin_amdgcn_fence(__ATOMIC_ACQUIRE, "agent");
            xb_add(&bar[XB_XGEN(b.x)], 1u);
            asm volatile("s_waitcnt vmcnt(0)" ::: "memory");
        } else {
            XB_SPIN(xb_ld(&bar[XB_XGEN(b.x)]) == gen, bar);
            __builtin_amdgcn_fence(__ATOMIC_ACQUIRE, "agent");
            asm volatile("s_waitcnt vmcnt(0)" ::: "memory");
        }
    }
    __syncthreads();
}


struct Ctx {
    const float *x, *c, *norm_w, *w_ada, *b_ada, *w_in, *qnw, *knw, *w_pool, *pool_scale, *w_out;
    float* out;
    float* mod; float2* rope; u16 *WinT, *WoutT, *XN, *U, *SG, *Q, *GA, *QI, *K, *V, *KI, *VT; float* WI; unsigned* MASK; u16* MIX;
    LAS unsigned char* lds;
    int tid, lane, wave, bid, G;
};

__device__ __forceinline__ void p0_mod_unit(const Ctx& C, int u) {
    LAS float* sc = (LAS float*)C.lds;
    const int b = u / 6, e = (u % 6) * 512 + C.tid;
    __syncthreads();
    for (int i = C.tid; i < DM; i += NTH) sc[i] = silu_f(C.c[b * DM + i]);
    __syncthreads();
    float acc = C.b_ada[e];
    for (int d = 0; d < DM; ++d) acc += sc[d] * C.w_ada[(size_t)d * 3072 + e];
    C.mod[b * 3072 + e] = acc;
}
__device__ __forceinline__ void p0_rope_unit(const Ctx& C, int u) {
    const int idx = u * NTH + C.tid, pos = idx >> 5, i = idx & 31;
    const double ang = (double)pos * ROPE_FREQ[i];
    double t = ang * 0.15915494309189533576888;
    t -= floor(t + 0.5);
    const double x = t * 6.283185307179586476925287, x2 = x * x;
    double s = 0.0, cc = 0.0, ts = x, tc = 1.0;
#pragma unroll 1
    for (int n = 0; n < 14; ++n) { cc += tc; s += ts; tc *= -x2 / (double)((2 * n + 1) * (2 * n + 2)); ts *= -x2 / (double)((2 * n + 2) * (2 * n + 3)); }
    C.rope[idx] = make_float2((float)cc, (float)s);
}
__device__ __forceinline__ void p0_conv_unit(const Ctx& C, const float* W, int N, u16* WT, int u, bool perm) {
    LAS float* tl = (LAS float*)C.lds;
    const int nb = u >> 4, kb = u & 15, k0 = kb * 64, n0 = nb * 64;
    __syncthreads();
#pragma unroll
    for (int i = 0; i < 8; ++i) { const int kk = (C.tid >> 6) + 8 * i, nn = C.tid & 63, n = n0 + nn;
        tl[kk * 65 + nn] = n < N ? W[(size_t)(k0 + kk) * N + n] : 0.f; }
    __syncthreads();
    const int nn = C.tid >> 3, kc = (C.tid & 7) * 8;
    v4u o;
    o.x = (unsigned)f2h(tl[(kc + 0) * 65 + nn]) | ((unsigned)f2h(tl[(kc + 1) * 65 + nn]) << 16);
    o.y = (unsigned)f2h(tl[(kc + 2) * 65 + nn]) | ((unsigned)f2h(tl[(kc + 3) * 65 + nn]) << 16);
    o.z = (unsigned)f2h(tl[(kc + 4) * 65 + nn]) | ((unsigned)f2h(tl[(kc + 5) * 65 + nn]) << 16);
    o.w = (unsigned)f2h(tl[(kc + 6) * 65 + nn]) | ((unsigned)f2h(tl[(kc + 7) * 65 + nn]) << 16);
    const int nl = n0 + nn, np = perm ? ((nl & ~255) | (((nl >> 5) & 1) << 7) | (((nl >> 6) & 3) << 5) | (nl & 31)) : nl;
    *(v4u*)(WT + (size_t)np * DM + k0 + kc) = o;
}
__device__ __forceinline__ void phase0(const Ctx& C) {
    constexpr int U_MOD = 48, U_ROPE = 128, U_WIN = 48 * 16, U_WOUT = 16 * 16, U_ALL = U_MOD + U_ROPE + U_WIN + U_WOUT;
    for (int u = C.bid; u < U_ALL; u += C.G) {
        int r = u;
        if (r < U_MOD) { p0_mod_unit(C, r); continue; } r -= U_MOD;
        if (r < U_ROPE) { p0_rope_unit(C, r); continue; } r -= U_ROPE;
        if (r < U_WIN) { p0_conv_unit(C, C.w_in, NPROJ, C.WinT, r, true); continue; } r -= U_WIN;
        p0_conv_unit(C, C.w_out, DM, C.WoutT, r, false);
    }
}

__device__ __forceinline__ void phase0b(const Ctx& C) {
    for (int row = C.bid * NWAVES + C.wave; row < MT; row += C.G * NWAVES) {
        const int lane = C.lane, b = row >> 11;
        const float4* xr = (const float4*)(C.x + (size_t)row * DM) + lane;
        float4 v[4]; float s = 0.f;
#pragma unroll
        for (int j = 0; j < 4; ++j) { v[j] = xr[64 * j]; s += v[j].x * v[j].x + v[j].y * v[j].y + v[j].z * v[j].z + v[j].w * v[j].w; }
        const float rstd = rsqrtf(wave_sum(s) * (1.f / DM) + EPS);
        const float* shift = C.mod + b * 3072; const float* scale = shift + 1024;
#pragma unroll
        for (int j = 0; j < 4; ++j) {
            const int k = 4 * lane + 256 * j;
            const float4 w4 = *(const float4*)(C.norm_w + k), s4 = *(const float4*)(scale + k), h4 = *(const float4*)(shift + k);
            const float o0 = v[j].x * rstd * w4.x * (1.f + s4.x) + h4.x, o1 = v[j].y * rstd * w4.y * (1.f + s4.y) + h4.y;
            const float o2 = v[j].z * rstd * w4.z * (1.f + s4.z) + h4.z, o3 = v[j].w * rstd * w4.w * (1.f + s4.w) + h4.w;
            ushort4 o; o.x = f2h(o0); o.y = f2h(o1); o.z = f2h(o2); o.w = f2h(o3);
            *(ushort4*)(C.XN + (size_t)row * DM + k) = o;
        }
    }
}


namespace pg8 {
#define PG8_LAS __attribute__((address_space(3)))
typedef unsigned short bf16_t;
typedef _Float16 bf16x8 __attribute__((ext_vector_type(8)));
typedef float f32x4 __attribute__((ext_vector_type(4)));
typedef unsigned u32x4 __attribute__((ext_vector_type(4)));
constexpr int BM = 256, BK = 64, HALF = 128, HTB = HALF * BK * 2  , STAGE_BYTES = 8 * HTB, NXCD = 8, WGM = 8;

__host__ __device__ __forceinline__ int lds_byte(int r, int c) { const int st = (r >> 4) * 2 + (c >> 5), rr = r & 15, cc = c & 31, ob = rr * 64 + cc * 2; return st * 1024 + (ob ^ (((ob >> 9) & 1) << 5)); }
__host__ __device__ __forceinline__ void stage_rc(int b, int& R, int& C) { const int st = b / 1024, sb = b % 1024, swz = sb ^ (((sb >> 9) & 1) << 5); R = (st >> 1) * 16 + swz / 64; C = (st & 1) * 32 + (swz % 64) / 2; }
__host__ __device__ __forceinline__ int perm32(int rho) { const int n = rho >> 4, i = rho & 15; return 8 * (i >> 2) + 4 * n + (i & 3); }

struct Unit { int pm, pn; };
struct Gemm { const bf16_t* A; const bf16_t* Bt; int M, N, K; };

struct StaticOrder {
    int nM, nN, nwg, G, c;
    __host__ __device__ void init(int M, int N, int G_, int c_) { nM = M / BM; nN = N / BM; nwg = nM * nN; G = G_; c = c_; }
    __host__ __device__ bool next(int i, Unit& u) const {
        const long L = (long)i * G + c; if (L >= nwg) return false;
        int wgid = (int)L; { const int q = nwg / NXCD, r = nwg % NXCD, xcd = wgid % NXCD, off = wgid / NXCD; wgid = (xcd < r ? xcd * (q + 1) : r * (q + 1) + (xcd - r) * q) + off; }
        const int nig = WGM * nN, gid = wgid / nig, fm = gid * WGM, gsz = (nM - fm) < WGM ? (nM - fm) : WGM;
        u.pm = fm + ((wgid % nig) % gsz); u.pn = (wgid % nig) / gsz; return true;
    }
    __device__ __forceinline__ void a_ready(const Unit&) const {}
    __device__ __forceinline__ void done(const Unit&) const {}
};

template <class Epi, class Sched, bool ALIGN_EPI = false, bool SP2 = false>
__device__ __forceinline__ void gemm_phase(PG8_LAS unsigned char* lds, const Gemm g, const Sched& S, const Epi& E) {
    const int tid = threadIdx.x, wid = __builtin_amdgcn_readfirstlane(tid >> 6), lane = tid & 63, wr = wid >> 2, wc = wid & 3, fr = lane & 15, fq = lane >> 4;
    const int K = g.K, nt = K / BK;
    unsigned voffA[2], voffB[2];
#pragma unroll
    for (int i = 0; i < 2; ++i) { int R, C; stage_rc(tid * 16 + i * 8192, R, C); const int Rb = Epi::PERM ? ((R & ~31) + perm32(R & 31)) : R;
        voffA[i] = (unsigned)(R * K + C) * 2u; voffB[i] = (unsigned)(Rb * K + C) * 2u; }
    const size_t kstep = (size_t)(BK * 2);
    const size_t hstep = (size_t)HALF * K * 2;
    const size_t tstep = 2 * hstep;
    const unsigned ldsw = (unsigned)wid * 1024u;
    const int aoff = lds_byte(wr * 64 + fr, fq * 8), boff = lds_byte(wc * 32 + fr, fq * 8);
#define PG8_SA(b, h) (((b) * 2 + (h)) * HTB)
#define PG8_SB(b, h) ((4 + (b) * 2 + (h)) * HTB)
#define PG8_STAGE(bufoff, gbase, voff) do { _Pragma("unroll") for (int _i = 0; _i < 2; ++_i) \
        __builtin_amdgcn_global_load_lds((const unsigned*)((const char*)(gbase) + (voff)[_i]), (PG8_LAS unsigned*)(lds + (bufoff) + ldsw + _i * 8192), 16, 0, 0); } while (0)
#define PG8_LDA(dst, b, h) do { _Pragma("unroll") for (int m = 0; m < 4; ++m) _Pragma("unroll") for (int k = 0; k < 2; ++k) dst[m][k] = *(const PG8_LAS bf16x8*)(lds + PG8_SA(b, h) + aoff + m * 2048 + k * 1024); } while (0)
#define PG8_LDB(dst, b, h) do { _Pragma("unroll") for (int n = 0; n < 2; ++n) _Pragma("unroll") for (int k = 0; k < 2; ++k) dst[n][k] = *(const PG8_LAS bf16x8*)(lds + PG8_SB(b, h) + boff + n * 2048 + k * 1024); } while (0)
#define PG8_MMA(ai, bj, At, Bt) do { __builtin_amdgcn_s_setprio(1); _Pragma("unroll") for (int m = 0; m < 4; ++m) _Pragma("unroll") for (int n = 0; n < 2; ++n) _Pragma("unroll") for (int k = 0; k < 2; ++k) \
        acc[ai][bj][m][n] = __builtin_amdgcn_mfma_f32_16x16x32_f16(Bt[n][k], At[m][k], acc[ai][bj][m][n], 0, 0, 0); __builtin_amdgcn_s_setprio(0); } while (0)
#define PG8_WAIT_V(n) asm volatile("s_waitcnt vmcnt(" #n ")" ::: "memory")
#define PG8_WAIT_L(n) asm volatile("s_waitcnt lgkmcnt(" #n ")" ::: "memory")
#define PG8_BAR __builtin_amdgcn_s_barrier()
#define PG8_SCHED __builtin_amdgcn_sched_barrier(0)
    Unit cur, nxt; int ui = 0;
    if (!S.next(0, cur)) return;
    f32x4 acc[2][2][4][2];
#pragma unroll
    for (int a = 0; a < 2; ++a)
#pragma unroll
        for (int b = 0; b < 2; ++b)
#pragma unroll
            for (int m = 0; m < 4; ++m)
#pragma unroll
                for (int n = 0; n < 2; ++n) acc[a][b][m][n] = (f32x4){0.f, 0.f, 0.f, 0.f};
    bf16x8 At[4][2], B0[2][2], B1[2][2];
    const char* cA = (const char*)g.A + (size_t)cur.pm * tstep; const char* cB = (const char*)g.Bt + (size_t)cur.pn * tstep;
    S.a_ready(cur);
    if constexpr (SP2) {
        PG8_STAGE(PG8_SB(0, 0), cB, voffB); PG8_STAGE(PG8_SB(0, 1), cB + hstep, voffB); PG8_STAGE(PG8_SA(0, 0), cA, voffA); PG8_STAGE(PG8_SA(0, 1), cA + hstep, voffA);
        if (wr == 1) PG8_BAR;
        PG8_WAIT_V(2); PG8_BAR;
        PG8_STAGE(PG8_SB(1, 0), cB + kstep, voffB); PG8_STAGE(PG8_SA(1, 0), cA + kstep, voffA); PG8_STAGE(PG8_SB(1, 1), cB + hstep + kstep, voffB);
        PG8_WAIT_V(6); PG8_BAR;
    } else {
        PG8_STAGE(PG8_SB(0, 0), cB, voffB); PG8_STAGE(PG8_SA(0, 0), cA, voffA); PG8_STAGE(PG8_SB(0, 1), cB + hstep, voffB); PG8_STAGE(PG8_SA(0, 1), cA + hstep, voffA);
        if (wr == 1) PG8_BAR;
        PG8_WAIT_V(4); PG8_BAR;
        PG8_STAGE(PG8_SB(1, 0), cB + kstep, voffB); PG8_STAGE(PG8_SA(1, 0), cA + kstep, voffA); PG8_STAGE(PG8_SB(1, 1), cB + hstep + kstep, voffB);
        PG8_WAIT_V(6); PG8_BAR;
    }
    for (;;) {
        const bool has_next = S.next(ui + 1, nxt);
        const char* nA = has_next ? (const char*)g.A + (size_t)nxt.pm * tstep : cA; const char* nB = has_next ? (const char*)g.Bt + (size_t)nxt.pn * tstep : cB;
        for (int t = 0; t < nt; t += 2) {
            const bool last = (t == nt - 2);
            const char* a1 = cA + (size_t)(t + 1) * kstep;
            const char* a2 = last ? nA : cA + (size_t)(t + 2) * kstep; const char* b2 = last ? nB : cB + (size_t)(t + 2) * kstep;
            const char* a3 = a2 + kstep; const char* b3 = b2 + kstep;
            if (last && has_next) S.a_ready(nxt);
            if constexpr (SP2) {
            PG8_LDB(B0, 0, 0); PG8_LDB(B1, 0, 1); PG8_SCHED; PG8_LDA(At, 0, 0); PG8_STAGE(PG8_SA(1, 1), a1 + hstep, voffA);
            PG8_WAIT_V(8); PG8_WAIT_L(0); PG8_BAR; PG8_MMA(0, 0, At, B0); PG8_MMA(0, 1, At, B1); PG8_BAR; PG8_SCHED;
            PG8_LDA(At, 0, 1); PG8_STAGE(PG8_SB(0, 0), b2, voffB); PG8_STAGE(PG8_SB(0, 1), b2 + hstep, voffB); PG8_STAGE(PG8_SA(0, 0), a2, voffA);
            PG8_WAIT_V(8); PG8_WAIT_L(0); PG8_BAR; PG8_MMA(1, 0, At, B0); PG8_MMA(1, 1, At, B1); PG8_BAR; PG8_SCHED;
            PG8_LDB(B0, 1, 0); PG8_LDB(B1, 1, 1); PG8_SCHED; PG8_LDA(At, 1, 0); PG8_STAGE(PG8_SA(0, 1), a2 + hstep, voffA);
            PG8_WAIT_V(8); PG8_WAIT_L(0); PG8_BAR; PG8_MMA(0, 0, At, B0); PG8_MMA(0, 1, At, B1); PG8_BAR; PG8_SCHED;
            PG8_LDA(At, 1, 1); PG8_STAGE(PG8_SB(1, 0), b3, voffB); PG8_STAGE(PG8_SB(1, 1), b3 + hstep, voffB); PG8_STAGE(PG8_SA(1, 0), a3, voffA);
            PG8_WAIT_V(8); PG8_WAIT_L(0); PG8_BAR; PG8_MMA(1, 0, At, B0); PG8_MMA(1, 1, At, B1); PG8_BAR; PG8_SCHED;
            } else {
            PG8_LDB(B0, 0, 0); PG8_SCHED; PG8_LDA(At, 0, 0); PG8_STAGE(PG8_SA(1, 1), a1 + hstep, voffA);
            PG8_WAIT_L(8); PG8_BAR; PG8_WAIT_L(0); PG8_MMA(0, 0, At, B0); PG8_BAR; PG8_SCHED;
            PG8_LDB(B1, 0, 1); PG8_STAGE(PG8_SB(0, 0), b2, voffB);
            PG8_BAR; PG8_WAIT_L(0); PG8_MMA(0, 1, At, B1); PG8_BAR;
            PG8_LDA(At, 0, 1); PG8_STAGE(PG8_SA(0, 0), a2, voffA);
            PG8_BAR; PG8_WAIT_L(0); PG8_MMA(1, 0, At, B0); PG8_BAR; PG8_SCHED;
            PG8_STAGE(PG8_SB(0, 1), b2 + hstep, voffB);
            PG8_WAIT_V(6); PG8_BAR; PG8_MMA(1, 1, At, B1); PG8_BAR;
            PG8_LDB(B0, 1, 0); PG8_SCHED; PG8_LDA(At, 1, 0); PG8_STAGE(PG8_SA(0, 1), a2 + hstep, voffA);
            PG8_WAIT_L(8); PG8_BAR; PG8_WAIT_L(0); PG8_MMA(0, 0, At, B0); PG8_BAR; PG8_SCHED;
            PG8_LDB(B1, 1, 1); PG8_STAGE(PG8_SB(1, 0), b3, voffB);
            PG8_BAR; PG8_WAIT_L(0); PG8_MMA(0, 1, At, B1); PG8_BAR;
            PG8_LDA(At, 1, 1); PG8_STAGE(PG8_SA(1, 0), a3, voffA);
            PG8_BAR; PG8_WAIT_L(0); PG8_MMA(1, 0, At, B0); PG8_BAR; PG8_SCHED;
            PG8_STAGE(PG8_SB(1, 1), b3 + hstep, voffB);
            PG8_WAIT_V(6); PG8_BAR; PG8_MMA(1, 1, At, B1); PG8_BAR;
            }
        }
        if constexpr (ALIGN_EPI) { if (wr == 0) PG8_BAR; }
        if constexpr (!Epi::AFTER_DRAIN) { E(acc, cur, wr, wc, fr, fq); S.done(cur); }
        if (!has_next) break;
#pragma unroll
        for (int a = 0; a < 2; ++a)
#pragma unroll
            for (int b = 0; b < 2; ++b)
#pragma unroll
                for (int m = 0; m < 4; ++m)
#pragma unroll
                    for (int n = 0; n < 2; ++n) acc[a][b][m][n] = (f32x4){0.f, 0.f, 0.f, 0.f};
        cur = nxt; cA = nA; cB = nB; ++ui;
        if constexpr (ALIGN_EPI) { if (wr == 1) PG8_BAR; }
    }
    PG8_WAIT_V(0);
    if constexpr (!ALIGN_EPI) { if (wr == 0) PG8_BAR; }
    PG8_BAR;
    if constexpr (Epi::AFTER_DRAIN) { E.fused(acc, cur, wr, wc, fr, fq, lds, wid, lane); S.done(cur); }
#undef PG8_SA
#undef PG8_SB
#undef PG8_STAGE
#undef PG8_LDA
#undef PG8_LDB
#undef PG8_MMA
#undef PG8_WAIT_V
#undef PG8_WAIT_L
#undef PG8_BAR
#undef PG8_SCHED
}
}


__device__ __forceinline__ unsigned pk2h(float lo, float hi) { typedef _Float16 h2 __attribute__((ext_vector_type(2))); h2 v; v.x = (_Float16)lo; v.y = (_Float16)hi; return __builtin_bit_cast(unsigned, v); }

struct EpiP1 {
    static constexpr bool PERM = true, AFTER_DRAIN = false;
    u16 *U, *SG, *Q, *GA, *QI, *K, *V, *KI; float* WI; const float *qnw, *knw; const float2* rope;
    __device__ __forceinline__ void operator()(const f32x4 (&acc)[2][2][4][2], const pg8::Unit& u, int wr, int wc, int fr, int fq) const {
        const int g = u.pn * 4 + wc;
        if (g > 45) return;
        int mode, ld; u16* dst; const float* nwp = qnw; float osc = 1.f;
        if (g < 8) { mode = 0; dst = U + g * 64; ld = 512; }
        else if (g < 16) { mode = 1; dst = SG + (g - 8) * 64; ld = 512; }
        else if (g < 24) { mode = 2; dst = Q + (g - 16) * 64; ld = 512; osc = QSCALE; }
        else if (g < 26) { mode = 2; dst = K + (g - 24) * 64; ld = 128; nwp = knw; }
        else if (g < 28) { mode = 5; dst = V; ld = 128; }
        else if (g < 36) { mode = 1; dst = GA + (g - 28) * 64; ld = 512; }
        else if (g < 44) { mode = 3; dst = QI + (g - 36) * 64; ld = 512; }
        else if (g == 44) { mode = 3; dst = KI; ld = 64; }
        else { mode = 4; dst = KI; ld = 64; }
        const int row0 = u.pm * 256 + wr * 64 + fr;
        if (mode == 5) {
            const int kvh = g - 26;
#pragma unroll
            for (int ai = 0; ai < 2; ++ai)
#pragma unroll
                for (int m = 0; m < 4; ++m) {
                    const int t = row0 + ai * 128 + m * 16, bb = t >> 11, pos = t & (SEQ - 1), pp = (pos & ~12) | ((pos & 4) << 1) | ((pos & 8) >> 1);
                    u16* vp = dst + ((size_t)((bb * 2 + kvh) * 64 + 8 * fq)) * SEQ + pp;
#pragma unroll
                    for (int bj = 0; bj < 2; ++bj)
#pragma unroll
                        for (int n = 0; n < 2; ++n)
#pragma unroll
                            for (int j = 0; j < 4; ++j) vp[(size_t)(32 * bj + 4 * n + j) * SEQ] = f2h(acc[ai][bj][m][n][j]);
                }
            return;
        }
        if (mode == 4) {
            if (fq == 0) {
#pragma unroll
                for (int ai = 0; ai < 2; ++ai)
#pragma unroll
                    for (int m = 0; m < 4; ++m) { float* wp = WI + (size_t)(row0 + ai * 128 + m * 16) * 8; *(f32x4*)wp = acc[ai][0][m][0]; *(f32x4*)(wp + 4) = acc[ai][0][m][1]; }
            }
            return;
        }
        f32x4 nlo0 = {1.f, 1.f, 1.f, 1.f}, nlo1 = nlo0, nhi0 = nlo0, nhi1 = nlo0;
        if (mode == 2) { nlo0 = *(const f32x4*)(nwp + 8 * fq); nlo1 = *(const f32x4*)(nwp + 8 * fq + 4); nhi0 = *(const f32x4*)(nwp + 32 + 8 * fq); nhi1 = *(const f32x4*)(nwp + 36 + 8 * fq); }
#pragma unroll
        for (int ai = 0; ai < 2; ++ai)
#pragma unroll
            for (int m = 0; m < 4; ++m) {
                const int t = row0 + ai * 128 + m * 16;
                f32x4 a0 = acc[ai][0][m][0], a1 = acc[ai][0][m][1], b0 = acc[ai][1][m][0], b1 = acc[ai][1][m][1];
                if (mode == 1) {
#pragma unroll
                    for (int j = 0; j < 4; ++j) { a0[j] = silu_f(a0[j]); a1[j] = silu_f(a1[j]); b0[j] = silu_f(b0[j]); b1[j] = silu_f(b1[j]); }
                } else if (mode >= 2) {
                    if (mode == 2) {
                        float ss = 0.f;
#pragma unroll
                        for (int j = 0; j < 4; ++j) ss += a0[j] * a0[j] + a1[j] * a1[j] + b0[j] * b0[j] + b1[j] * b1[j];
                        ss += __shfl_xor(ss, 16); ss += __shfl_xor(ss, 32);
                        const float rinv = rsqrtf(ss * (1.f / 64.f) + EPS);
                        a0 = a0 * rinv * nlo0; a1 = a1 * rinv * nlo1; b0 = b0 * rinv * nhi0; b1 = b1 * rinv * nhi1;
                    }
                    const f32x4* rp = (const f32x4*)(rope + (size_t)(t & (SEQ - 1)) * 32 + 8 * fq);
                    const f32x4 r0 = rp[0], r1 = rp[1], r2 = rp[2], r3 = rp[3];
                    f32x4 o0, o1, p0, p1;
                    o0[0] = a0[0] * r0[0] - b0[0] * r0[1]; p0[0] = b0[0] * r0[0] + a0[0] * r0[1];
                    o0[1] = a0[1] * r0[2] - b0[1] * r0[3]; p0[1] = b0[1] * r0[2] + a0[1] * r0[3];
                    o0[2] = a0[2] * r1[0] - b0[2] * r1[1]; p0[2] = b0[2] * r1[0] + a0[2] * r1[1];
                    o0[3] = a0[3] * r1[2] - b0[3] * r1[3]; p0[3] = b0[3] * r1[2] + a0[3] * r1[3];
                    o1[0] = a1[0] * r2[0] - b1[0] * r2[1]; p1[0] = b1[0] * r2[0] + a1[0] * r2[1];
                    o1[1] = a1[1] * r2[2] - b1[1] * r2[3]; p1[1] = b1[1] * r2[2] + a1[1] * r2[3];
                    o1[2] = a1[2] * r3[0] - b1[2] * r3[1]; p1[2] = b1[2] * r3[0] + a1[2] * r3[1];
                    o1[3] = a1[3] * r3[2] - b1[3] * r3[3]; p1[3] = b1[3] * r3[2] + a1[3] * r3[3];
                    a0 = o0 * osc; a1 = o1 * osc; b0 = p0 * osc; b1 = p1 * osc;
                }
                u16* dp = dst + (size_t)t * ld + 8 * fq;
                v4u lo, hi; lo.x = pk2h(a0[0], a0[1]); lo.y = pk2h(a0[2], a0[3]); lo.z = pk2h(a1[0], a1[1]); lo.w = pk2h(a1[2], a1[3]);
                hi.x = pk2h(b0[0], b0[1]); hi.y = pk2h(b0[2], b0[3]); hi.z = pk2h(b1[0], b1[1]); hi.w = pk2h(b1[2], b1[3]);
                *(v4u*)dp = lo; *(v4u*)(dp + 32) = hi;
                if (m & 1) asm volatile("" ::: "memory");
            }
    }
};
struct EpiOut {
    static constexpr bool PERM = true, AFTER_DRAIN = false;
    const float* x; const float* gate; float* out;
    __device__ __forceinline__ void operator()(const f32x4 (&acc)[2][2][4][2], const pg8::Unit& u, int wr, int wc, int fr, int fq) const {
        const int row0 = u.pm * 256 + wr * 64 + fr, col0 = u.pn * 256 + wc * 32 + 8 * fq, b = (u.pm * 256) >> 11;
        f32x4 gv[2][2];
#pragma unroll
        for (int bj = 0; bj < 2; ++bj)
#pragma unroll
            for (int n = 0; n < 2; ++n) gv[bj][n] = *(const f32x4*)(gate + b * 3072 + col0 + bj * 128 + 4 * n);
#pragma unroll
        for (int ai = 0; ai < 2; ++ai)
#pragma unroll
            for (int m = 0; m < 4; ++m) {
                const size_t off = (size_t)(row0 + ai * 128 + m * 16) * DM + col0;
#pragma unroll
                for (int bj = 0; bj < 2; ++bj)
#pragma unroll
                    for (int n = 0; n < 2; ++n) { const f32x4 xv = *(const f32x4*)(x + off + bj * 128 + 4 * n); *(f32x4*)(out + off + bj * 128 + 4 * n) = xv + gv[bj][n] * acc[ai][bj][m][n]; }
                if (m & 1) asm volatile("" ::: "memory");
            }
    }
};

__device__ __forceinline__ void p1_epilogue_row(const Ctx& C, int g, int t, int sub, const LAS float* tr) {
    const int pos = t & (SEQ - 1);
    if (g < 8) {
        for (int c = 16 * sub; c < 16 * sub + 16; ++c) C.U[(size_t)t * 512 + g * 64 + c] = f2h(tr[c]);
    } else if (g < 16) {
        for (int c = 16 * sub; c < 16 * sub + 16; ++c) C.SG[(size_t)t * 512 + (g - 8) * 64 + c] = f2h(silu_f(tr[c]));
    } else if (g < 26) {
        float ss = 0.f;
        for (int c = 16 * sub; c < 16 * sub + 16; ++c) ss += tr[c] * tr[c];
        ss += __shfl_xor(ss, 1); ss += __shfl_xor(ss, 2);
        const float rinv = rsqrtf(ss * (1.f / 64.f) + EPS);
        const bool isq = g < 24; const float* nwp = isq ? C.qnw : C.knw; const float osc = isq ? QSCALE : 1.f;
        u16* dst = isq ? C.Q + (size_t)t * 512 + (g - 16) * 64 : C.K + (size_t)t * 128 + (g - 24) * 64;
        for (int i = 8 * sub; i < 8 * sub + 8; ++i) {
            const float x1 = tr[i] * rinv * nwp[i], x2 = tr[i + 32] * rinv * nwp[i + 32];
            const float2 cs = C.rope[pos * 32 + i];
            dst[i] = f2h((x1 * cs.x - x2 * cs.y) * osc); dst[i + 32] = f2h((x2 * cs.x + x1 * cs.y) * osc);
        }
    } else if (g < 28) {
        for (int c = 16 * sub; c < 16 * sub + 16; ++c) C.V[(size_t)t * 128 + (g - 26) * 64 + c] = f2h(tr[c]);
    } else if (g < 36) {
        for (int c = 16 * sub; c < 16 * sub + 16; ++c) C.GA[(size_t)t * 512 + (g - 28) * 64 + c] = f2h(silu_f(tr[c]));
    } else if (g < 45) {
        u16* dst = g < 44 ? C.QI + (size_t)t * 512 + (g - 36) * 64 : C.KI + (size_t)t * 64;
        for (int i = 8 * sub; i < 8 * sub + 8; ++i) {
            const float x1 = tr[i], x2 = tr[i + 32];
            const float2 cs = C.rope[pos * 32 + i];
            dst[i] = f2h(x1 * cs.x - x2 * cs.y); dst[i + 32] = f2h(x2 * cs.x + x1 * cs.y);
        }
    } else {
        if (sub == 0) for (int c = 0; c < 8; ++c) C.WI[(size_t)t * 8 + c] = tr[c];
    }
}
__device__ __forceinline__ void phase1_naive(const Ctx& C) {
    LAS float* tile = (LAS float*)C.lds;
    for (int u = C.bid; u < 46 * 128; u += C.G) {
        const int g = u % 46, r0 = (u / 46) * 128, w = C.wave, lane = C.lane, wr = w & 3, wcn = w >> 2;
        const u16* ap = C.XN + (size_t)(r0 + wr * 32 + (lane & 31)) * DM + 8 * (lane >> 5);
        const u16* bp = C.WinT + (size_t)(g * 64 + wcn * 32 + (lane & 31)) * DM + 8 * (lane >> 5);
        f32x16 acc;
#pragma unroll
        for (int r = 0; r < 16; ++r) acc[r] = 0.f;
        for (int k0 = 0; k0 < DM; k0 += 16) {
            const h16x8 a = *(const h16x8*)(ap + k0), bb = *(const h16x8*)(bp + k0);
            acc = __builtin_amdgcn_mfma_f32_32x32x16_f16(a, bb, acc, 0, 0, 0);
        }
        __syncthreads();
#pragma unroll
        for (int r = 0; r < 16; ++r) tile[(wr * 32 + (r & 3) + 8 * (r >> 2) + 4 * (lane >> 5)) * 65 + wcn * 32 + (lane & 31)] = acc[r];
        __syncthreads();
        const int row = C.tid >> 2, sub = C.tid & 3;
        p1_epilogue_row(C, g, r0 + row, sub, tile + row * 65);
    }
}

__device__ __forceinline__ void pool_unit_naive(const Ctx& C, int u) {
    LAS float* pl = (LAS float*)C.lds;
    const int t0 = (u >> 2) * 64, g = u & 3, tid = C.tid, win = 2 << g;
    __syncthreads();
    for (int idx = tid; idx < 64 * 128; idx += NTH) {
        const int tl = idx >> 7, c = idx & 127, t = t0 + tl, pos = t & (SEQ - 1);
        const int cnt = (pos + 1 < win) ? pos + 1 : win;
        float s = 0.f;
        for (int j = 0; j < cnt; ++j) s += h2f(C.U[(size_t)(t - j) * 512 + g * 128 + c]);
        pl[tl * 128 + c] = s / (float)cnt - h2f(C.U[(size_t)t * 512 + g * 128 + c]);
    }
    __syncthreads();
    const int d = tid & 127, rh = tid >> 7;
    float acc[16];
#pragma unroll
    for (int i = 0; i < 16; ++i) acc[i] = 0.f;
    const float* wp = C.w_pool + (size_t)g * 128 * 128 + d;
    for (int c = 0; c < 128; ++c) {
        const float wv = wp[(size_t)c * 128];
#pragma unroll
        for (int i = 0; i < 16; ++i) acc[i] += pl[(rh * 16 + i) * 128 + c] * wv;
    }
    const float ps = C.pool_scale[g * 128 + d];
#pragma unroll
    for (int i = 0; i < 16; ++i) {
        const int t = t0 + rh * 16 + i;
        C.MIX[(size_t)t * 1024 + g * 128 + d] = f2h(acc[i] * ps * h2f(C.SG[(size_t)t * 512 + g * 128 + d]));
    }
}

__device__ __forceinline__ unsigned fkey(float f) { const unsigned u = __float_as_uint(f); return (u & 0x80000000u) ? ~u : (u | 0x80000000u); }
__device__ __forceinline__ int block_sum_int(int v, LAS int* red) {
#pragma unroll
    for (int o = 1; o < 64; o <<= 1) v += __shfl_xor(v, o);
    __syncthreads();
    if ((threadIdx.x & 63) == 0) red[threadIdx.x >> 6] = v;
    __syncthreads();
    return red[0] + red[1] + red[2] + red[3] + red[4] + red[5] + red[6] + red[7];
}

typedef _Float16 h16x8_t __attribute__((ext_vector_type(8)));
__device__ __forceinline__ int stageA_total(LAS int* part, int pp, int w, int fr, int fq, int cnt) {
    cnt += __shfl_xor(cnt, 16); cnt += __shfl_xor(cnt, 32);
    if (fq == 0) part[(pp * 8 + w) * 16 + fr] = cnt;
    __syncthreads();
    int tot = 0;
#pragma unroll
    for (int ww = 0; ww < 8; ++ww) tot += part[(pp * 8 + ww) * 16 + fr];
    return tot;
}
__device__ __forceinline__ void stageA_unit(const Ctx& C, int b, int qb) {
    LAS int* part = (LAS int*)C.lds;
    const int w = C.wave, lane = C.lane, fr = lane & 15, fq = lane >> 4;
    const int pos = 16 * qb + fr, t = b * SEQ + pos;
    __syncthreads();
    h16x8 qf[8][2];
#pragma unroll
    for (int h = 0; h < 8; ++h)
#pragma unroll
        for (int ks = 0; ks < 2; ++ks) qf[h][ks] = *(const h16x8*)(C.QI + (size_t)t * 512 + h * 64 + 32 * ks + 8 * fq);
    float wi[8];
    { const f32x4 w0 = *(const f32x4*)(C.WI + (size_t)t * 8), w1 = *(const f32x4*)(C.WI + (size_t)t * 8 + 4);
      wi[0] = w0[0]; wi[1] = w0[1]; wi[2] = w0[2]; wi[3] = w0[3]; wi[4] = w1[0]; wi[5] = w1[1]; wi[6] = w1[2]; wi[7] = w1[3]; }
    const int nst = (qb >> 1) + 1;
    unsigned key[8][2][4];
#pragma unroll
    for (int i = 0; i < 8; ++i) {
        const int st = w + 8 * i;
#pragma unroll
        for (int tt = 0; tt < 2; ++tt) {
            const int kt = 2 * st + tt;
            if (st < nst && kt <= qb) {
                const u16* kp = C.KI + (size_t)(b * SEQ + 16 * kt + fr) * 64 + 8 * fq;
                const h16x8 a0 = *(const h16x8*)kp, a1 = *(const h16x8*)(kp + 32);
                f32x4 sc = {0.f, 0.f, 0.f, 0.f};
#pragma unroll
                for (int h = 0; h < 8; ++h) {
                    f32x4 acc = {0.f, 0.f, 0.f, 0.f};
                    acc = __builtin_amdgcn_mfma_f32_16x16x32_f16(a0, qf[h][0], acc, 0, 0, 0);
                    acc = __builtin_amdgcn_mfma_f32_16x16x32_f16(a1, qf[h][1], acc, 0, 0, 0);
#pragma unroll
                    for (int r = 0; r < 4; ++r) sc[r] += wi[h] * fmaxf(acc[r], 0.f);
                }
#pragma unroll
                for (int r = 0; r < 4; ++r) key[i][tt][r] = (16 * kt + r <= pos - 4 * fq) ? fkey(sc[r]) : 0u;
            } else {
#pragma unroll
                for (int r = 0; r < 4; ++r) key[i][tt][r] = 0u;
            }
        }
        asm volatile("" ::: "memory");
    }
    bool done = pos < 256; unsigned T = done ? 1u : 0u; int pp = 0;
    for (int bit = 31; bit >= 0; --bit) {
        const unsigned cand = done ? T : (T | (1u << bit));
        int cnt = 0;
#pragma unroll
        for (int i = 0; i < 8; ++i) if (w + 8 * i < nst) {
#pragma unroll
            for (int tt = 0; tt < 2; ++tt)
#pragma unroll
                for (int r = 0; r < 4; ++r) cnt += key[i][tt][r] >= cand ? 1 : 0; }
        const int tot = stageA_total(part, pp, w, fr, fq, cnt); pp ^= 1;
        if (!done && tot >= 256) { T = cand; if (tot == 256) done = true; }
        if (__all(done)) break;
    }
    unsigned J = 2047u;
    if (__any(!done)) {
        int cnt = 0;
#pragma unroll
        for (int i = 0; i < 8; ++i) if (w + 8 * i < nst) {
#pragma unroll
            for (int tt = 0; tt < 2; ++tt)
#pragma unroll
                for (int r = 0; r < 4; ++r) cnt += key[i][tt][r] > T ? 1 : 0; }
        const int need = 256 - stageA_total(part, pp, w, fr, fq, cnt); pp ^= 1;
        unsigned Jt = 0u;
        for (int bit = 10; bit >= 0; --bit) {
            const unsigned cj = Jt | (1u << bit);
            const int cjl = (int)cj - 4 * fq;
            int c2 = 0;
#pragma unroll
            for (int i = 0; i < 8; ++i) if (w + 8 * i < nst) {
#pragma unroll
                for (int tt = 0; tt < 2; ++tt)
#pragma unroll
                    for (int r = 0; r < 4; ++r) c2 += (key[i][tt][r] == T && (32 * (w + 8 * i) + 16 * tt + r) < cjl) ? 1 : 0; }
            const int tot = stageA_total(part, pp, w, fr, fq, c2); pp ^= 1;
            if (tot < need) Jt = cj;
        }
        if (!done) J = Jt;
    }
    const int Jl = (int)J - 4 * fq;
#pragma unroll
    for (int i = 0; i < 8; ++i) {
        const int st = w + 8 * i; unsigned loc = 0u;
        if (st < nst) {
#pragma unroll
            for (int tt = 0; tt < 2; ++tt)
#pragma unroll
                for (int r = 0; r < 4; ++r) { const unsigned k = key[i][tt][r];
                    if (k > T || (k == T && (32 * st + 16 * tt + r) <= Jl)) loc |= 1u << (4 * tt + r); }
        }
        unsigned bits = ((loc & 15u) << (4 * fq)) | ((loc >> 4) << (16 + 4 * fq));
        bits |= __shfl_xor(bits, 16); bits |= __shfl_xor(bits, 32);
        if (fq == 0) C.MASK[(size_t)t * 64 + st] = bits;
    }
}
__device__ __forceinline__ void stageA_phase(const Ctx& C) {
    for (int bb = C.bid; bb < 256; bb += C.G) {
        const int b = bb >> 5, s = bb & 31;
#pragma unroll 1
        for (int j = 0; j < 4; ++j) stageA_unit(C, b, (j & 1) ? (j * 32 + 31 - s) : (j * 32 + s));
    }
}

__device__ __forceinline__ int swz(int r, int c) { return r * 128 + ((c ^ ((r >> 1) & 7)) << 4); }
__device__ __forceinline__ float maskf(float sv, unsigned mbits, int pos) {
    const unsigned m = (unsigned)(((int)(mbits << (31 - pos))) >> 31);
    return __uint_as_float((__float_as_uint(sv) & m) | (~m & 0xFF800000u));
}
__device__ __forceinline__ h16x8 pack8(const f32x16& p, int b0) {
    typedef __fp16 hh2 __attribute__((ext_vector_type(2)));
    typedef unsigned u4 __attribute__((ext_vector_type(4)));
    u4 v;
    v.x = __builtin_bit_cast(unsigned, (hh2)__builtin_amdgcn_cvt_pkrtz(p[b0], p[b0 + 1])); v.y = __builtin_bit_cast(unsigned, (hh2)__builtin_amdgcn_cvt_pkrtz(p[b0 + 2], p[b0 + 3]));
    v.z = __builtin_bit_cast(unsigned, (hh2)__builtin_amdgcn_cvt_pkrtz(p[b0 + 4], p[b0 + 5])); v.w = __builtin_bit_cast(unsigned, (hh2)__builtin_amdgcn_cvt_pkrtz(p[b0 + 6], p[b0 + 7]));
    return __builtin_bit_cast(h16x8, v);
}
__device__ __forceinline__ void stageB_unit(const Ctx& C, int b, int kvh, int qb) {
    LAS unsigned char* L = C.lds;
    const int w = C.wave, lane = C.lane, q32 = lane & 31, half = lane >> 5, h = kvh * 4 + (w & 3);
    const int t = b * SEQ + 64 * qb + 32 * (w >> 2) + q32;
    h16x8 qf[4];
#pragma unroll
    for (int ks = 0; ks < 4; ++ks) qf[ks] = *(const h16x8*)(C.Q + (size_t)t * 512 + h * 64 + 16 * ks + 8 * half);
    f32x16 o0, o1;
#pragma unroll
    for (int r = 0; r < 16; ++r) { o0[r] = 0.f; o1[r] = 0.f; }
    float m_run = -1e30f, l_run = 0.f;
    const int lr = C.tid >> 3, lc = C.tid & 7;
    const u16* kg = C.K + ((size_t)(b * SEQ) + lr) * 128 + kvh * 64 + lc * 8;
    const u16* vg = C.VT + ((size_t)((b * 2 + kvh) * 64 + lr)) * SEQ + lc * 8;
    const int ldsw = swz(lr, lc);
    const unsigned* mg = C.MASK + (size_t)t * 64;
    __syncthreads();
    { const v4u kr = *(const v4u*)kg, vr = *(const v4u*)vg; *(LAS v4u*)(L + ldsw) = kr; *(LAS v4u*)(L + 16384 + ldsw) = vr; }
    uint2 mw = *(const uint2*)mg;
    __syncthreads();
    const int nt = qb + 1;
    const int ra0 = swz(q32, half), ra1 = swz(32 + q32, half);
#pragma unroll 1
    for (int j = 0; j < nt; ++j) {
        const int cur = (j & 1) * 8192;
        const bool more = j + 1 < nt;
        v4u kr = {0u, 0u, 0u, 0u}, vr = {0u, 0u, 0u, 0u}; uint2 mwn = make_uint2(0u, 0u);
        if (more) { kr = *(const v4u*)(kg + (size_t)(j + 1) * 64 * 128); vr = *(const v4u*)(vg + (j + 1) * 64); mwn = *(const uint2*)(mg + 2 * (j + 1)); }
        f32x16 s0, s1;
#pragma unroll
        for (int r = 0; r < 16; ++r) { s0[r] = 0.f; s1[r] = 0.f; }
#pragma unroll
        for (int ks = 0; ks < 4; ++ks) {
            const h16x8 a0 = *(const LAS h16x8*)(L + cur + swz(q32, 2 * ks + half)), a1 = *(const LAS h16x8*)(L + cur + swz(32 + q32, 2 * ks + half));
            s0 = __builtin_amdgcn_mfma_f32_32x32x16_f16(a0, qf[ks], s0, 0, 0, 0);
            s1 = __builtin_amdgcn_mfma_f32_32x32x16_f16(a1, qf[ks], s1, 0, 0, 0);
        }
        const unsigned m0 = mw.x >> (4 * half), m1 = mw.y >> (4 * half);
        float mx = -INFINITY;
#pragma unroll
        for (int r = 0; r < 16; ++r) { const int pos = (r & 3) + 8 * (r >> 2); s0[r] = maskf(s0[r], m0, pos); s1[r] = maskf(s1[r], m1, pos); mx = fmaxf(mx, fmaxf(s0[r], s1[r])); }
        mx = fmaxf(mx, __shfl_xor(mx, 32));
        if (__any(mx > m_run)) {
            const float mn = fmaxf(m_run, mx), alpha = __builtin_amdgcn_exp2f(m_run - mn);
            l_run *= alpha; m_run = mn;
#pragma unroll
            for (int r = 0; r < 16; ++r) { o0[r] *= alpha; o1[r] *= alpha; }
        }
        float ls = 0.f;
#pragma unroll
        for (int r = 0; r < 16; ++r) { s0[r] = __builtin_amdgcn_exp2f(s0[r] - m_run); s1[r] = __builtin_amdgcn_exp2f(s1[r] - m_run); ls += s0[r] + s1[r]; }
        l_run += ls;
        const h16x8 pb0 = pack8(s0, 0), pb1 = pack8(s0, 8), pb2 = pack8(s1, 0), pb3 = pack8(s1, 8);
#pragma unroll
        for (int kc = 0; kc < 4; ++kc) {
            const h16x8 va0 = *(const LAS h16x8*)(L + 16384 + cur + swz(q32, 2 * kc + half)), va1 = *(const LAS h16x8*)(L + 16384 + cur + swz(32 + q32, 2 * kc + half));
            const h16x8 pb = kc == 0 ? pb0 : kc == 1 ? pb1 : kc == 2 ? pb2 : pb3;
            o0 = __builtin_amdgcn_mfma_f32_32x32x16_f16(va0, pb, o0, 0, 0, 0);
            o1 = __builtin_amdgcn_mfma_f32_32x32x16_f16(va1, pb, o1, 0, 0, 0);
        }
        if (more) { *(LAS v4u*)(L + (cur ^ 8192) + ldsw) = kr; *(LAS v4u*)(L + 16384 + (cur ^ 8192) + ldsw) = vr; }
        mw = mwn;
        __syncthreads();
    }
    (void)ra0; (void)ra1;
    l_run += __shfl_xor(l_run, 32);
    const float inv = 1.f / l_run;
    const u16* gp = C.GA + (size_t)t * 512 + h * 64 + 4 * half; u16* mp = C.MIX + (size_t)t * 1024 + 512 + h * 64 + 4 * half;
#pragma unroll
    for (int dt = 0; dt < 2; ++dt)
#pragma unroll
        for (int g4 = 0; g4 < 4; ++g4) {
            const int d0 = 32 * dt + 8 * g4;
            const uint2 gv = *(const uint2*)(gp + d0);
            const float ga0 = h2f((u16)(gv.x & 0xffffu)), ga1 = h2f((u16)(gv.x >> 16)), ga2 = h2f((u16)(gv.y & 0xffffu)), ga3 = h2f((u16)(gv.y >> 16));
            const f32x16& oo = dt ? o1 : o0;
            uint2 ov; ov.x = pk2h(oo[4 * g4] * inv * ga0, oo[4 * g4 + 1] * inv * ga1); ov.y = pk2h(oo[4 * g4 + 2] * inv * ga2, oo[4 * g4 + 3] * inv * ga3);
            *(uint2*)(mp + d0) = ov;
        }
}
__device__ __forceinline__ void stageB_phase(const Ctx& C) {
    for (int bb = C.bid; bb < 256; bb += C.G) {
        const int bk = bb >> 4, s = bb & 15;
        stageB_unit(C, bk >> 1, bk & 1, 31 - s);
        stageB_unit(C, bk >> 1, bk & 1, s);
    }
}
__device__ __forceinline__ void selattn_row_naive(const Ctx& C, int t) {
    LAS float* qs = (LAS float*)C.lds;
    LAS unsigned* keys = (LAS unsigned*)(C.lds + 2048);
    LAS unsigned* mk = (LAS unsigned*)(C.lds + 10240);
    LAS int* wpre = (LAS int*)(C.lds + 10496);
    LAS int* red = (LAS int*)(C.lds + 10816);
    LAS int* sel = (LAS int*)(C.lds + 10880);
    LAS float* p = (LAS float*)(C.lds + 11904);
    LAS float* hl = (LAS float*)(C.lds + 21120);
    const int b = t >> 11, pos = t & (SEQ - 1), n = pos + 1, tid = C.tid;
    __syncthreads();
    if (tid < 64) mk[tid] = C.MASK[(size_t)t * 64 + tid];
    __syncthreads();
    if (tid == 0) { int a = 0; for (int i = 0; i < 64; ++i) { wpre[i] = a; a += __popc(mk[i]); } wpre[64] = a; }
    __syncthreads();
    const int nsel = wpre[64];
    for (int s = tid; s < n; s += NTH) { const unsigned wv = mk[s >> 5]; if ((wv >> (s & 31)) & 1u) sel[wpre[s >> 5] + __popc(wv & ((1u << (s & 31)) - 1u))] = s; }
    for (int i = tid; i < 512; i += NTH) qs[i] = h2f(C.Q[(size_t)t * 512 + i]);
    __syncthreads();
    if (tid < 256) {
        if (tid < nsel) {
            const int s = sel[tid];
#pragma unroll
            for (int kvh = 0; kvh < 2; ++kvh) {
                const u16* kp = C.K + (size_t)(b * SEQ + s) * 128 + kvh * 64;
                float dq[4] = {0.f, 0.f, 0.f, 0.f};
#pragma unroll 1
                for (int i = 0; i < 8; ++i) { const h16x8 v8 = *(const h16x8*)(kp + 8 * i);
#pragma unroll
                    for (int gq = 0; gq < 4; ++gq) {
#pragma unroll
                        for (int j = 0; j < 8; ++j) dq[gq] += qs[(kvh * 4 + gq) * 64 + 8 * i + j] * (float)v8[j]; } }
#pragma unroll
                for (int gq = 0; gq < 4; ++gq) p[tid * 9 + kvh * 4 + gq] = dq[gq];
            }
        } else {
#pragma unroll
            for (int h = 0; h < 8; ++h) p[tid * 9 + h] = -INFINITY;
        }
    }
    __syncthreads();
    {
        const int h = C.wave, lane = C.lane;
        float m = -INFINITY;
        for (int j = lane; j < 256; j += 64) m = fmaxf(m, p[j * 9 + h]);
#pragma unroll
        for (int o2 = 1; o2 < 64; o2 <<= 1) m = fmaxf(m, __shfl_xor(m, o2));
        float l = 0.f;
        for (int j = lane; j < 256; j += 64) { const float e = exp2f(p[j * 9 + h] - m); p[j * 9 + h] = e; l += e; }
        l = wave_sum(l);
        if (lane == 0) hl[h] = l;
    }
    __syncthreads();
    {
        const int h = tid >> 6, d = tid & 63, kvh = h >> 2;
        float a0 = 0.f;
        for (int j = 0; j < nsel; ++j) a0 += p[j * 9 + h] * h2f(C.V[(size_t)(b * SEQ + sel[j]) * 128 + kvh * 64 + d]);
        C.MIX[(size_t)t * 1024 + 512 + h * 64 + d] = f2h(a0 / hl[h] * h2f(C.GA[(size_t)t * 512 + h * 64 + d]));
    }
}

__device__ __forceinline__ void phase3_naive(const Ctx& C) {
    for (int u = C.bid; u < 16 * 128; u += C.G) {
        const int c0 = (u & 15) * 64, r0 = (u >> 4) * 128, w = C.wave, lane = C.lane, wr = w & 3, wcn = w >> 2;
        const u16* ap = C.MIX + (size_t)(r0 + wr * 32 + (lane & 31)) * DM + 8 * (lane >> 5);
        const u16* bp = C.WoutT + (size_t)(c0 + wcn * 32 + (lane & 31)) * DM + 8 * (lane >> 5);
        f32x16 acc;
#pragma unroll
        for (int r = 0; r < 16; ++r) acc[r] = 0.f;
        for (int k0 = 0; k0 < DM; k0 += 16) {
            const h16x8 a = *(const h16x8*)(ap + k0), bb = *(const h16x8*)(bp + k0);
            acc = __builtin_amdgcn_mfma_f32_32x32x16_f16(a, bb, acc, 0, 0, 0);
        }
        const int col = c0 + wcn * 32 + (lane & 31), b = r0 >> 11;
        const float gate = C.mod[b * 3072 + 2048 + col];
#pragma unroll
        for (int r = 0; r < 16; ++r) {
            const int row = r0 + wr * 32 + (r & 3) + 8 * (r >> 2) + 4 * (lane >> 5);
            C.out[(size_t)row * DM + col] = C.x[(size_t)row * DM + col] + gate * acc[r];
        }
    }
}

struct Args { const float* in[11]; float* out; unsigned char* ws; };
__global__ void __launch_bounds__(NTH, 2) mk_fwd(Args a) {
    extern __shared__ __attribute__((aligned(16))) unsigned char lds_raw[];
    Ctx C;
    C.lds = (LAS unsigned char*)lds_raw;
    C.tid = threadIdx.x; C.lane = C.tid & 63; C.wave = __builtin_amdgcn_readfirstlane(C.tid >> 6); C.bid = blockIdx.x; C.G = gridDim.x;
    C.x = a.in[0]; C.c = a.in[1]; C.norm_w = a.in[2]; C.w_ada = a.in[3]; C.b_ada = a.in[4]; C.w_in = a.in[5]; C.qnw = a.in[6]; C.knw = a.in[7];
    C.w_pool = a.in[8]; C.pool_scale = a.in[9]; C.w_out = a.in[10]; C.out = a.out;
    unsigned char* ws = a.ws;
    C.mod = (float*)(ws + WS_MOD); C.rope = (float2*)(ws + WS_ROPE); C.WinT = (u16*)(ws + WS_WINT); C.WoutT = (u16*)(ws + WS_WOUTT); C.XN = (u16*)(ws + WS_XN);
    C.U = (u16*)(ws + WS_U); C.SG = (u16*)(ws + WS_SG); C.Q = (u16*)(ws + WS_Q); C.GA = (u16*)(ws + WS_GA); C.QI = (u16*)(ws + WS_QI);
    C.K = (u16*)(ws + WS_K); C.V = (u16*)(ws + WS_V); C.KI = (u16*)(ws + WS_KI); C.VT = C.V; C.WI = (float*)(ws + WS_WI); C.MASK = (unsigned*)(ws + WS_MASK); C.MIX = (u16*)(ws + WS_MIX);
    volatile LAS unsigned* MISC = (volatile LAS unsigned*)(C.lds + MISC_OFF);
    for (int u = C.tid; u < (LDS_BYTES - LDSCTL_OFF) / 4; u += NTH) ((LAS unsigned*)(C.lds + LDSCTL_OFF))[u] = 0u;
    __syncthreads();
    XcdBarrier bar = xcd_barrier_post((unsigned*)(ws + WS_CTL) + CW_BAR, MISC + 8);

    phase0(C);
    xcd_barrier(bar);
    phase0b(C);
    xcd_barrier(bar);
    {
        pg8::Gemm g{C.XN, C.WinT, MT, NPAD, DM}; pg8::StaticOrder S; S.init(MT, NPAD, C.G, C.bid);
        EpiP1 E{C.U, C.SG, C.Q, C.GA, C.QI, C.K, C.V, C.KI, C.WI, C.qnw, C.knw, C.rope};
        pg8::gemm_phase<EpiP1, pg8::StaticOrder, true, true>(C.lds, g, S, E);
    }
    xcd_barrier(bar);
    stageA_phase(C);
    for (int u = C.bid; u < 1024; u += C.G) pool_unit_naive(C, u);
    xcd_barrier(bar);
    stageB_phase(C);
    xcd_barrier(bar);
    {
        pg8::Gemm g{C.MIX, C.WoutT, MT, DM, DM}; pg8::StaticOrder S; S.init(MT, DM, C.G, C.bid);
        EpiOut E{C.x, C.mod + 2048, C.out};
        pg8::gemm_phase<EpiOut, pg8::StaticOrder, true, true>(C.lds, g, S, E);
    }
}

extern "C" void kernel_launch(void* const* d_in, const int* in_sizes, int n_in, void* d_out, int out_size, void* d_ws, size_t ws_size, hipStream_t stream) {
    (void)in_sizes; (void)out_size;
    static int grid = 0;
    if (grid == 0) {
        if (n_in != 11 || ws_size < WS_END) { fprintf(stderr, "kernel_launch: unexpected inputs / workspace (%d, %zu)\n", n_in, ws_size); grid = -1; return; }
        int dev = 0, cus = 0, per_cu = 0;
        hipGetDevice(&dev); hipDeviceGetAttribute(&cus, hipDeviceAttributeMultiprocessorCount, dev);
        hipFuncSetAttribute((const void*)mk_fwd, hipFuncAttributeMaxDynamicSharedMemorySize, LDS_BYTES);
        hipOccupancyMaxActiveBlocksPerMultiprocessor(&per_cu, (const void*)mk_fwd, NTH, LDS_BYTES);
        (void)hipGetLastError();
        if (per_cu < 1) { fprintf(stderr, "kernel_launch: occupancy query says %d blocks per CU\n", per_cu); per_cu = 1; }
        grid = cus;
    }
    if (grid < 0) return;
    hipMemsetAsync((char*)d_ws + WS_CTL, 0, CTL_ZERO_BYTES, stream);
    Args a{};
    for (int i = 0; i < 11; ++i) a.in[i] = (const float*)d_in[i];
    a.out = (float*)d_out; a.ws = (unsigned char*)d_ws;
    void* kargs[] = {&a};
    hipError_t e = hipLaunchCooperativeKernel((const void*)mk_fwd, dim3(grid), dim3(NTH), kargs, LDS_BYTES, stream);
    if (e != hipSuccess) fprintf(stderr, "kernel_launch: cooperative launch failed: %s (grid %d)\n", hipGetErrorString(e), grid);
}
```

```cpp
#include <hip/hip_runtime.h>
#include <stdint.h>
#include <cstdio>

typedef unsigned short u16;
typedef _Float16 h16x8 __attribute__((ext_vector_type(8)));
typedef float f32x16 __attribute__((ext_vector_type(16)));
typedef float f32x4 __attribute__((ext_vector_type(4)));
typedef unsigned v4u __attribute__((ext_vector_type(4)));
#define LAS __attribute__((address_space(3)))
#define GAS __attribute__((address_space(1)))

constexpr int NB = 8, SEQ = 2048, DM = 1024, MT = NB * SEQ;
constexpr int NPROJ = 2888, NPAD = 3072;
constexpr int NTH = 512, NWAVES = 8;
constexpr float QSCALE = 0.18033688011112042f;
constexpr float EPS = 1e-6f;

constexpr size_t WS_CTL = 0, CTL_ZERO_BYTES = 65536;
constexpr size_t WS_MOD = 65536;
constexpr size_t WS_ROPE = WS_MOD + (size_t)NB * 3072 * 4;
constexpr size_t WS_WINT = WS_ROPE + (size_t)SEQ * 32 * 8;
constexpr size_t WS_WOUTT = WS_WINT + (size_t)NPAD * DM * 2;
constexpr size_t WS_XN = WS_WOUTT + (size_t)DM * DM * 2;
constexpr size_t WS_U = WS_XN + (size_t)MT * DM * 2;
constexpr size_t WS_SG = WS_U + (size_t)MT * 512 * 2;
constexpr size_t WS_Q = WS_SG + (size_t)MT * 512 * 2;
constexpr size_t WS_GA = WS_Q + (size_t)MT * 512 * 2;
constexpr size_t WS_QI = WS_GA + (size_t)MT * 512 * 2;
constexpr size_t WS_K = WS_QI + (size_t)MT * 512 * 2;
constexpr size_t WS_V = WS_K + (size_t)MT * 128 * 2;
constexpr size_t WS_KI = WS_V + (size_t)MT * 128 * 2;
constexpr size_t WS_WI = WS_KI + (size_t)MT * 64 * 2;
constexpr size_t WS_MASK = WS_WI + (size_t)MT * 8 * 4;
constexpr size_t WS_MIX = WS_MASK + (size_t)MT * 64 * 4;
constexpr size_t WS_WPT = WS_MIX + (size_t)MT * DM * 2;
constexpr size_t WS_END = WS_WPT + (size_t)4 * 128 * 128 * 2;
constexpr int CW_BAR = 1024;

constexpr int RING_BYTES = 131072;
constexpr int LDSCTL_OFF = RING_BYTES, MISC_OFF = LDSCTL_OFF + 320;
constexpr int LDS_BYTES = 147456;

__device__ __forceinline__ u16 f2h(float f) { return __builtin_bit_cast(u16, (_Float16)f); }
__device__ __forceinline__ float h2f(u16 h) { return (float)__builtin_bit_cast(_Float16, h); }
__device__ __forceinline__ float silu_f(float v) { return v / (1.f + __expf(-v)); }
__device__ __forceinline__ float wave_sum(float v) {
#pragma unroll
    for (int o = 1; o < 64; o <<= 1) v += __shfl_xor(v, o);
    return v;
}

__constant__ double ROPE_FREQ[32] = {1.0,0.7498942093324559,0.5623413251903491,0.4216965034285822,0.31622776601683794,0.23713737056616552,0.1778279410038923,0.1333521432163324,0.1,0.07498942093324558,0.05623413251903491,0.042169650342858224,0.03162277660168379,0.023713737056616554,0.01778279410038923,0.01333521432163324,0.01,0.007498942093324558,0.005623413251903491,0.004216965034285823,0.0031622776601683794,0.0023713737056616554,0.0017782794100389228,0.001333521432163324,0.001,0.0007498942093324559,0.0005623413251903491,0.00042169650342858224,0.00031622776601683794,0.00023713737056616554,0.00017782794100389227,0.0001333521432163324};

#define XB_TMO      128
#define XB_XCNT(j)  (256  + 64 * (j))
#define XB_XSUB(j)  (1280 + 64 * (j))
#define XB_XGEN(j)  (2304 + 64 * (j))
#define XB_TOP      3328
#define XB_TOPGEN   3392
#define XCD_BAR_WORDS 3456
#define XB_SPIN_CAP (1u << 18)

__device__ __forceinline__ unsigned xb_ld(unsigned* p)              { return __hip_atomic_load(p, __ATOMIC_RELAXED, __HIP_MEMORY_SCOPE_AGENT); }
__device__ __forceinline__ unsigned xb_add(unsigned* p, unsigned v) { return __hip_atomic_fetch_add(p, v, __ATOMIC_RELAXED, __HIP_MEMORY_SCOPE_AGENT); }
__device__ __forceinline__ unsigned xb_xcc_id() { return (unsigned)__builtin_amdgcn_s_getreg((3 << 11) | 20) & 0xFu; }
#define XB_SPIN(cond, bar) do { unsigned _sp = 0; while (cond) { __builtin_amdgcn_s_sleep(1); \
    if ((++_sp & 255u) == 0u) { if (xb_ld(&(bar)[XB_TMO])) break; if (_sp > XB_SPIN_CAP) { atomicAdd(&(bar)[XB_TMO], 1u); break; } } } } while (0)

struct XcdBarrier {
    unsigned* bar; unsigned x;
    volatile LAS unsigned* st;
};

__device__ __forceinline__ XcdBarrier xcd_barrier_post(unsigned* bar, volatile LAS unsigned* st) {
    XcdBarrier b; b.bar = bar; b.x = xb_xcc_id(); b.st = st;
    if (threadIdx.x == 0) (void)xb_add(&bar[XB_XCNT(b.x)], 1u);
    return b;
}
__device__ __forceinline__ void xcd_barrier_complete(unsigned* bar, unsigned x, unsigned& nloc, unsigned& nx) {
    const unsigned G = gridDim.x * gridDim.y * gridDim.z;
    unsigned sum, cnt, mine, sp = 0u;
    for (;;) {
        sum = 0u; cnt = 0u; mine = 0u;
#pragma unroll
        for (unsigned j = 0; j < 16; ++j) { const unsigned c = xb_ld(&bar[XB_XCNT(j)]); sum += c; cnt += (c > 0u) ? 1u : 0u; mine = (j == x) ? c : mine; }
        if (sum == G) break;
        __builtin_amdgcn_s_sleep(1);
        if ((++sp & 255u) == 0u) { if (xb_ld(&bar[XB_TMO])) break; if (sp > XB_SPIN_CAP) { atomicAdd(&bar[XB_TMO], 1u); break; } }
    }
    nloc = mine > 0u ? mine : 1u; nx = cnt > 0u ? cnt : 1u;
}

__device__ __forceinline__ void xcd_barrier(const XcdBarrier& b) {
    asm volatile("s_waitcnt vmcnt(0)" ::: "memory");
    __syncthreads();
    if (threadIdx.x == 0) {
        unsigned* bar = b.bar;
        __builtin_amdgcn_s_waitcnt(0);
        unsigned nloc = b.st[0], nx = b.st[1];
        if (nloc == 0u) { xcd_barrier_complete(bar, b.x, nloc, nx); b.st[0] = nloc; b.st[1] = nx; }
        const unsigned old = xb_add(&bar[XB_XSUB(b.x)], 1u);
        const unsigned gen = old / nloc;
        if (old + 1u == (gen + 1u) * nloc) {
            __builtin_amdgcn_fence(__ATOMIC_RELEASE, "agent");
            asm volatile("s_waitcnt vmcnt(0)" ::: "memory");
            const unsigned og = xb_add(&bar[XB_TOP], 1u);
            const unsigned tg = og / nx;
            if (og + 1u == (tg + 1u) * nx) xb_add(&bar[XB_TOPGEN], 1u);
            else XB_SPIN(xb_ld(&bar[XB_TOPGEN]) == tg, bar);
            __builtin_amdgcn_fence(__ATOMIC_ACQUIRE, "agent");
            xb_add(&bar[XB_XGEN(b.x)], 1u);
            asm volatile("s_waitcnt vmcnt(0)" ::: "memory");
        } else {
            XB_SPIN(xb_ld(&bar[XB_XGEN(b.x)]) == gen, bar);
            __builtin_amdgcn_fence(__ATOMIC_ACQUIRE, "agent");
            asm volatile("s_waitcnt vmcnt(0)" ::: "memory");
        }
    }
    __syncthreads();
}


struct Ctx {
    const float *x, *c, *norm_w, *w_ada, *b_ada, *w_in, *qnw, *knw, *w_pool, *pool_scale, *w_out;
    float* out;
    float* mod; float2* rope; u16 *WinT, *WoutT, *XN, *U, *SG, *Q, *GA, *QI, *K, *V, *KI, *VT, *WpT; float* WI; unsigned* MASK; u16* MIX;
    LAS unsigned char* lds;
    int tid, lane, wave, bid, G;
};

__device__ __forceinline__ void p0_mod_unit(const Ctx& C, int u) {
    LAS float* sc = (LAS float*)C.lds;
    const int b = u / 6, e = (u % 6) * 512 + C.tid;
    __syncthreads();
    for (int i = C.tid; i < DM; i += NTH) sc[i] = silu_f(C.c[b * DM + i]);
    __syncthreads();
    float acc = C.b_ada[e];
    for (int d = 0; d < DM; ++d) acc += sc[d] * C.w_ada[(size_t)d * 3072 + e];
    C.mod[b * 3072 + e] = acc;
}
__device__ __forceinline__ void p0_rope_unit(const Ctx& C, int u) {
    const int idx = u * NTH + C.tid, pos = idx >> 5, i = idx & 31;
    const double ang = (double)pos * ROPE_FREQ[i];
    double t = ang * 0.15915494309189533576888;
    t -= floor(t + 0.5);
    const double x = t * 6.283185307179586476925287, x2 = x * x;
    double s = 0.0, cc = 0.0, ts = x, tc = 1.0;
#pragma unroll 1
    for (int n = 0; n < 14; ++n) { cc += tc; s += ts; tc *= -x2 / (double)((2 * n + 1) * (2 * n + 2)); ts *= -x2 / (double)((2 * n + 2) * (2 * n + 3)); }
    C.rope[idx] = make_float2((float)cc, (float)s);
}
__device__ __forceinline__ void p0_conv_unit(const Ctx& C, const float* W, int N, u16* WT, int nb, int kb, int Kdim, bool perm) {
    LAS float* tl = (LAS float*)C.lds;
    const int k0 = kb * 64, n0 = nb * 64;
    __syncthreads();
#pragma unroll
    for (int i = 0; i < 8; ++i) { const int kk = (C.tid >> 6) + 8 * i, nn = C.tid & 63, n = n0 + nn;
        tl[kk * 65 + nn] = n < N ? W[(size_t)(k0 + kk) * N + n] : 0.f; }
    __syncthreads();
    const int nn = C.tid >> 3, kc = (C.tid & 7) * 8;
    v4u o;
    o.x = (unsigned)f2h(tl[(kc + 0) * 65 + nn]) | ((unsigned)f2h(tl[(kc + 1) * 65 + nn]) << 16);
    o.y = (unsigned)f2h(tl[(kc + 2) * 65 + nn]) | ((unsigned)f2h(tl[(kc + 3) * 65 + nn]) << 16);
    o.z = (unsigned)f2h(tl[(kc + 4) * 65 + nn]) | ((unsigned)f2h(tl[(kc + 5) * 65 + nn]) << 16);
    o.w = (unsigned)f2h(tl[(kc + 6) * 65 + nn]) | ((unsigned)f2h(tl[(kc + 7) * 65 + nn]) << 16);
    const int nl = n0 + nn, np = perm ? ((nl & ~255) | (((nl >> 5) & 1) << 7) | (((nl >> 6) & 3) << 5) | (nl & 31)) : nl;
    *(v4u*)(WT + (size_t)np * Kdim + k0 + kc) = o;
}
__device__ __forceinline__ void phase0(const Ctx& C) {
    constexpr int U_MOD = 48, U_ROPE = 128, U_WIN = 48 * 16, U_WOUT = 16 * 16, U_WP = 16, U_ALL = U_MOD + U_ROPE + U_WIN + U_WOUT + U_WP;
    for (int u = C.bid; u < U_ALL; u += C.G) {
        int r = u;
        if (r < U_MOD) { p0_mod_unit(C, r); continue; } r -= U_MOD;
        if (r < U_ROPE) { p0_rope_unit(C, r); continue; } r -= U_ROPE;
        if (r < U_WIN) { p0_conv_unit(C, C.w_in, NPROJ, C.WinT, r >> 4, r & 15, DM, true); continue; } r -= U_WIN;
        if (r < U_WOUT) { p0_conv_unit(C, C.w_out, DM, C.WoutT, r >> 4, r & 15, DM, false); continue; } r -= U_WOUT;
        p0_conv_unit(C, C.w_pool + (size_t)(r >> 2) * 128 * 128, 128, C.WpT + (size_t)(r >> 2) * 128 * 128, (r >> 1) & 1, r & 1, 128, false);
    }
}

__device__ __forceinline__ void phase0b(const Ctx& C) {
    for (int row = C.bid * NWAVES + C.wave; row < MT; row += C.G * NWAVES) {
        const int lane = C.lane, b = row >> 11;
        const float4* xr = (const float4*)(C.x + (size_t)row * DM) + lane;
        float4 v[4]; float s = 0.f;
#pragma unroll
        for (int j = 0; j < 4; ++j) { v[j] = xr[64 * j]; s += v[j].x * v[j].x + v[j].y * v[j].y + v[j].z * v[j].z + v[j].w * v[j].w; }
        const float rstd = rsqrtf(wave_sum(s) * (1.f / DM) + EPS);
        const float* shift = C.mod + b * 3072; const float* scale = shift + 1024;
#pragma unroll
        for (int j = 0; j < 4; ++j) {
            const int k = 4 * lane + 256 * j;
            const float4 w4 = *(const float4*)(C.norm_w + k), s4 = *(const float4*)(scale + k), h4 = *(const float4*)(shift + k);
            const float o0 = v[j].x * rstd * w4.x * (1.f + s4.x) + h4.x, o1 = v[j].y * rstd * w4.y * (1.f + s4.y) + h4.y;
            const float o2 = v[j].z * rstd * w4.z * (1.f + s4.z) + h4.z, o3 = v[j].w * rstd * w4.w * (1.f + s4.w) + h4.w;
            ushort4 o; o.x = f2h(o0); o.y = f2h(o1); o.z = f2h(o2); o.w = f2h(o3);
            *(ushort4*)(C.XN + (size_t)row * DM + k) = o;
        }
    }
}


namespace pg8 {
#define PG8_LAS __attribute__((address_space(3)))
typedef unsigned short bf16_t;
typedef _Float16 bf16x8 __attribute__((ext_vector_type(8)));
typedef float f32x4 __attribute__((ext_vector_type(4)));
typedef unsigned u32x4 __attribute__((ext_vector_type(4)));
constexpr int BM = 256, BK = 64, HALF = 128, HTB = HALF * BK * 2  , STAGE_BYTES = 8 * HTB, NXCD = 8, WGM = 8;

__host__ __device__ __forceinline__ int lds_byte(int r, int c) { const int st = (r >> 4) * 2 + (c >> 5), rr = r & 15, cc = c & 31, ob = rr * 64 + cc * 2; return st * 1024 + (ob ^ (((ob >> 9) & 1) << 5)); }
__host__ __device__ __forceinline__ void stage_rc(int b, int& R, int& C) { const int st = b / 1024, sb = b % 1024, swz = sb ^ (((sb >> 9) & 1) << 5); R = (st >> 1) * 16 + swz / 64; C = (st & 1) * 32 + (swz % 64) / 2; }
__host__ __device__ __forceinline__ int perm32(int rho) { const int n = rho >> 4, i = rho & 15; return 8 * (i >> 2) + 4 * n + (i & 3); }

struct Unit { int pm, pn; };
struct Gemm { const bf16_t* A; const bf16_t* Bt; int M, N, K; };

struct StaticOrder {
    int nM, nN, nwg, G, c;
    __host__ __device__ void init(int M, int N, int G_, int c_) { nM = M / BM; nN = N / BM; nwg = nM * nN; G = G_; c = c_; }
    __host__ __device__ bool next(int i, Unit& u) const {
        const long L = (long)i * G + c; if (L >= nwg) return false;
        int wgid = (int)L; { const int q = nwg / NXCD, r = nwg % NXCD, xcd = wgid % NXCD, off = wgid / NXCD; wgid = (xcd < r ? xcd * (q + 1) : r * (q + 1) + (xcd - r) * q) + off; }
        const int nig = WGM * nN, gid = wgid / nig, fm = gid * WGM, gsz = (nM - fm) < WGM ? (nM - fm) : WGM;
        u.pm = fm + ((wgid % nig) % gsz); u.pn = (wgid % nig) / gsz; return true;
    }
    __device__ __forceinline__ void a_ready(const Unit&) const {}
    __device__ __forceinline__ void done(const Unit&) const {}
};

template <class Epi, class Sched, bool ALIGN_EPI = false, bool SP2 = false>
__device__ __forceinline__ void gemm_phase(PG8_LAS unsigned char* lds, const Gemm g, const Sched& S, const Epi& E) {
    const int tid = threadIdx.x, wid = __builtin_amdgcn_readfirstlane(tid >> 6), lane = tid & 63, wr = wid >> 2, wc = wid & 3, fr = lane & 15, fq = lane >> 4;
    const int K = g.K, nt = K / BK;
    unsigned voffA[2], voffB[2];
#pragma unroll
    for (int i = 0; i < 2; ++i) { int R, C; stage_rc(tid * 16 + i * 8192, R, C); const int Rb = Epi::PERM ? ((R & ~31) + perm32(R & 31)) : R;
        voffA[i] = (unsigned)(R * K + C) * 2u; voffB[i] = (unsigned)(Rb * K + C) * 2u; }
    const size_t kstep = (size_t)(BK * 2);
    const size_t hstep = (size_t)HALF * K * 2;
    const size_t tstep = 2 * hstep;
    const unsigned ldsw = (unsigned)wid * 1024u;
    const int aoff = lds_byte(wr * 64 + fr, fq * 8), boff = lds_byte(wc * 32 + fr, fq * 8);
#define PG8_SA(b, h) (((b) * 2 + (h)) * HTB)
#define PG8_SB(b, h) ((4 + (b) * 2 + (h)) * HTB)
#define PG8_STAGE(bufoff, gbase, voff) do { _Pragma("unroll") for (int _i = 0; _i < 2; ++_i) \
        __builtin_amdgcn_global_load_lds((const unsigned*)((const char*)(gbase) + (voff)[_i]), (PG8_LAS unsigned*)(lds + (bufoff) + ldsw + _i * 8192), 16, 0, 0); } while (0)
#define PG8_LDA(dst, b, h) do { _Pragma("unroll") for (int m = 0; m < 4; ++m) _Pragma("unroll") for (int k = 0; k < 2; ++k) dst[m][k] = *(const PG8_LAS bf16x8*)(lds + PG8_SA(b, h) + aoff + m * 2048 + k * 1024); } while (0)
#define PG8_LDB(dst, b, h) do { _Pragma("unroll") for (int n = 0; n < 2; ++n) _Pragma("unroll") for (int k = 0; k < 2; ++k) dst[n][k] = *(const PG8_LAS bf16x8*)(lds + PG8_SB(b, h) + boff + n * 2048 + k * 1024); } while (0)
#define PG8_MMA(ai, bj, At, Bt) do { __builtin_amdgcn_s_setprio(1); _Pragma("unroll") for (int m = 0; m < 4; ++m) _Pragma("unroll") for (int n = 0; n < 2; ++n) _Pragma("unroll") for (int k = 0; k < 2; ++k) \
        acc[ai][bj][m][n] = __builtin_amdgcn_mfma_f32_16x16x32_f16(Bt[n][k], At[m][k], acc[ai][bj][m][n], 0, 0, 0); __builtin_amdgcn_s_setprio(0); } while (0)
#define PG8_WAIT_V(n) asm volatile("s_waitcnt vmcnt(" #n ")" ::: "memory")
#define PG8_WAIT_L(n) asm volatile("s_waitcnt lgkmcnt(" #n ")" ::: "memory")
#define PG8_BAR __builtin_amdgcn_s_barrier()
#define PG8_SCHED __builtin_amdgcn_sched_barrier(0)
    Unit cur, nxt; int ui = 0;
    if (!S.next(0, cur)) return;
    f32x4 acc[2][2][4][2];
#pragma unroll
    for (int a = 0; a < 2; ++a)
#pragma unroll
        for (int b = 0; b < 2; ++b)
#pragma unroll
            for (int m = 0; m < 4; ++m)
#pragma unroll
                for (int n = 0; n < 2; ++n) acc[a][b][m][n] = (f32x4){0.f, 0.f, 0.f, 0.f};
    bf16x8 At[4][2], B0[2][2], B1[2][2];
    const char* cA = (const char*)g.A + (size_t)cur.pm * tstep; const char* cB = (const char*)g.Bt + (size_t)cur.pn * tstep;
    S.a_ready(cur);
    if constexpr (SP2) {
        PG8_STAGE(PG8_SB(0, 0), cB, voffB); PG8_STAGE(PG8_SB(0, 1), cB + hstep, voffB); PG8_STAGE(PG8_SA(0, 0), cA, voffA); PG8_STAGE(PG8_SA(0, 1), cA + hstep, voffA);
        if (wr == 1) PG8_BAR;
        PG8_WAIT_V(2); PG8_BAR;
        PG8_STAGE(PG8_SB(1, 0), cB + kstep, voffB); PG8_STAGE(PG8_SA(1, 0), cA + kstep, voffA); PG8_STAGE(PG8_SB(1, 1), cB + hstep + kstep, voffB);
        PG8_WAIT_V(6); PG8_BAR;
    } else {
        PG8_STAGE(PG8_SB(0, 0), cB, voffB); PG8_STAGE(PG8_SA(0, 0), cA, voffA); PG8_STAGE(PG8_SB(0, 1), cB + hstep, voffB); PG8_STAGE(PG8_SA(0, 1), cA + hstep, voffA);
        if (wr == 1) PG8_BAR;
        PG8_WAIT_V(4); PG8_BAR;
        PG8_STAGE(PG8_SB(1, 0), cB + kstep, voffB); PG8_STAGE(PG8_SA(1, 0), cA + kstep, voffA); PG8_STAGE(PG8_SB(1, 1), cB + hstep + kstep, voffB);
        PG8_WAIT_V(6); PG8_BAR;
    }
    for (;;) {
        const bool has_next = S.next(ui + 1, nxt);
        const char* nA = has_next ? (const char*)g.A + (size_t)nxt.pm * tstep : cA; const char* nB = has_next ? (const char*)g.Bt + (size_t)nxt.pn * tstep : cB;
        for (int t = 0; t < nt; t += 2) {
            const bool last = (t == nt - 2);
            const char* a1 = cA + (size_t)(t + 1) * kstep;
            const char* a2 = last ? nA : cA + (size_t)(t + 2) * kstep; const char* b2 = last ? nB : cB + (size_t)(t + 2) * kstep;
            const char* a3 = a2 + kstep; const char* b3 = b2 + kstep;
            if (last && has_next) S.a_ready(nxt);
            if constexpr (SP2) {
            PG8_LDB(B0, 0, 0); PG8_LDB(B1, 0, 1); PG8_SCHED; PG8_LDA(At, 0, 0); PG8_STAGE(PG8_SA(1, 1), a1 + hstep, voffA);
            PG8_WAIT_V(8); PG8_WAIT_L(0); PG8_BAR; PG8_MMA(0, 0, At, B0); PG8_MMA(0, 1, At, B1); PG8_BAR; PG8_SCHED;
            PG8_LDA(At, 0, 1); PG8_STAGE(PG8_SB(0, 0), b2, voffB); PG8_STAGE(PG8_SB(0, 1), b2 + hstep, voffB); PG8_STAGE(PG8_SA(0, 0), a2, voffA);
            PG8_WAIT_V(8); PG8_WAIT_L(0); PG8_BAR; PG8_MMA(1, 0, At, B0); PG8_MMA(1, 1, At, B1); PG8_BAR; PG8_SCHED;
            PG8_LDB(B0, 1, 0); PG8_LDB(B1, 1, 1); PG8_SCHED; PG8_LDA(At, 1, 0); PG8_STAGE(PG8_SA(0, 1), a2 + hstep, voffA);
            PG8_WAIT_V(8); PG8_WAIT_L(0); PG8_BAR; PG8_MMA(0, 0, At, B0); PG8_MMA(0, 1, At, B1); PG8_BAR; PG8_SCHED;
            PG8_LDA(At, 1, 1); PG8_STAGE(PG8_SB(1, 0), b3, voffB); PG8_STAGE(PG8_SB(1, 1), b3 + hstep, voffB); PG8_STAGE(PG8_SA(1, 0), a3, voffA);
            PG8_WAIT_V(8); PG8_WAIT_L(0); PG8_BAR; PG8_MMA(1, 0, At, B0); PG8_MMA(1, 1, At, B1); PG8_BAR; PG8_SCHED;
            } else {
            PG8_LDB(B0, 0, 0); PG8_SCHED; PG8_LDA(At, 0, 0); PG8_STAGE(PG8_SA(1, 1), a1 + hstep, voffA);
            PG8_WAIT_L(8); PG8_BAR; PG8_WAIT_L(0); PG8_MMA(0, 0, At, B0); PG8_BAR; PG8_SCHED;
            PG8_LDB(B1, 0, 1); PG8_STAGE(PG8_SB(0, 0), b2, voffB);
            PG8_BAR; PG8_WAIT_L(0); PG8_MMA(0, 1, At, B1); PG8_BAR;
            PG8_LDA(At, 0, 1); PG8_STAGE(PG8_SA(0, 0), a2, voffA);
            PG8_BAR; PG8_WAIT_L(0); PG8_MMA(1, 0, At, B0); PG8_BAR; PG8_SCHED;
            PG8_STAGE(PG8_SB(0, 1), b2 + hstep, voffB);
            PG8_WAIT_V(6); PG8_BAR; PG8_MMA(1, 1, At, B1); PG8_BAR;
            PG8_LDB(B0, 1, 0); PG8_SCHED; PG8_LDA(At, 1, 0); PG8_STAGE(PG8_SA(0, 1), a2 + hstep, voffA);
            PG8_WAIT_L(8); PG8_BAR; PG8_WAIT_L(0); PG8_MMA(0, 0, At, B0); PG8_BAR; PG8_SCHED;
            PG8_LDB(B1, 1, 1); PG8_STAGE(PG8_SB(1, 0), b3, voffB);
            PG8_BAR; PG8_WAIT_L(0); PG8_MMA(0, 1, At, B1); PG8_BAR;
            PG8_LDA(At, 1, 1); PG8_STAGE(PG8_SA(1, 0), a3, voffA);
            PG8_BAR; PG8_WAIT_L(0); PG8_MMA(1, 0, At, B0); PG8_BAR; PG8_SCHED;
            PG8_STAGE(PG8_SB(1, 1), b3 + hstep, voffB);
            PG8_WAIT_V(6); PG8_BAR; PG8_MMA(1, 1, At, B1); PG8_BAR;
            }
        }
        if constexpr (ALIGN_EPI) { if (wr == 0) PG8_BAR; }
        if constexpr (!Epi::AFTER_DRAIN) { E(acc, cur, wr, wc, fr, fq); S.done(cur); }
        if (!has_next) break;
#pragma unroll
        for (int a = 0; a < 2; ++a)
#pragma unroll
            for (int b = 0; b < 2; ++b)
#pragma unroll
                for (int m = 0; m < 4; ++m)
#pragma unroll
                    for (int n = 0; n < 2; ++n) acc[a][b][m][n] = (f32x4){0.f, 0.f, 0.f, 0.f};
        cur = nxt; cA = nA; cB = nB; ++ui;
        if constexpr (ALIGN_EPI) { if (wr == 1) PG8_BAR; }
    }
    PG8_WAIT_V(0);
    if constexpr (!ALIGN_EPI) { if (wr == 0) PG8_BAR; }
    PG8_BAR;
    if constexpr (Epi::AFTER_DRAIN) { E.fused(acc, cur, wr, wc, fr, fq, lds, wid, lane); S.done(cur); }
#undef PG8_SA
#undef PG8_SB
#undef PG8_STAGE
#undef PG8_LDA
#undef PG8_LDB
#undef PG8_MMA
#undef PG8_WAIT_V
#undef PG8_WAIT_L
#undef PG8_BAR
#undef PG8_SCHED
}
}


__device__ __forceinline__ unsigned pk2h(float lo, float hi) { typedef _Float16 h2 __attribute__((ext_vector_type(2))); h2 v; v.x = (_Float16)lo; v.y = (_Float16)hi; return __builtin_bit_cast(unsigned, v); }

struct EpiP1 {
    static constexpr bool PERM = true, AFTER_DRAIN = false;
    u16 *U, *SG, *Q, *GA, *QI, *K, *V, *KI; float* WI; const float *qnw, *knw; const float2* rope;
    __device__ __forceinline__ void operator()(const f32x4 (&acc)[2][2][4][2], const pg8::Unit& u, int wr, int wc, int fr, int fq) const {
        const int g = u.pn * 4 + wc;
        if (g > 45) return;
        int mode, ld; u16* dst; const float* nwp = qnw; float osc = 1.f;
        if (g < 8) { mode = 0; dst = U + g * 64; ld = 512; }
        else if (g < 16) { mode = 1; dst = SG + (g - 8) * 64; ld = 512; }
        else if (g < 24) { mode = 2; dst = Q + (g - 16) * 64; ld = 512; osc = QSCALE; }
        else if (g < 26) { mode = 2; dst = K + (g - 24) * 64; ld = 128; nwp = knw; }
        else if (g < 28) { mode = 5; dst = V; ld = 128; }
        else if (g < 36) { mode = 1; dst = GA + (g - 28) * 64; ld = 512; }
        else if (g < 44) { mode = 3; dst = QI + (g - 36) * 64; ld = 512; }
        else if (g == 44) { mode = 3; dst = KI; ld = 64; }
        else { mode = 4; dst = KI; ld = 64; }
        const int row0 = u.pm * 256 + wr * 64 + fr;
        if (mode == 5) {
            const int kvh = g - 26;
#pragma unroll
            for (int ai = 0; ai < 2; ++ai)
#pragma unroll
                for (int m = 0; m < 4; ++m) {
                    const int t = row0 + ai * 128 + m * 16, bb = t >> 11, pos = t & (SEQ - 1), pp = (pos & ~12) | ((pos & 4) << 1) | ((pos & 8) >> 1);
                    u16* vp = dst + ((size_t)((bb * 2 + kvh) * 64 + 8 * fq)) * SEQ + pp;
#pragma unroll
                    for (int bj = 0; bj < 2; ++bj)
#pragma unroll
                        for (int n = 0; n < 2; ++n)
#pragma unroll
                            for (int j = 0; j < 4; ++j) vp[(size_t)(32 * bj + 4 * n + j) * SEQ] = f2h(acc[ai][bj][m][n][j]);
                }
            return;
        }
        if (mode == 4) {
            if (fq == 0) {
#pragma unroll
                for (int ai = 0; ai < 2; ++ai)
#pragma unroll
                    for (int m = 0; m < 4; ++m) { float* wp = WI + (size_t)(row0 + ai * 128 + m * 16) * 8; *(f32x4*)wp = acc[ai][0][m][0]; *(f32x4*)(wp + 4) = acc[ai][0][m][1]; }
            }
            return;
        }
        f32x4 nlo0 = {1.f, 1.f, 1.f, 1.f}, nlo1 = nlo0, nhi0 = nlo0, nhi1 = nlo0;
        if (mode == 2) { nlo0 = *(const f32x4*)(nwp + 8 * fq); nlo1 = *(const f32x4*)(nwp + 8 * fq + 4); nhi0 = *(const f32x4*)(nwp + 32 + 8 * fq); nhi1 = *(const f32x4*)(nwp + 36 + 8 * fq); }
#pragma unroll
        for (int ai = 0; ai < 2; ++ai)
#pragma unroll
            for (int m = 0; m < 4; ++m) {
                const int t = row0 + ai * 128 + m * 16;
                f32x4 a0 = acc[ai][0][m][0], a1 = acc[ai][0][m][1], b0 = acc[ai][1][m][0], b1 = acc[ai][1][m][1];
                if (mode == 1) {
#pragma unroll
                    for (int j = 0; j < 4; ++j) { a0[j] = silu_f(a0[j]); a1[j] = silu_f(a1[j]); b0[j] = silu_f(b0[j]); b1[j] = silu_f(b1[j]); }
                } else if (mode >= 2) {
                    if (mode == 2) {
                        float ss = 0.f;
#pragma unroll
                        for (int j = 0; j < 4; ++j) ss += a0[j] * a0[j] + a1[j] * a1[j] + b0[j] * b0[j] + b1[j] * b1[j];
                        ss += __shfl_xor(ss, 16); ss += __shfl_xor(ss, 32);
                        const float rinv = rsqrtf(ss * (1.f / 64.f) + EPS);
                        a0 = a0 * rinv * nlo0; a1 = a1 * rinv * nlo1; b0 = b0 * rinv * nhi0; b1 = b1 * rinv * nhi1;
                    }
                    const f32x4* rp = (const f32x4*)(rope + (size_t)(t & (SEQ - 1)) * 32 + 8 * fq);
                    const f32x4 r0 = rp[0], r1 = rp[1], r2 = rp[2], r3 = rp[3];
                    f32x4 o0, o1, p0, p1;
                    o0[0] = a0[0] * r0[0] - b0[0] * r0[1]; p0[0] = b0[0] * r0[0] + a0[0] * r0[1];
                    o0[1] = a0[1] * r0[2] - b0[1] * r0[3]; p0[1] = b0[1] * r0[2] + a0[1] * r0[3];
                    o0[2] = a0[2] * r1[0] - b0[2] * r1[1]; p0[2] = b0[2] * r1[0] + a0[2] * r1[1];
                    o0[3] = a0[3] * r1[2] - b0[3] * r1[3]; p0[3] = b0[3] * r1[2] + a0[3] * r1[3];
                    o1[0] = a1[0] * r2[0] - b1[0] * r2[1]; p1[0] = b1[0] * r2[0] + a1[0] * r2[1];
                    o1[1] = a1[1] * r2[2] - b1[1] * r2[3]; p1[1] = b1[1] * r2[2] + a1[1] * r2[3];
                    o1[2] = a1[2] * r3[0] - b1[2] * r3[1]; p1[2] = b1[2] * r3[0] + a1[2] * r3[1];
                    o1[3] = a1[3] * r3[2] - b1[3] * r3[3]; p1[3] = b1[3] * r3[2] + a1[3] * r3[3];
                    a0 = o0 * osc; a1 = o1 * osc; b0 = p0 * osc; b1 = p1 * osc;
                }
                u16* dp = dst + (size_t)t * ld + 8 * fq;
                v4u lo, hi; lo.x = pk2h(a0[0], a0[1]); lo.y = pk2h(a0[2], a0[3]); lo.z = pk2h(a1[0], a1[1]); lo.w = pk2h(a1[2], a1[3]);
                hi.x = pk2h(b0[0], b0[1]); hi.y = pk2h(b0[2], b0[3]); hi.z = pk2h(b1[0], b1[1]); hi.w = pk2h(b1[2], b1[3]);
                *(v4u*)dp = lo; *(v4u*)(dp + 32) = hi;
                if (m & 1) asm volatile("" ::: "memory");
            }
    }
};
struct EpiOut {
    static constexpr bool PERM = true, AFTER_DRAIN = false;
    const float* x; const float* gate; float* out;
    __device__ __forceinline__ void operator()(const f32x4 (&acc)[2][2][4][2], const pg8::Unit& u, int wr, int wc, int fr, int fq) const {
        const int row0 = u.pm * 256 + wr * 64 + fr, col0 = u.pn * 256 + wc * 32 + 8 * fq, b = (u.pm * 256) >> 11;
        f32x4 gv[2][2];
#pragma unroll
        for (int bj = 0; bj < 2; ++bj)
#pragma unroll
            for (int n = 0; n < 2; ++n) gv[bj][n] = *(const f32x4*)(gate + b * 3072 + col0 + bj * 128 + 4 * n);
#pragma unroll
        for (int ai = 0; ai < 2; ++ai)
#pragma unroll
            for (int m = 0; m < 4; ++m) {
                const size_t off = (size_t)(row0 + ai * 128 + m * 16) * DM + col0;
#pragma unroll
                for (int bj = 0; bj < 2; ++bj)
#pragma unroll
                    for (int n = 0; n < 2; ++n) { const f32x4 xv = *(const f32x4*)(x + off + bj * 128 + 4 * n); *(f32x4*)(out + off + bj * 128 + 4 * n) = xv + gv[bj][n] * acc[ai][bj][m][n]; }
                if (m & 1) asm volatile("" ::: "memory");
            }
    }
};

__device__ __forceinline__ void p1_epilogue_row(const Ctx& C, int g, int t, int sub, const LAS float* tr) {
    const int pos = t & (SEQ - 1);
    if (g < 8) {
        for (int c = 16 * sub; c < 16 * sub + 16; ++c) C.U[(size_t)t * 512 + g * 64 + c] = f2h(tr[c]);
    } else if (g < 16) {
        for (int c = 16 * sub; c < 16 * sub + 16; ++c) C.SG[(size_t)t * 512 + (g - 8) * 64 + c] = f2h(silu_f(tr[c]));
    } else if (g < 26) {
        float ss = 0.f;
        for (int c = 16 * sub; c < 16 * sub + 16; ++c) ss += tr[c] * tr[c];
        ss += __shfl_xor(ss, 1); ss += __shfl_xor(ss, 2);
        const float rinv = rsqrtf(ss * (1.f / 64.f) + EPS);
        const bool isq = g < 24; const float* nwp = isq ? C.qnw : C.knw; const float osc = isq ? QSCALE : 1.f;
        u16* dst = isq ? C.Q + (size_t)t * 512 + (g - 16) * 64 : C.K + (size_t)t * 128 + (g - 24) * 64;
        for (int i = 8 * sub; i < 8 * sub + 8; ++i) {
            const float x1 = tr[i] * rinv * nwp[i], x2 = tr[i + 32] * rinv * nwp[i + 32];
            const float2 cs = C.rope[pos * 32 + i];
            dst[i] = f2h((x1 * cs.x - x2 * cs.y) * osc); dst[i + 32] = f2h((x2 * cs.x + x1 * cs.y) * osc);
        }
    } else if (g < 28) {
        for (int c = 16 * sub; c < 16 * sub + 16; ++c) C.V[(size_t)t * 128 + (g - 26) * 64 + c] = f2h(tr[c]);
    } else if (g < 36) {
        for (int c = 16 * sub; c < 16 * sub + 16; ++c) C.GA[(size_t)t * 512 + (g - 28) * 64 + c] = f2h(silu_f(tr[c]));
    } else if (g < 45) {
        u16* dst = g < 44 ? C.QI + (size_t)t * 512 + (g - 36) * 64 : C.KI + (size_t)t * 64;
        for (int i = 8 * sub; i < 8 * sub + 8; ++i) {
            const float x1 = tr[i], x2 = tr[i + 32];
            const float2 cs = C.rope[pos * 32 + i];
            dst[i] = f2h(x1 * cs.x - x2 * cs.y); dst[i + 32] = f2h(x2 * cs.x + x1 * cs.y);
        }
    } else {
        if (sub == 0) for (int c = 0; c < 8; ++c) C.WI[(size_t)t * 8 + c] = tr[c];
    }
}
__device__ __forceinline__ void phase1_naive(const Ctx& C) {
    LAS float* tile = (LAS float*)C.lds;
    for (int u = C.bid; u < 46 * 128; u += C.G) {
        const int g = u % 46, r0 = (u / 46) * 128, w = C.wave, lane = C.lane, wr = w & 3, wcn = w >> 2;
        const u16* ap = C.XN + (size_t)(r0 + wr * 32 + (lane & 31)) * DM + 8 * (lane >> 5);
        const u16* bp = C.WinT + (size_t)(g * 64 + wcn * 32 + (lane & 31)) * DM + 8 * (lane >> 5);
        f32x16 acc;
#pragma unroll
        for (int r = 0; r < 16; ++r) acc[r] = 0.f;
        for (int k0 = 0; k0 < DM; k0 += 16) {
            const h16x8 a = *(const h16x8*)(ap + k0), bb = *(const h16x8*)(bp + k0);
            acc = __builtin_amdgcn_mfma_f32_32x32x16_f16(a, bb, acc, 0, 0, 0);
        }
        __syncthreads();
#pragma unroll
        for (int r = 0; r < 16; ++r) tile[(wr * 32 + (r & 3) + 8 * (r >> 2) + 4 * (lane >> 5)) * 65 + wcn * 32 + (lane & 31)] = acc[r];
        __syncthreads();
        const int row = C.tid >> 2, sub = C.tid & 3;
        p1_epilogue_row(C, g, r0 + row, sub, tile + row * 65);
    }
}

__device__ __forceinline__ void pool_unit_naive(const Ctx& C, int u) {
    LAS float* pl = (LAS float*)C.lds;
    const int t0 = (u >> 2) * 64, g = u & 3, tid = C.tid, win = 2 << g;
    __syncthreads();
    for (int idx = tid; idx < 64 * 128; idx += NTH) {
        const int tl = idx >> 7, c = idx & 127, t = t0 + tl, pos = t & (SEQ - 1);
        const int cnt = (pos + 1 < win) ? pos + 1 : win;
        float s = 0.f;
        for (int j = 0; j < cnt; ++j) s += h2f(C.U[(size_t)(t - j) * 512 + g * 128 + c]);
        pl[tl * 128 + c] = s / (float)cnt - h2f(C.U[(size_t)t * 512 + g * 128 + c]);
    }
    __syncthreads();
    const int d = tid & 127, rh = tid >> 7;
    float acc[16];
#pragma unroll
    for (int i = 0; i < 16; ++i) acc[i] = 0.f;
    const float* wp = C.w_pool + (size_t)g * 128 * 128 + d;
    for (int c = 0; c < 128; ++c) {
        const float wv = wp[(size_t)c * 128];
#pragma unroll
        for (int i = 0; i < 16; ++i) acc[i] += pl[(rh * 16 + i) * 128 + c] * wv;
    }
    const float ps = C.pool_scale[g * 128 + d];
#pragma unroll
    for (int i = 0; i < 16; ++i) {
        const int t = t0 + rh * 16 + i;
        C.MIX[(size_t)t * 1024 + g * 128 + d] = f2h(acc[i] * ps * h2f(C.SG[(size_t)t * 512 + g * 128 + d]));
    }
}


__device__ __forceinline__ int pswz(int row, int ch) { return row * 256 + ((ch ^ (row & 15)) << 4); }
__device__ __forceinline__ void pool_unit(const Ctx& C, int u) {
    LAS unsigned char* L = C.lds;
    const int t0 = (u >> 2) * 128, g = u & 3, win = 2 << g, w = C.wave, lane = C.lane;
    __syncthreads();
    {
        const int cp = lane, c0 = 2 * cp;
        const int tb = t0 + 16 * w, pos0 = tb & (SEQ - 1);
        const u16* up = C.U + (size_t)tb * 512 + g * 128 + c0;
        float s0 = 0.f, s1 = 0.f;
        const int npre = pos0 < win ? pos0 : win;
        for (int j = 1; j <= npre; ++j) { const unsigned v = *(const unsigned*)(up - (size_t)j * 512); s0 += h2f((u16)(v & 0xffffu)); s1 += h2f((u16)(v >> 16)); }
#pragma unroll 4
        for (int i = 0; i < 16; ++i) {
            const int pos = pos0 + i;
            const unsigned v = *(const unsigned*)(up + (size_t)i * 512);
            const float a0 = h2f((u16)(v & 0xffffu)), a1 = h2f((u16)(v >> 16));
            s0 += a0; s1 += a1;
            if (pos >= win) { const unsigned vo = *(const unsigned*)(up + (size_t)(i - win) * 512); s0 -= h2f((u16)(vo & 0xffffu)); s1 -= h2f((u16)(vo >> 16)); }
            const float cnt = (float)(pos + 1 < win ? pos + 1 : win);
            const int row = 16 * w + i;
            *(LAS unsigned*)(L + pswz(row, c0 >> 3) + (c0 & 7) * 2) = pk2h(s0 / cnt - a0, s1 / cnt - a1);
        }
    }
    __syncthreads();
    const int q32 = lane & 31, half = lane >> 5, dt = w & 3, tp = w >> 2;
    h16x8 af[8];
    const u16* wp = C.WpT + ((size_t)g * 128 + 32 * dt + q32) * 128 + 8 * half;
#pragma unroll
    for (int ks = 0; ks < 8; ++ks) af[ks] = *(const h16x8*)(wp + 16 * ks);
    const int d0 = g * 128 + 32 * dt + 4 * half;
#pragma unroll
    for (int tt = 0; tt < 2; ++tt) {
        const int trow = 64 * tp + 32 * tt + q32;
        f32x16 acc;
#pragma unroll
        for (int r = 0; r < 16; ++r) acc[r] = 0.f;
#pragma unroll
        for (int ks = 0; ks < 8; ++ks) {
            const h16x8 bf = *(const LAS h16x8*)(L + pswz(trow, 2 * ks + half));
            acc = __builtin_amdgcn_mfma_f32_32x32x16_f16(af[ks], bf, acc, 0, 0, 0);
        }
        const int t = t0 + trow;
#pragma unroll
        for (int g4 = 0; g4 < 4; ++g4) {
            const int d = d0 + 8 * g4;
            const f32x4 ps = *(const f32x4*)(C.pool_scale + d);
            const uint2 gv = *(const uint2*)(C.SG + (size_t)t * 512 + d);
            uint2 ov;
            ov.x = pk2h(acc[4 * g4] * ps[0] * h2f((u16)(gv.x & 0xffffu)), acc[4 * g4 + 1] * ps[1] * h2f((u16)(gv.x >> 16)));
            ov.y = pk2h(acc[4 * g4 + 2] * ps[2] * h2f((u16)(gv.y & 0xffffu)), acc[4 * g4 + 3] * ps[3] * h2f((u16)(gv.y >> 16)));
            *(uint2*)(C.MIX + (size_t)t * 1024 + d) = ov;
        }
    }
}
__device__ __forceinline__ unsigned fkey(float f) { const unsigned u = __float_as_uint(f); return (u & 0x80000000u) ? ~u : (u | 0x80000000u); }
__device__ __forceinline__ int block_sum_int(int v, LAS int* red) {
#pragma unroll
    for (int o = 1; o < 64; o <<= 1) v += __shfl_xor(v, o);
    __syncthreads();
    if ((threadIdx.x & 63) == 0) red[threadIdx.x >> 6] = v;
    __syncthreads();
    return red[0] + red[1] + red[2] + red[3] + red[4] + red[5] + red[6] + red[7];
}

typedef _Float16 h16x8_t __attribute__((ext_vector_type(8)));
__device__ __forceinline__ int stageA_total(LAS int* part, int pp, int w, int fr, int fq, int cnt) {
    cnt += __shfl_xor(cnt, 16); cnt += __shfl_xor(cnt, 32);
    if (fq == 0) part[(pp * 8 + w) * 16 + fr] = cnt;
    __syncthreads();
    int tot = 0;
#pragma unroll
    for (int ww = 0; ww < 8; ++ww) tot += part[(pp * 8 + ww) * 16 + fr];
    return tot;
}
__device__ __forceinline__ void stageA_unit(const Ctx& C, int b, int qb) {
    LAS int* part = (LAS int*)C.lds;
    const int w = C.wave, lane = C.lane, fr = lane & 15, fq = lane >> 4;
    const int pos = 16 * qb + fr, t = b * SEQ + pos;
    __syncthreads();
    h16x8 qf[8][2];
#pragma unroll
    for (int h = 0; h < 8; ++h)
#pragma unroll
        for (int ks = 0; ks < 2; ++ks) qf[h][ks] = *(const h16x8*)(C.QI + (size_t)t * 512 + h * 64 + 32 * ks + 8 * fq);
    float wi[8];
    { const f32x4 w0 = *(const f32x4*)(C.WI + (size_t)t * 8), w1 = *(const f32x4*)(C.WI + (size_t)t * 8 + 4);
      wi[0] = w0[0]; wi[1] = w0[1]; wi[2] = w0[2]; wi[3] = w0[3]; wi[4] = w1[0]; wi[5] = w1[1]; wi[6] = w1[2]; wi[7] = w1[3]; }
    const int nst = (qb >> 1) + 1;
    unsigned key[8][2][4];
#pragma unroll
    for (int i = 0; i < 8; ++i) {
        const int st = w + 8 * i;
#pragma unroll
        for (int tt = 0; tt < 2; ++tt) {
            const int kt = 2 * st + tt;
            if (st < nst && kt <= qb) {
                const u16* kp = C.KI + (size_t)(b * SEQ + 16 * kt + fr) * 64 + 8 * fq;
                const h16x8 a0 = *(const h16x8*)kp, a1 = *(const h16x8*)(kp + 32);
                f32x4 sc = {0.f, 0.f, 0.f, 0.f};
#pragma unroll
                for (int h = 0; h < 8; ++h) {
                    f32x4 acc = {0.f, 0.f, 0.f, 0.f};
                    acc = __builtin_amdgcn_mfma_f32_16x16x32_f16(a0, qf[h][0], acc, 0, 0, 0);
                    acc = __builtin_amdgcn_mfma_f32_16x16x32_f16(a1, qf[h][1], acc, 0, 0, 0);
#pragma unroll
                    for (int r = 0; r < 4; ++r) sc[r] += wi[h] * fmaxf(acc[r], 0.f);
                }
#pragma unroll
                for (int r = 0; r < 4; ++r) key[i][tt][r] = (16 * kt + r <= pos - 4 * fq) ? fkey(sc[r]) : 0u;
            } else {
#pragma unroll
                for (int r = 0; r < 4; ++r) key[i][tt][r] = 0u;
            }
        }
        asm volatile("" ::: "memory");
    }
    bool done = pos < 256; unsigned T = done ? 1u : 0u; int pp = 0;
    for (int bit = 31; bit >= 0; --bit) {
        const unsigned cand = done ? T : (T | (1u << bit));
        int cnt = 0;
#pragma unroll
        for (int i = 0; i < 8; ++i) if (w + 8 * i < nst) {
#pragma unroll
            for (int tt = 0; tt < 2; ++tt)
#pragma unroll
                for (int r = 0; r < 4; ++r) cnt += key[i][tt][r] >= cand ? 1 : 0; }
        const int tot = stageA_total(part, pp, w, fr, fq, cnt); pp ^= 1;
        if (!done && tot >= 256) { T = cand; if (tot == 256) done = true; }
        if (__all(done)) break;
    }
    unsigned J = 2047u;
    if (__any(!done)) {
        int cnt = 0;
#pragma unroll
        for (int i = 0; i < 8; ++i) if (w + 8 * i < nst) {
#pragma unroll
            for (int tt = 0; tt < 2; ++tt)
#pragma unroll
                for (int r = 0; r < 4; ++r) cnt += key[i][tt][r] > T ? 1 : 0; }
        const int need = 256 - stageA_total(part, pp, w, fr, fq, cnt); pp ^= 1;
        unsigned Jt = 0u;
        for (int bit = 10; bit >= 0; --bit) {
            const unsigned cj = Jt | (1u << bit);
            const int cjl = (int)cj - 4 * fq;
            int c2 = 0;
#pragma unroll
            for (int i = 0; i < 8; ++i) if (w + 8 * i < nst) {
#pragma unroll
                for (int tt = 0; tt < 2; ++tt)
#pragma unroll
                    for (int r = 0; r < 4; ++r) c2 += (key[i][tt][r] == T && (32 * (w + 8 * i) + 16 * tt + r) < cjl) ? 1 : 0; }
            const int tot = stageA_total(part, pp, w, fr, fq, c2); pp ^= 1;
            if (tot < need) Jt = cj;
        }
        if (!done) J = Jt;
    }
    const int Jl = (int)J - 4 * fq;
#pragma unroll
    for (int i = 0; i < 8; ++i) {
        const int st = w + 8 * i; unsigned loc = 0u;
        if (st < nst) {
#pragma unroll
            for (int tt = 0; tt < 2; ++tt)
#pragma unroll
                for (int r = 0; r < 4; ++r) { const unsigned k = key[i][tt][r];
                    if (k > T || (k == T && (32 * st + 16 * tt + r) <= Jl)) loc |= 1u << (4 * tt + r); }
        }
        unsigned bits = ((loc & 15u) << (4 * fq)) | ((loc >> 4) << (16 + 4 * fq));
        bits |= __shfl_xor(bits, 16); bits |= __shfl_xor(bits, 32);
        if (fq == 0) C.MASK[(size_t)t * 64 + st] = bits;
    }
}
__device__ __forceinline__ void stageA_phase(const Ctx& C) {
    for (int bb = C.bid; bb < 256; bb += C.G) {
        const int b = bb >> 5, s = bb & 31;
#pragma unroll 1
        for (int j = 0; j < 4; ++j) stageA_unit(C, b, (j & 1) ? (j * 32 + 31 - s) : (j * 32 + s));
    }
}

__device__ __forceinline__ int swz(int r, int c) { return r * 128 + ((c ^ ((r >> 1) & 7)) << 4); }
__device__ __forceinline__ float maskf(float sv, unsigned mbits, int pos) {
    const unsigned m = (unsigned)(((int)(mbits << (31 - pos))) >> 31);
    return __uint_as_float((__float_as_uint(sv) & m) | (~m & 0xFF800000u));
}
__device__ __forceinline__ h16x8 pack8(const f32x16& p, int b0) {
    typedef __fp16 hh2 __attribute__((ext_vector_type(2)));
    typedef unsigned u4 __attribute__((ext_vector_type(4)));
    u4 v;
    v.x = __builtin_bit_cast(unsigned, (hh2)__builtin_amdgcn_cvt_pkrtz(p[b0], p[b0 + 1])); v.y = __builtin_bit_cast(unsigned, (hh2)__builtin_amdgcn_cvt_pkrtz(p[b0 + 2], p[b0 + 3]));
    v.z = __builtin_bit_cast(unsigned, (hh2)__builtin_amdgcn_cvt_pkrtz(p[b0 + 4], p[b0 + 5])); v.w = __builtin_bit_cast(unsigned, (hh2)__builtin_amdgcn_cvt_pkrtz(p[b0 + 6], p[b0 + 7]));
    return __builtin_bit_cast(h16x8, v);
}
__device__ __forceinline__ void stageB_unit(const Ctx& C, int b, int kvh, int qb) {
    LAS unsigned char* L = C.lds;
    const int w = C.wave, lane = C.lane, q32 = lane & 31, half = lane >> 5, h = kvh * 4 + (w & 3);
    const int t = b * SEQ + 64 * qb + 32 * (w >> 2) + q32;
    h16x8 qf[4];
#pragma unroll
    for (int ks = 0; ks < 4; ++ks) qf[ks] = *(const h16x8*)(C.Q + (size_t)t * 512 + h * 64 + 16 * ks + 8 * half);
    f32x16 o0, o1;
#pragma unroll
    for (int r = 0; r < 16; ++r) { o0[r] = 0.f; o1[r] = 0.f; }
    float m_run = -1e30f, l_run = 0.f;
    const int lr = C.tid >> 3, lc = C.tid & 7;
    const u16* kg = C.K + ((size_t)(b * SEQ) + lr) * 128 + kvh * 64 + lc * 8;
    const u16* vg = C.VT + ((size_t)((b * 2 + kvh) * 64 + lr)) * SEQ + lc * 8;
    const int ldsw = swz(lr, lc);
    const unsigned* mg = C.MASK + (size_t)t * 64;
    __syncthreads();
    { const v4u kr = *(const v4u*)kg, vr = *(const v4u*)vg; *(LAS v4u*)(L + ldsw) = kr; *(LAS v4u*)(L + 16384 + ldsw) = vr; }
    uint2 mw = *(const uint2*)mg;
    __syncthreads();
    const int nt = qb + 1;
    const int ra0 = swz(q32, half), ra1 = swz(32 + q32, half);
#pragma unroll 1
    for (int j = 0; j < nt; ++j) {
        const int cur = (j & 1) * 8192;
        const bool more = j + 1 < nt;
        v4u kr = {0u, 0u, 0u, 0u}, vr = {0u, 0u, 0u, 0u}; uint2 mwn = make_uint2(0u, 0u);
        if (more) { kr = *(const v4u*)(kg + (size_t)(j + 1) * 64 * 128); vr = *(const v4u*)(vg + (j + 1) * 64); mwn = *(const uint2*)(mg + 2 * (j + 1)); }
        f32x16 s0, s1;
#pragma unroll
        for (int r = 0; r < 16; ++r) { s0[r] = 0.f; s1[r] = 0.f; }
#pragma unroll
        for (int ks = 0; ks < 4; ++ks) {
            const h16x8 a0 = *(const LAS h16x8*)(L + cur + swz(q32, 2 * ks + half)), a1 = *(const LAS h16x8*)(L + cur + swz(32 + q32, 2 * ks + half));
            s0 = __builtin_amdgcn_mfma_f32_32x32x16_f16(a0, qf[ks], s0, 0, 0, 0);
            s1 = __builtin_amdgcn_mfma_f32_32x32x16_f16(a1, qf[ks], s1, 0, 0, 0);
        }
        const unsigned m0 = mw.x >> (4 * half), m1 = mw.y >> (4 * half);
        float mx = -INFINITY;
#pragma unroll
        for (int r = 0; r < 16; ++r) { const int pos = (r & 3) + 8 * (r >> 2); s0[r] = maskf(s0[r], m0, pos); s1[r] = maskf(s1[r], m1, pos); mx = fmaxf(mx, fmaxf(s0[r], s1[r])); }
        mx = fmaxf(mx, __shfl_xor(mx, 32));
        if (__any(mx > m_run)) {
            const float mn = fmaxf(m_run, mx), alpha = __builtin_amdgcn_exp2f(m_run - mn);
            l_run *= alpha; m_run = mn;
#pragma unroll
            for (int r = 0; r < 16; ++r) { o0[r] *= alpha; o1[r] *= alpha; }
        }
        float ls = 0.f;
#pragma unroll
        for (int r = 0; r < 16; ++r) { s0[r] = __builtin_amdgcn_exp2f(s0[r] - m_run); s1[r] = __builtin_amdgcn_exp2f(s1[r] - m_run); ls += s0[r] + s1[r]; }
        l_run += ls;
        const h16x8 pb0 = pack8(s0, 0), pb1 = pack8(s0, 8), pb2 = pack8(s1, 0), pb3 = pack8(s1, 8);
#pragma unroll
        for (int kc = 0; kc < 4; ++kc) {
            const h16x8 va0 = *(const LAS h16x8*)(L + 16384 + cur + swz(q32, 2 * kc + half)), va1 = *(const LAS h16x8*)(L + 16384 + cur + swz(32 + q32, 2 * kc + half));
            const h16x8 pb = kc == 0 ? pb0 : kc == 1 ? pb1 : kc == 2 ? pb2 : pb3;
            o0 = __builtin_amdgcn_mfma_f32_32x32x16_f16(va0, pb, o0, 0, 0, 0);
            o1 = __builtin_amdgcn_mfma_f32_32x32x16_f16(va1, pb, o1, 0, 0, 0);
        }
        if (more) { *(LAS v4u*)(L + (cur ^ 8192) + ldsw) = kr; *(LAS v4u*)(L + 16384 + (cur ^ 8192) + ldsw) = vr; }
        mw = mwn;
        __syncthreads();
    }
    (void)ra0; (void)ra1;
    l_run += __shfl_xor(l_run, 32);
    const float inv = 1.f / l_run;
    const u16* gp = C.GA + (size_t)t * 512 + h * 64 + 4 * half; u16* mp = C.MIX + (size_t)t * 1024 + 512 + h * 64 + 4 * half;
#pragma unroll
    for (int dt = 0; dt < 2; ++dt)
#pragma unroll
        for (int g4 = 0; g4 < 4; ++g4) {
            const int d0 = 32 * dt + 8 * g4;
            const uint2 gv = *(const uint2*)(gp + d0);
            const float ga0 = h2f((u16)(gv.x & 0xffffu)), ga1 = h2f((u16)(gv.x >> 16)), ga2 = h2f((u16)(gv.y & 0xffffu)), ga3 = h2f((u16)(gv.y >> 16));
            const f32x16& oo = dt ? o1 : o0;
            uint2 ov; ov.x = pk2h(oo[4 * g4] * inv * ga0, oo[4 * g4 + 1] * inv * ga1); ov.y = pk2h(oo[4 * g4 + 2] * inv * ga2, oo[4 * g4 + 3] * inv * ga3);
            *(uint2*)(mp + d0) = ov;
        }
}
__device__ __forceinline__ void stageB_phase(const Ctx& C) {
    for (int bb = C.bid; bb < 256; bb += C.G) {
        const int bk = bb >> 4, s = bb & 15;
        stageB_unit(C, bk >> 1, bk & 1, 31 - s);
        stageB_unit(C, bk >> 1, bk & 1, s);
    }
}
__device__ __forceinline__ void selattn_row_naive(const Ctx& C, int t) {
    LAS float* qs = (LAS float*)C.lds;
    LAS unsigned* keys = (LAS unsigned*)(C.lds + 2048);
    LAS unsigned* mk = (LAS unsigned*)(C.lds + 10240);
    LAS int* wpre = (LAS int*)(C.lds + 10496);
    LAS int* red = (LAS int*)(C.lds + 10816);
    LAS int* sel = (LAS int*)(C.lds + 10880);
    LAS float* p = (LAS float*)(C.lds + 11904);
    LAS float* hl = (LAS float*)(C.lds + 21120);
    const int b = t >> 11, pos = t & (SEQ - 1), n = pos + 1, tid = C.tid;
    __syncthreads();
    if (tid < 64) mk[tid] = C.MASK[(size_t)t * 64 + tid];
    __syncthreads();
    if (tid == 0) { int a = 0; for (int i = 0; i < 64; ++i) { wpre[i] = a; a += __popc(mk[i]); } wpre[64] = a; }
    __syncthreads();
    const int nsel = wpre[64];
    for (int s = tid; s < n; s += NTH) { const unsigned wv = mk[s >> 5]; if ((wv >> (s & 31)) & 1u) sel[wpre[s >> 5] + __popc(wv & ((1u << (s & 31)) - 1u))] = s; }
    for (int i = tid; i < 512; i += NTH) qs[i] = h2f(C.Q[(size_t)t * 512 + i]);
    __syncthreads();
    if (tid < 256) {
        if (tid < nsel) {
            const int s = sel[tid];
#pragma unroll
            for (int kvh = 0; kvh < 2; ++kvh) {
                const u16* kp = C.K + (size_t)(b * SEQ + s) * 128 + kvh * 64;
                float dq[4] = {0.f, 0.f, 0.f, 0.f};
#pragma unroll 1
                for (int i = 0; i < 8; ++i) { const h16x8 v8 = *(const h16x8*)(kp + 8 * i);
#pragma unroll
                    for (int gq = 0; gq < 4; ++gq) {
#pragma unroll
                        for (int j = 0; j < 8; ++j) dq[gq] += qs[(kvh * 4 + gq) * 64 + 8 * i + j] * (float)v8[j]; } }
#pragma unroll
                for (int gq = 0; gq < 4; ++gq) p[tid * 9 + kvh * 4 + gq] = dq[gq];
            }
        } else {
#pragma unroll
            for (int h = 0; h < 8; ++h) p[tid * 9 + h] = -INFINITY;
        }
    }
    __syncthreads();
    {
        const int h = C.wave, lane = C.lane;
        float m = -INFINITY;
        for (int j = lane; j < 256; j += 64) m = fmaxf(m, p[j * 9 + h]);
#pragma unroll
        for (int o2 = 1; o2 < 64; o2 <<= 1) m = fmaxf(m, __shfl_xor(m, o2));
        float l = 0.f;
        for (int j = lane; j < 256; j += 64) { const float e = exp2f(p[j * 9 + h] - m); p[j * 9 + h] = e; l += e; }
        l = wave_sum(l);
        if (lane == 0) hl[h] = l;
    }
    __syncthreads();
    {
        const int h = tid >> 6, d = tid & 63, kvh = h >> 2;
        float a0 = 0.f;
        for (int j = 0; j < nsel; ++j) a0 += p[j * 9 + h] * h2f(C.V[(size_t)(b * SEQ + sel[j]) * 128 + kvh * 64 + d]);
        C.MIX[(size_t)t * 1024 + 512 + h * 64 + d] = f2h(a0 / hl[h] * h2f(C.GA[(size_t)t * 512 + h * 64 + d]));
    }
}

__device__ __forceinline__ void phase3_naive(const Ctx& C) {
    for (int u = C.bid; u < 16 * 128; u += C.G) {
        const int c0 = (u & 15) * 64, r0 = (u >> 4) * 128, w = C.wave, lane = C.lane, wr = w & 3, wcn = w >> 2;
        const u16* ap = C.MIX + (size_t)(r0 + wr * 32 + (lane & 31)) * DM + 8 * (lane >> 5);
        const u16* bp = C.WoutT + (size_t)(c0 + wcn * 32 + (lane & 31)) * DM + 8 * (lane >> 5);
        f32x16 acc;
#pragma unroll
        for (int r = 0; r < 16; ++r) acc[r] = 0.f;
        for (int k0 = 0; k0 < DM; k0 += 16) {
            const h16x8 a = *(const h16x8*)(ap + k0), bb = *(const h16x8*)(bp + k0);
            acc = __builtin_amdgcn_mfma_f32_32x32x16_f16(a, bb, acc, 0, 0, 0);
        }
        const int col = c0 + wcn * 32 + (lane & 31), b = r0 >> 11;
        const float gate = C.mod[b * 3072 + 2048 + col];
#pragma unroll
        for (int r = 0; r < 16; ++r) {
            const int row = r0 + wr * 32 + (r & 3) + 8 * (r >> 2) + 4 * (lane >> 5);
            C.out[(size_t)row * DM + col] = C.x[(size_t)row * DM + col] + gate * acc[r];
        }
    }
}

struct Args { const float* in[11]; float* out; unsigned char* ws; };
__global__ void __launch_bounds__(NTH, 2) mk_fwd(Args a) {
    extern __shared__ __attribute__((aligned(16))) unsigned char lds_raw[];
    Ctx C;
    C.lds = (LAS unsigned char*)lds_raw;
    C.tid = threadIdx.x; C.lane = C.tid & 63; C.wave = __builtin_amdgcn_readfirstlane(C.tid >> 6); C.bid = blockIdx.x; C.G = gridDim.x;
    C.x = a.in[0]; C.c = a.in[1]; C.norm_w = a.in[2]; C.w_ada = a.in[3]; C.b_ada = a.in[4]; C.w_in = a.in[5]; C.qnw = a.in[6]; C.knw = a.in[7];
    C.w_pool = a.in[8]; C.pool_scale = a.in[9]; C.w_out = a.in[10]; C.out = a.out;
    unsigned char* ws = a.ws;
    C.mod = (float*)(ws + WS_MOD); C.rope = (float2*)(ws + WS_ROPE); C.WinT = (u16*)(ws + WS_WINT); C.WoutT = (u16*)(ws + WS_WOUTT); C.XN = (u16*)(ws + WS_XN);
    C.U = (u16*)(ws + WS_U); C.SG = (u16*)(ws + WS_SG); C.Q = (u16*)(ws + WS_Q); C.GA = (u16*)(ws + WS_GA); C.QI = (u16*)(ws + WS_QI);
    C.K = (u16*)(ws + WS_K); C.V = (u16*)(ws + WS_V); C.KI = (u16*)(ws + WS_KI); C.VT = C.V; C.WpT = (u16*)(ws + WS_WPT); C.WI = (float*)(ws + WS_WI); C.MASK = (unsigned*)(ws + WS_MASK); C.MIX = (u16*)(ws + WS_MIX);
    volatile LAS unsigned* MISC = (volatile LAS unsigned*)(C.lds + MISC_OFF);
    for (int u = C.tid; u < (LDS_BYTES - LDSCTL_OFF) / 4; u += NTH) ((LAS unsigned*)(C.lds + LDSCTL_OFF))[u] = 0u;
    __syncthreads();
    XcdBarrier bar = xcd_barrier_post((unsigned*)(ws + WS_CTL) + CW_BAR, MISC + 8);

    phase0(C);
    xcd_barrier(bar);
    phase0b(C);
    xcd_barrier(bar);
    {
        pg8::Gemm g{C.XN, C.WinT, MT, NPAD, DM}; pg8::StaticOrder S; S.init(MT, NPAD, C.G, C.bid);
        EpiP1 E{C.U, C.SG, C.Q, C.GA, C.QI, C.K, C.V, C.KI, C.WI, C.qnw, C.knw, C.rope};
        pg8::gemm_phase<EpiP1, pg8::StaticOrder, true, true>(C.lds, g, S, E);
    }
    xcd_barrier(bar);
    stageA_phase(C);
    for (int u = C.bid; u < 512; u += C.G) pool_unit(C, u);
    xcd_barrier(bar);
    stageB_phase(C);
    xcd_barrier(bar);
    {
        pg8::Gemm g{C.MIX, C.WoutT, MT, DM, DM}; pg8::StaticOrder S; S.init(MT, DM, C.G, C.bid);
        EpiOut E{C.x, C.mod + 2048, C.out};
        pg8::gemm_phase<EpiOut, pg8::StaticOrder, true, true>(C.lds, g, S, E);
    }
}

extern "C" void kernel_launch(void* const* d_in, const int* in_sizes, int n_in, void* d_out, int out_size, void* d_ws, size_t ws_size, hipStream_t stream) {
    (void)in_sizes; (void)out_size;
    static int grid = 0;
    if (grid == 0) {
        if (n_in != 11 || ws_size < WS_END) { fprintf(stderr, "kernel_launch: unexpected inputs / workspace (%d, %zu)\n", n_in, ws_size); grid = -1; return; }
        int dev = 0, cus = 0, per_cu = 0;
        hipGetDevice(&dev); hipDeviceGetAttribute(&cus, hipDeviceAttributeMultiprocessorCount, dev);
        hipFuncSetAttribute((const void*)mk_fwd, hipFuncAttributeMaxDynamicSharedMemorySize, LDS_BYTES);
        hipOccupancyMaxActiveBlocksPerMultiprocessor(&per_cu, (const void*)mk_fwd, NTH, LDS_BYTES);
        (void)hipGetLastError();
        if (per_cu < 1) { fprintf(stderr, "kernel_launch: occupancy query says %d blocks per CU\n", per_cu); per_cu = 1; }
        grid = cus;
    }
    if (grid < 0) return;
    hipMemsetAsync((char*)d_ws + WS_CTL, 0, CTL_ZERO_BYTES, stream);
    Args a{};
    for (int i = 0; i < 11; ++i) a.in[i] = (const float*)d_in[i];
    a.out = (float*)d_out; a.ws = (unsigned char*)d_ws;
    void* kargs[] = {&a};
    hipError_t e = hipLaunchCooperativeKernel((const void*)mk_fwd, dim3(grid), dim3(NTH), kargs, LDS_BYTES, stream);
    if (e != hipSuccess) fprintf(stderr, "kernel_launch: cooperative launch failed: %s (grid %d)\n", hipGetErrorString(e), grid);
}
```

```cpp
#include <hip/hip_runtime.h>
#include <stdint.h>
#include <cstdio>

typedef unsigned short u16;
typedef _Float16 h16x8 __attribute__((ext_vector_type(8)));
typedef float f32x16 __attribute__((ext_vector_type(16)));
typedef float f32x4 __attribute__((ext_vector_type(4)));
typedef unsigned v4u __attribute__((ext_vector_type(4)));
#define LAS __attribute__((address_space(3)))
#define GAS __attribute__((address_space(1)))

constexpr int NB = 8, SEQ = 2048, DM = 1024, MT = NB * SEQ;
constexpr int NPROJ = 2888, NPAD = 3072;
constexpr int NTH = 512, NWAVES = 8;
constexpr float QSCALE = 0.18033688011112042f;
constexpr float EPS = 1e-6f;

constexpr size_t WS_CTL = 0, CTL_ZERO_BYTES = 65536 + (size_t)NB * 3072 * 4;
constexpr size_t WS_MOD = 65536;
constexpr size_t WS_ROPE = WS_MOD + (size_t)NB * 3072 * 4;
constexpr size_t WS_WINT = WS_ROPE + (size_t)SEQ * 32 * 8;
constexpr size_t WS_WOUTT = WS_WINT + (size_t)NPAD * DM * 2;
constexpr size_t WS_XN = WS_WOUTT + (size_t)DM * DM * 2;
constexpr size_t WS_U = WS_XN + (size_t)MT * DM * 2;
constexpr size_t WS_SG = WS_U + (size_t)MT * 512 * 2;
constexpr size_t WS_Q = WS_SG + (size_t)MT * 512 * 2;
constexpr size_t WS_GA = WS_Q + (size_t)MT * 512 * 2;
constexpr size_t WS_QI = WS_GA + (size_t)MT * 512 * 2;
constexpr size_t WS_K = WS_QI + (size_t)MT * 512 * 2;
constexpr size_t WS_V = WS_K + (size_t)MT * 128 * 2;
constexpr size_t WS_KI = WS_V + (size_t)MT * 128 * 2;
constexpr size_t WS_WI = WS_KI + (size_t)MT * 64 * 2;
constexpr size_t WS_MASK = WS_WI + (size_t)MT * 8 * 4;
constexpr size_t WS_MIX = WS_MASK + (size_t)MT * 64 * 4;
constexpr size_t WS_WPT = WS_MIX + (size_t)MT * DM * 2;
constexpr size_t WS_END = WS_WPT + (size_t)4 * 128 * 128 * 2;
constexpr int CW_BAR = 1024;
constexpr int CW_QA = 8192, CW_QB = 8192 + 64;


#ifndef ECHO
#define ECHO -1
#endif
#ifndef ECHOM
#define ECHOM (1u << (ECHO < 0 ? 31 : ECHO))
#endif
#define TS(k) do { if (ECHO >= 0 && threadIdx.x == 0) { volatile LAS unsigned long long* tsb_ = (volatile LAS unsigned long long*)(C.lds + LDSCTL_OFF + 512); \
    const unsigned long long t_ = __builtin_amdgcn_s_memtime(); tsb_[(k)] += t_ - tsb_[31]; tsb_[31] = t_; } } while (0)
constexpr int LDS_BYTES = 147456;
constexpr int LDSCTL_OFF = LDS_BYTES - 1024, MISC_OFF = LDSCTL_OFF + 320;
__device__ __forceinline__ u16 f2h(float f) { return __builtin_bit_cast(u16, (_Float16)f); }
__device__ __forceinline__ float h2f(u16 h) { return (float)__builtin_bit_cast(_Float16, h); }
__device__ __forceinline__ float silu_f(float v) { return v / (1.f + __expf(-v)); }
__device__ __forceinline__ float wave_sum(float v) {
#pragma unroll
    for (int o = 1; o < 64; o <<= 1) v += __shfl_xor(v, o);
    return v;
}

__constant__ double ROPE_FREQ[32] = {1.0,0.7498942093324559,0.5623413251903491,0.4216965034285822,0.31622776601683794,0.23713737056616552,0.1778279410038923,0.1333521432163324,0.1,0.07498942093324558,0.05623413251903491,0.042169650342858224,0.03162277660168379,0.023713737056616554,0.01778279410038923,0.01333521432163324,0.01,0.007498942093324558,0.005623413251903491,0.004216965034285823,0.0031622776601683794,0.0023713737056616554,0.0017782794100389228,0.001333521432163324,0.001,0.0007498942093324559,0.0005623413251903491,0.00042169650342858224,0.00031622776601683794,0.00023713737056616554,0.00017782794100389227,0.0001333521432163324};

#define XB_TMO      128
#define XB_XCNT(j)  (256  + 64 * (j))
#define XB_XSUB(j)  (1280 + 64 * (j))
#define XB_XGEN(j)  (2304 + 64 * (j))
#define XB_TOP      3328
#define XB_TOPGEN   3392
#define XCD_BAR_WORDS 3456
#define XB_SPIN_CAP (1u << 18)

__device__ __forceinline__ unsigned xb_ld(unsigned* p)              { return __hip_atomic_load(p, __ATOMIC_RELAXED, __HIP_MEMORY_SCOPE_AGENT); }
__device__ __forceinline__ unsigned xb_add(unsigned* p, unsigned v) { return __hip_atomic_fetch_add(p, v, __ATOMIC_RELAXED, __HIP_MEMORY_SCOPE_AGENT); }
__device__ __forceinline__ unsigned xb_xcc_id() { return (unsigned)__builtin_amdgcn_s_getreg((3 << 11) | 20) & 0xFu; }
#define XB_SPIN(cond, bar) do { unsigned _sp = 0; while (cond) { __builtin_amdgcn_s_sleep(1); \
    if ((++_sp & 255u) == 0u) { if (xb_ld(&(bar)[XB_TMO])) break; if (_sp > XB_SPIN_CAP) { atomicAdd(&(bar)[XB_TMO], 1u); break; } } } } while (0)

struct XcdBarrier {
    unsigned* bar; unsigned x;
    volatile LAS unsigned* st;
};

__device__ __forceinline__ XcdBarrier xcd_barrier_post(unsigned* bar, volatile LAS unsigned* st) {
    XcdBarrier b; b.bar = bar; b.x = xb_xcc_id(); b.st = st;
    if (threadIdx.x == 0) (void)xb_add(&bar[XB_XCNT(b.x)], 1u);
    return b;
}
__device__ __forceinline__ void xcd_barrier_complete(unsigned* bar, unsigned x, unsigned& nloc, unsigned& nx) {
    const unsigned G = gridDim.x * gridDim.y * gridDim.z;
    unsigned sum, cnt, mine, sp = 0u;
    for (;;) {
        sum = 0u; cnt = 0u; mine = 0u;
#pragma unroll
        for (unsigned j = 0; j < 16; ++j) { const unsigned c = xb_ld(&bar[XB_XCNT(j)]); sum += c; cnt += (c > 0u) ? 1u : 0u; mine = (j == x) ? c : mine; }
        if (sum == G) break;
        __builtin_amdgcn_s_sleep(1);
        if ((++sp & 255u) == 0u) { if (xb_ld(&bar[XB_TMO])) break; if (sp > XB_SPIN_CAP) { atomicAdd(&bar[XB_TMO], 1u); break; } }
    }
    nloc = mine > 0u ? mine : 1u; nx = cnt > 0u ? cnt : 1u;
}

__device__ __forceinline__ void xcd_barrier(const XcdBarrier& b) {
    asm volatile("s_waitcnt vmcnt(0)" ::: "memory");
    __syncthreads();
    if (threadIdx.x == 0) {
        unsigned* bar = b.bar;
        __builtin_amdgcn_s_waitcnt(0);
        unsigned nloc = b.st[0], nx = b.st[1];
        if (nloc == 0u) { xcd_barrier_complete(bar, b.x, nloc, nx); b.st[0] = nloc; b.st[1] = nx; }
        const unsigned old = xb_add(&bar[XB_XSUB(b.x)], 1u);
        const unsigned gen = old / nloc;
        if (old + 1u == (gen + 1u) * nloc) {
            __builtin_amdgcn_fence(__ATOMIC_RELEASE, "agent");
            asm volatile("s_waitcnt vmcnt(0)" ::: "memory");
            const unsigned og = xb_add(&bar[XB_TOP], 1u);
            const unsigned tg = og / nx;
            if (og + 1u == (tg + 1u) * nx) xb_add(&bar[XB_TOPGEN], 1u);
            else XB_SPIN(xb_ld(&bar[XB_TOPGEN]) == tg, bar);
            __builtin_amdgcn_fence(__ATOMIC_ACQUIRE, "agent");
            xb_add(&bar[XB_XGEN(b.x)], 1u);
            asm volatile("s_waitcnt vmcnt(0)" ::: "memory");
        } else {
            XB_SPIN(xb_ld(&bar[XB_XGEN(b.x)]) == gen, bar);
            __builtin_amdgcn_fence(__ATOMIC_ACQUIRE, "agent");
            asm volatile("s_waitcnt vmcnt(0)" ::: "memory");
        }
    }
    __syncthreads();
}


struct Ctx {
    const float *x, *c, *norm_w, *w_ada, *b_ada, *w_in, *qnw, *knw, *w_pool, *pool_scale, *w_out;
    float* out;
    float* mod; float2* rope; u16 *WinT, *WoutT, *XN, *U, *SG, *Q, *GA, *QI, *K, *V, *KI, *VT, *WpT; float* WI; unsigned* MASK; u16* MIX;
    LAS unsigned char* lds;
    int tid, lane, wave, bid, G;
};

__device__ __forceinline__ unsigned pk2h(float lo, float hi);
__device__ __forceinline__ void p0_mod_unit(const Ctx& C, int u) {
    LAS float* sc = (LAS float*)C.lds;
    const int nb = u >> 4, ks = u & 15, d0 = ks * 64;
    __syncthreads();
    { const int bb = C.tid >> 6, dd = C.tid & 63; sc[C.tid] = silu_f(C.c[bb * DM + d0 + dd]); }
    __syncthreads();
    const int col = nb * 256 + (C.tid & 255), bh = (C.tid >> 8) * 4;
    float a0 = 0.f, a1 = 0.f, a2 = 0.f, a3 = 0.f;
    const float* wp = C.w_ada + (size_t)d0 * 3072 + col;
#pragma unroll 8
    for (int d = 0; d < 64; ++d) { const float wv = wp[(size_t)d * 3072]; a0 += sc[(bh + 0) * 64 + d] * wv; a1 += sc[(bh + 1) * 64 + d] * wv; a2 += sc[(bh + 2) * 64 + d] * wv; a3 += sc[(bh + 3) * 64 + d] * wv; }
    if (ks == 0) { const float bv = C.b_ada[col]; a0 += bv; a1 += bv; a2 += bv; a3 += bv; }
    atomicAdd(C.mod + (bh + 0) * 3072 + col, a0); atomicAdd(C.mod + (bh + 1) * 3072 + col, a1); atomicAdd(C.mod + (bh + 2) * 3072 + col, a2); atomicAdd(C.mod + (bh + 3) * 3072 + col, a3);
}
__device__ __forceinline__ void p0_rope_unit(const Ctx& C, int u) {
    const int idx = u * NTH + C.tid, pos = idx >> 5, i = idx & 31;
    const double ang = (double)pos * ROPE_FREQ[i];
    double t = ang * 0.15915494309189533576888;
    t -= floor(t + 0.5);
    const double x = t * 6.283185307179586476925287, x2 = x * x;
    double s = 0.0, cc = 0.0, ts = x, tc = 1.0;
#pragma unroll 1
    for (int n = 0; n < 14; ++n) { cc += tc; s += ts; tc *= -x2 / (double)((2 * n + 1) * (2 * n + 2)); ts *= -x2 / (double)((2 * n + 2) * (2 * n + 3)); }
    C.rope[idx] = make_float2((float)cc, (float)s);
}
__device__ __forceinline__ void p0_conv_item(const Ctx& C, const float* W, int N, u16* WT, int Kdim, bool perm, LAS float* scr, int item) {
    const int lane = C.lane, nkb = Kdim >> 6, kb = item % nkb, nb = item / nkb, k0 = 64 * kb, n0 = 32 * nb;
    const int nn = lane & 31, n = n0 + nn;
#pragma unroll 8
    for (int i = 0; i < 32; ++i) { const int kk = 2 * i + (lane >> 5); scr[kk * 33 + nn] = n < N ? W[(size_t)(k0 + kk) * N + n] : 0.f; }
    asm volatile("s_waitcnt lgkmcnt(0)" ::: "memory");
    const int c = lane & 7;
#pragma unroll
    for (int j = 0; j < 4; ++j) {
        const int nr = (lane >> 3) + 8 * j; const LAS float* sp = scr + (8 * c) * 33 + nr;
        v4u o; o.x = pk2h(sp[0 * 33], sp[1 * 33]); o.y = pk2h(sp[2 * 33], sp[3 * 33]); o.z = pk2h(sp[4 * 33], sp[5 * 33]); o.w = pk2h(sp[6 * 33], sp[7 * 33]);
        const int nl = n0 + nr, np = perm ? ((nl & ~255) | (((nl >> 5) & 1) << 7) | (((nl >> 6) & 3) << 5) | (nl & 31)) : nl;
        *(v4u*)(WT + (size_t)np * Kdim + k0 + 8 * c) = o;
    }
    asm volatile("s_waitcnt lgkmcnt(0)" ::: "memory");
}
__device__ __forceinline__ void phase0(const Ctx& C) {
    constexpr int U_MOD = 192, U_ROPE = 128;
    for (int u = C.bid; u < U_MOD + U_ROPE; u += C.G) { if (u < U_MOD) p0_mod_unit(C, u); else p0_rope_unit(C, u - U_MOD); }
    __syncthreads();
    LAS float* scr = (LAS float*)(C.lds + C.wave * 16384);
    constexpr int I_WIN = 16 * 96, I_WOUT = 16 * 32, I_WP = 4 * 2 * 4, I_ALL = I_WIN + I_WOUT + I_WP;
    const int gw0 = ((C.bid + 64) % C.G) * NWAVES + C.wave, NGW = C.G * NWAVES;
    for (int it = gw0; it < I_ALL; it += NGW) {
        int r = it;
        if (r < I_WIN) { p0_conv_item(C, C.w_in, NPROJ, C.WinT, DM, true, scr, r); continue; } r -= I_WIN;
        if (r < I_WOUT) { p0_conv_item(C, C.w_out, DM, C.WoutT, DM, false, scr, r); continue; } r -= I_WOUT;
        p0_conv_item(C, C.w_pool + (size_t)(r >> 3) * 128 * 128, 128, C.WpT + (size_t)(r >> 3) * 128 * 128, 128, false, scr, r & 7);
    }
}

__device__ __forceinline__ void phase0b(const Ctx& C) {
    for (int row = C.bid * NWAVES + C.wave; row < MT; row += C.G * NWAVES) {
        const int lane = C.lane, b = row >> 11;
        const float4* xr = (const float4*)(C.x + (size_t)row * DM) + lane;
        float4 v[4]; float s = 0.f;
#pragma unroll
        for (int j = 0; j < 4; ++j) { v[j] = xr[64 * j]; s += v[j].x * v[j].x + v[j].y * v[j].y + v[j].z * v[j].z + v[j].w * v[j].w; }
        const float rstd = rsqrtf(wave_sum(s) * (1.f / DM) + EPS);
        const float* shift = C.mod + b * 3072; const float* scale = shift + 1024;
#pragma unroll
        for (int j = 0; j < 4; ++j) {
            const int k = 4 * lane + 256 * j;
            const float4 w4 = *(const float4*)(C.norm_w + k), s4 = *(const float4*)(scale + k), h4 = *(const float4*)(shift + k);
            const float o0 = v[j].x * rstd * w4.x * (1.f + s4.x) + h4.x, o1 = v[j].y * rstd * w4.y * (1.f + s4.y) + h4.y;
            const float o2 = v[j].z * rstd * w4.z * (1.f + s4.z) + h4.z, o3 = v[j].w * rstd * w4.w * (1.f + s4.w) + h4.w;
            ushort4 o; o.x = f2h(o0); o.y = f2h(o1); o.z = f2h(o2); o.w = f2h(o3);
            *(ushort4*)(C.XN + (size_t)row * DM + k) = o;
        }
    }
}


namespace pg8 {
#define PG8_LAS __attribute__((address_space(3)))
typedef unsigned short bf16_t;
typedef _Float16 bf16x8 __attribute__((ext_vector_type(8)));
typedef float f32x4 __attribute__((ext_vector_type(4)));
typedef unsigned u32x4 __attribute__((ext_vector_type(4)));
constexpr int BM = 256, BK = 64, HALF = 128, HTB = HALF * BK * 2  , STAGE_BYTES = 8 * HTB, NXCD = 8, WGM = 8;

__host__ __device__ __forceinline__ int lds_byte(int r, int c) { const int st = (r >> 4) * 2 + (c >> 5), rr = r & 15, cc = c & 31, ob = rr * 64 + cc * 2; return st * 1024 + (ob ^ (((ob >> 9) & 1) << 5)); }
__host__ __device__ __forceinline__ void stage_rc(int b, int& R, int& C) { const int st = b / 1024, sb = b % 1024, swz = sb ^ (((sb >> 9) & 1) << 5); R = (st >> 1) * 16 + swz / 64; C = (st & 1) * 32 + (swz % 64) / 2; }
__host__ __device__ __forceinline__ int perm32(int rho) { const int n = rho >> 4, i = rho & 15; return 8 * (i >> 2) + 4 * n + (i & 3); }

struct Unit { int pm, pn; };
struct Gemm { const bf16_t* A; const bf16_t* Bt; int M, N, K; };

struct StaticOrder {
    int nM, nN, nwg, G, c;
    __host__ __device__ void init(int M, int N, int G_, int c_) { nM = M / BM; nN = N / BM; nwg = nM * nN; G = G_; c = c_; }
    __host__ __device__ bool next(int i, Unit& u) const {
        const long L = (long)i * G + c; if (L >= nwg) return false;
        int wgid = (int)L; { const int q = nwg / NXCD, r = nwg % NXCD, xcd = wgid % NXCD, off = wgid / NXCD; wgid = (xcd < r ? xcd * (q + 1) : r * (q + 1) + (xcd - r) * q) + off; }
        const int nig = WGM * nN, gid = wgid / nig, fm = gid * WGM, gsz = (nM - fm) < WGM ? (nM - fm) : WGM;
        u.pm = fm + ((wgid % nig) % gsz); u.pn = (wgid % nig) / gsz; return true;
    }
    __device__ __forceinline__ void a_ready(const Unit&) const {}
    __device__ __forceinline__ void done(const Unit&) const {}
};

template <class Epi, class Sched, bool ALIGN_EPI = false, bool SP2 = false>
__device__ __forceinline__ void gemm_phase(PG8_LAS unsigned char* lds, const Gemm g, const Sched& S, const Epi& E) {
    const int tid = threadIdx.x, wid = __builtin_amdgcn_readfirstlane(tid >> 6), lane = tid & 63, wr = wid >> 2, wc = wid & 3, fr = lane & 15, fq = lane >> 4;
    const int K = g.K, nt = K / BK;
    unsigned voffA[2], voffB[2];
#pragma unroll
    for (int i = 0; i < 2; ++i) { int R, C; stage_rc(tid * 16 + i * 8192, R, C); const int Rb = Epi::PERM ? ((R & ~31) + perm32(R & 31)) : R;
        voffA[i] = (unsigned)(R * K + C) * 2u; voffB[i] = (unsigned)(Rb * K + C) * 2u; }
    const size_t kstep = (size_t)(BK * 2);
    const size_t hstep = (size_t)HALF * K * 2;
    const size_t tstep = 2 * hstep;
    const unsigned ldsw = (unsigned)wid * 1024u;
    const int aoff = lds_byte(wr * 64 + fr, fq * 8), boff = lds_byte(wc * 32 + fr, fq * 8);
#define PG8_SA(b, h) (((b) * 2 + (h)) * HTB)
#define PG8_SB(b, h) ((4 + (b) * 2 + (h)) * HTB)
#define PG8_STAGE(bufoff, gbase, voff) do { _Pragma("unroll") for (int _i = 0; _i < 2; ++_i) \
        __builtin_amdgcn_global_load_lds((const unsigned*)((const char*)(gbase) + (voff)[_i]), (PG8_LAS unsigned*)(lds + (bufoff) + ldsw + _i * 8192), 16, 0, 0); } while (0)
#define PG8_LDA(dst, b, h) do { _Pragma("unroll") for (int m = 0; m < 4; ++m) _Pragma("unroll") for (int k = 0; k < 2; ++k) dst[m][k] = *(const PG8_LAS bf16x8*)(lds + PG8_SA(b, h) + aoff + m * 2048 + k * 1024); } while (0)
#define PG8_LDB(dst, b, h) do { _Pragma("unroll") for (int n = 0; n < 2; ++n) _Pragma("unroll") for (int k = 0; k < 2; ++k) dst[n][k] = *(const PG8_LAS bf16x8*)(lds + PG8_SB(b, h) + boff + n * 2048 + k * 1024); } while (0)
#define PG8_MMA(ai, bj, At, Bt) do { __builtin_amdgcn_s_setprio(1); _Pragma("unroll") for (int m = 0; m < 4; ++m) _Pragma("unroll") for (int n = 0; n < 2; ++n) _Pragma("unroll") for (int k = 0; k < 2; ++k) \
        acc[ai][bj][m][n] = __builtin_amdgcn_mfma_f32_16x16x32_f16(Bt[n][k], At[m][k], acc[ai][bj][m][n], 0, 0, 0); __builtin_amdgcn_s_setprio(0); } while (0)
#define PG8_WAIT_V(n) asm volatile("s_waitcnt vmcnt(" #n ")" ::: "memory")
#define PG8_WAIT_L(n) asm volatile("s_waitcnt lgkmcnt(" #n ")" ::: "memory")
#define PG8_BAR __builtin_amdgcn_s_barrier()
#define PG8_SCHED __builtin_amdgcn_sched_barrier(0)
    Unit cur, nxt; int ui = 0;
    if (!S.next(0, cur)) return;
    f32x4 acc[2][2][4][2];
#pragma unroll
    for (int a = 0; a < 2; ++a)
#pragma unroll
        for (int b = 0; b < 2; ++b)
#pragma unroll
            for (int m = 0; m < 4; ++m)
#pragma unroll
                for (int n = 0; n < 2; ++n) acc[a][b][m][n] = (f32x4){0.f, 0.f, 0.f, 0.f};
    bf16x8 At[4][2], B0[2][2], B1[2][2];
    const char* cA = (const char*)g.A + (size_t)cur.pm * tstep; const char* cB = (const char*)g.Bt + (size_t)cur.pn * tstep;
    S.a_ready(cur);
    if constexpr (SP2) {
        PG8_STAGE(PG8_SB(0, 0), cB, voffB); PG8_STAGE(PG8_SB(0, 1), cB + hstep, voffB); PG8_STAGE(PG8_SA(0, 0), cA, voffA); PG8_STAGE(PG8_SA(0, 1), cA + hstep, voffA);
        if (wr == 1) PG8_BAR;
        PG8_WAIT_V(2); PG8_BAR;
        PG8_STAGE(PG8_SB(1, 0), cB + kstep, voffB); PG8_STAGE(PG8_SA(1, 0), cA + kstep, voffA); PG8_STAGE(PG8_SB(1, 1), cB + hstep + kstep, voffB);
        PG8_WAIT_V(6); PG8_BAR;
    } else {
        PG8_STAGE(PG8_SB(0, 0), cB, voffB); PG8_STAGE(PG8_SA(0, 0), cA, voffA); PG8_STAGE(PG8_SB(0, 1), cB + hstep, voffB); PG8_STAGE(PG8_SA(0, 1), cA + hstep, voffA);
        if (wr == 1) PG8_BAR;
        PG8_WAIT_V(4); PG8_BAR;
        PG8_STAGE(PG8_SB(1, 0), cB + kstep, voffB); PG8_STAGE(PG8_SA(1, 0), cA + kstep, voffA); PG8_STAGE(PG8_SB(1, 1), cB + hstep + kstep, voffB);
        PG8_WAIT_V(6); PG8_BAR;
    }
    for (;;) {
        const bool has_next = S.next(ui + 1, nxt);
        const char* nA = has_next ? (const char*)g.A + (size_t)nxt.pm * tstep : cA; const char* nB = has_next ? (const char*)g.Bt + (size_t)nxt.pn * tstep : cB;
        for (int t = 0; t < nt; t += 2) {
            const bool last = (t == nt - 2);
            const char* a1 = cA + (size_t)(t + 1) * kstep;
            const char* a2 = last ? nA : cA + (size_t)(t + 2) * kstep; const char* b2 = last ? nB : cB + (size_t)(t + 2) * kstep;
            const char* a3 = a2 + kstep; const char* b3 = b2 + kstep;
            if (last && has_next) S.a_ready(nxt);
            if constexpr (SP2) {
            PG8_LDB(B0, 0, 0); PG8_LDB(B1, 0, 1); PG8_SCHED; PG8_LDA(At, 0, 0); PG8_STAGE(PG8_SA(1, 1), a1 + hstep, voffA);
            PG8_WAIT_V(8); PG8_WAIT_L(0); PG8_BAR; PG8_MMA(0, 0, At, B0); PG8_MMA(0, 1, At, B1); PG8_BAR; PG8_SCHED;
            PG8_LDA(At, 0, 1); PG8_STAGE(PG8_SB(0, 0), b2, voffB); PG8_STAGE(PG8_SB(0, 1), b2 + hstep, voffB); PG8_STAGE(PG8_SA(0, 0), a2, voffA);
            PG8_WAIT_V(8); PG8_WAIT_L(0); PG8_BAR; PG8_MMA(1, 0, At, B0); PG8_MMA(1, 1, At, B1); PG8_BAR; PG8_SCHED;
            PG8_LDB(B0, 1, 0); PG8_LDB(B1, 1, 1); PG8_SCHED; PG8_LDA(At, 1, 0); PG8_STAGE(PG8_SA(0, 1), a2 + hstep, voffA);
            PG8_WAIT_V(8); PG8_WAIT_L(0); PG8_BAR; PG8_MMA(0, 0, At, B0); PG8_MMA(0, 1, At, B1); PG8_BAR; PG8_SCHED;
            PG8_LDA(At, 1, 1); PG8_STAGE(PG8_SB(1, 0), b3, voffB); PG8_STAGE(PG8_SB(1, 1), b3 + hstep, voffB); PG8_STAGE(PG8_SA(1, 0), a3, voffA);
            PG8_WAIT_V(8); PG8_WAIT_L(0); PG8_BAR; PG8_MMA(1, 0, At, B0); PG8_MMA(1, 1, At, B1); PG8_BAR; PG8_SCHED;
            } else {
            PG8_LDB(B0, 0, 0); PG8_SCHED; PG8_LDA(At, 0, 0); PG8_STAGE(PG8_SA(1, 1), a1 + hstep, voffA);
            PG8_WAIT_L(8); PG8_BAR; PG8_WAIT_L(0); PG8_MMA(0, 0, At, B0); PG8_BAR; PG8_SCHED;
            PG8_LDB(B1, 0, 1); PG8_STAGE(PG8_SB(0, 0), b2, voffB);
            PG8_BAR; PG8_WAIT_L(0); PG8_MMA(0, 1, At, B1); PG8_BAR;
            PG8_LDA(At, 0, 1); PG8_STAGE(PG8_SA(0, 0), a2, voffA);
            PG8_BAR; PG8_WAIT_L(0); PG8_MMA(1, 0, At, B0); PG8_BAR; PG8_SCHED;
            PG8_STAGE(PG8_SB(0, 1), b2 + hstep, voffB);
            PG8_WAIT_V(6); PG8_BAR; PG8_MMA(1, 1, At, B1); PG8_BAR;
            PG8_LDB(B0, 1, 0); PG8_SCHED; PG8_LDA(At, 1, 0); PG8_STAGE(PG8_SA(0, 1), a2 + hstep, voffA);
            PG8_WAIT_L(8); PG8_BAR; PG8_WAIT_L(0); PG8_MMA(0, 0, At, B0); PG8_BAR; PG8_SCHED;
            PG8_LDB(B1, 1, 1); PG8_STAGE(PG8_SB(1, 0), b3, voffB);
            PG8_BAR; PG8_WAIT_L(0); PG8_MMA(0, 1, At, B1); PG8_BAR;
            PG8_LDA(At, 1, 1); PG8_STAGE(PG8_SA(1, 0), a3, voffA);
            PG8_BAR; PG8_WAIT_L(0); PG8_MMA(1, 0, At, B0); PG8_BAR; PG8_SCHED;
            PG8_STAGE(PG8_SB(1, 1), b3 + hstep, voffB);
            PG8_WAIT_V(6); PG8_BAR; PG8_MMA(1, 1, At, B1); PG8_BAR;
            }
        }
        if constexpr (ALIGN_EPI) { if (wr == 0) PG8_BAR; }
        if constexpr (!Epi::AFTER_DRAIN) { E(acc, cur, wr, wc, fr, fq); S.done(cur); }
        if (!has_next) break;
#pragma unroll
        for (int a = 0; a < 2; ++a)
#pragma unroll
            for (int b = 0; b < 2; ++b)
#pragma unroll
                for (int m = 0; m < 4; ++m)
#pragma unroll
                    for (int n = 0; n < 2; ++n) acc[a][b][m][n] = (f32x4){0.f, 0.f, 0.f, 0.f};
        cur = nxt; cA = nA; cB = nB; ++ui;
        if constexpr (ALIGN_EPI) { if (wr == 1) PG8_BAR; }
    }
    PG8_WAIT_V(0);
    if constexpr (!ALIGN_EPI) { if (wr == 0) PG8_BAR; }
    PG8_BAR;
    if constexpr (Epi::AFTER_DRAIN) { E.fused(acc, cur, wr, wc, fr, fq, lds, wid, lane); S.done(cur); }
#undef PG8_SA
#undef PG8_SB
#undef PG8_STAGE
#undef PG8_LDA
#undef PG8_LDB
#undef PG8_MMA
#undef PG8_WAIT_V
#undef PG8_WAIT_L
#undef PG8_BAR
#undef PG8_SCHED
}
}


__device__ __forceinline__ unsigned pk2h(float lo, float hi) { typedef _Float16 h2 __attribute__((ext_vector_type(2))); h2 v; v.x = (_Float16)lo; v.y = (_Float16)hi; return __builtin_bit_cast(unsigned, v); }

struct EpiP1 {
    static constexpr bool PERM = true, AFTER_DRAIN = false;
    u16 *U, *SG, *Q, *GA, *QI, *K, *V, *KI; float* WI; const float *qnw, *knw; const float2* rope;
    __device__ __forceinline__ void operator()(const f32x4 (&acc)[2][2][4][2], const pg8::Unit& u, int wr, int wc, int fr, int fq) const {
        const int g = u.pn * 4 + wc;
        if (g > 45) return;
        int mode, ld; u16* dst; const float* nwp = qnw; float osc = 1.f;
        if (g < 8) { mode = 0; dst = U + g * 64; ld = 512; }
        else if (g < 16) { mode = 1; dst = SG + (g - 8) * 64; ld = 512; }
        else if (g < 24) { mode = 2; dst = Q + (g - 16) * 64; ld = 512; osc = QSCALE; }
        else if (g < 26) { mode = 2; dst = K + (g - 24) * 64; ld = 128; nwp = knw; }
        else if (g < 28) { mode = 5; dst = V; ld = 128; }
        else if (g < 36) { mode = 1; dst = GA + (g - 28) * 64; ld = 512; }
        else if (g < 44) { mode = 3; dst = QI + (g - 36) * 64; ld = 512; }
        else if (g == 44) { mode = 3; dst = KI; ld = 64; }
        else { mode = 4; dst = KI; ld = 64; }
        const int row0 = u.pm * 256 + wr * 64 + fr;
        if (mode == 5) {
            const int kvh = g - 26;
#pragma unroll
            for (int ai = 0; ai < 2; ++ai)
#pragma unroll
                for (int m = 0; m < 4; ++m) {
                    const int t = row0 + ai * 128 + m * 16, bb = t >> 11, pos = t & (SEQ - 1), pp = (pos & ~12) | ((pos & 4) << 1) | ((pos & 8) >> 1);
                    u16* vp = dst + ((size_t)((bb * 2 + kvh) * 64 + 8 * fq)) * SEQ + pp;
#pragma unroll
                    for (int bj = 0; bj < 2; ++bj)
#pragma unroll
                        for (int n = 0; n < 2; ++n)
#pragma unroll
                            for (int j = 0; j < 4; ++j) vp[(size_t)(32 * bj + 4 * n + j) * SEQ] = f2h(acc[ai][bj][m][n][j]);
                }
            return;
        }
        if (mode == 4) {
            if (fq == 0) {
#pragma unroll
                for (int ai = 0; ai < 2; ++ai)
#pragma unroll
                    for (int m = 0; m < 4; ++m) { float* wp = WI + (size_t)(row0 + ai * 128 + m * 16) * 8; *(f32x4*)wp = acc[ai][0][m][0]; *(f32x4*)(wp + 4) = acc[ai][0][m][1]; }
            }
            return;
        }
        f32x4 nlo0 = {1.f, 1.f, 1.f, 1.f}, nlo1 = nlo0, nhi0 = nlo0, nhi1 = nlo0;
        if (mode == 2) { nlo0 = *(const f32x4*)(nwp + 8 * fq); nlo1 = *(const f32x4*)(nwp + 8 * fq + 4); nhi0 = *(const f32x4*)(nwp + 32 + 8 * fq); nhi1 = *(const f32x4*)(nwp + 36 + 8 * fq); }
#pragma unroll
        for (int ai = 0; ai < 2; ++ai)
#pragma unroll
            for (int m = 0; m < 4; ++m) {
                const int t = row0 + ai * 128 + m * 16;
                f32x4 a0 = acc[ai][0][m][0], a1 = acc[ai][0][m][1], b0 = acc[ai][1][m][0], b1 = acc[ai][1][m][1];
                if (mode == 1) {
#pragma unroll
                    for (int j = 0; j < 4; ++j) { a0[j] = silu_f(a0[j]); a1[j] = silu_f(a1[j]); b0[j] = silu_f(b0[j]); b1[j] = silu_f(b1[j]); }
                } else if (mode >= 2) {
                    if (mode == 2) {
                        float ss = 0.f;
#pragma unroll
                        for (int j = 0; j < 4; ++j) ss += a0[j] * a0[j] + a1[j] * a1[j] + b0[j] * b0[j] + b1[j] * b1[j];
                        ss += __shfl_xor(ss, 16); ss += __shfl_xor(ss, 32);
                        const float rinv = rsqrtf(ss * (1.f / 64.f) + EPS);
                        a0 = a0 * rinv * nlo0; a1 = a1 * rinv * nlo1; b0 = b0 * rinv * nhi0; b1 = b1 * rinv * nhi1;
                    }
                    const f32x4* rp = (const f32x4*)(rope + (size_t)(t & (SEQ - 1)) * 32 + 8 * fq);
                    const f32x4 r0 = rp[0], r1 = rp[1], r2 = rp[2], r3 = rp[3];
                    f32x4 o0, o1, p0, p1;
                    o0[0] = a0[0] * r0[0] - b0[0] * r0[1]; p0[0] = b0[0] * r0[0] + a0[0] * r0[1];
                    o0[1] = a0[1] * r0[2] - b0[1] * r0[3]; p0[1] = b0[1] * r0[2] + a0[1] * r0[3];
                    o0[2] = a0[2] * r1[0] - b0[2] * r1[1]; p0[2] = b0[2] * r1[0] + a0[2] * r1[1];
                    o0[3] = a0[3] * r1[2] - b0[3] * r1[3]; p0[3] = b0[3] * r1[2] + a0[3] * r1[3];
                    o1[0] = a1[0] * r2[0] - b1[0] * r2[1]; p1[0] = b1[0] * r2[0] + a1[0] * r2[1];
                    o1[1] = a1[1] * r2[2] - b1[1] * r2[3]; p1[1] = b1[1] * r2[2] + a1[1] * r2[3];
                    o1[2] = a1[2] * r3[0] - b1[2] * r3[1]; p1[2] = b1[2] * r3[0] + a1[2] * r3[1];
                    o1[3] = a1[3] * r3[2] - b1[3] * r3[3]; p1[3] = b1[3] * r3[2] + a1[3] * r3[3];
                    a0 = o0 * osc; a1 = o1 * osc; b0 = p0 * osc; b1 = p1 * osc;
                }
                u16* dp = dst + (size_t)t * ld + 8 * fq;
                v4u lo, hi; lo.x = pk2h(a0[0], a0[1]); lo.y = pk2h(a0[2], a0[3]); lo.z = pk2h(a1[0], a1[1]); lo.w = pk2h(a1[2], a1[3]);
                hi.x = pk2h(b0[0], b0[1]); hi.y = pk2h(b0[2], b0[3]); hi.z = pk2h(b1[0], b1[1]); hi.w = pk2h(b1[2], b1[3]);
                *(v4u*)dp = lo; *(v4u*)(dp + 32) = hi;
                if (m & 1) asm volatile("" ::: "memory");
            }
    }
};
struct EpiOut {
    static constexpr bool PERM = true, AFTER_DRAIN = false;
    const float* x; const float* gate; float* out;
    __device__ __forceinline__ void operator()(const f32x4 (&acc)[2][2][4][2], const pg8::Unit& u, int wr, int wc, int fr, int fq) const {
        const int row0 = u.pm * 256 + wr * 64 + fr, col0 = u.pn * 256 + wc * 32 + 8 * fq, b = (u.pm * 256) >> 11;
        f32x4 gv[2][2];
#pragma unroll
        for (int bj = 0; bj < 2; ++bj)
#pragma unroll
            for (int n = 0; n < 2; ++n) gv[bj][n] = *(const f32x4*)(gate + b * 3072 + col0 + bj * 128 + 4 * n);
#pragma unroll
        for (int ai = 0; ai < 2; ++ai)
#pragma unroll
            for (int m = 0; m < 4; ++m) {
                const size_t off = (size_t)(row0 + ai * 128 + m * 16) * DM + col0;
#pragma unroll
                for (int bj = 0; bj < 2; ++bj)
#pragma unroll
                    for (int n = 0; n < 2; ++n) { const f32x4 xv = *(const f32x4*)(x + off + bj * 128 + 4 * n); *(f32x4*)(out + off + bj * 128 + 4 * n) = xv + gv[bj][n] * acc[ai][bj][m][n]; }
                if (m & 1) asm volatile("" ::: "memory");
            }
    }
};

__device__ __forceinline__ void p1_epilogue_row(const Ctx& C, int g, int t, int sub, const LAS float* tr) {
    const int pos = t & (SEQ - 1);
    if (g < 8) {
        for (int c = 16 * sub; c < 16 * sub + 16; ++c) C.U[(size_t)t * 512 + g * 64 + c] = f2h(tr[c]);
    } else if (g < 16) {
        for (int c = 16 * sub; c < 16 * sub + 16; ++c) C.SG[(size_t)t * 512 + (g - 8) * 64 + c] = f2h(silu_f(tr[c]));
    } else if (g < 26) {
        float ss = 0.f;
        for (int c = 16 * sub; c < 16 * sub + 16; ++c) ss += tr[c] * tr[c];
        ss += __shfl_xor(ss, 1); ss += __shfl_xor(ss, 2);
        const float rinv = rsqrtf(ss * (1.f / 64.f) + EPS);
        const bool isq = g < 24; const float* nwp = isq ? C.qnw : C.knw; const float osc = isq ? QSCALE : 1.f;
        u16* dst = isq ? C.Q + (size_t)t * 512 + (g - 16) * 64 : C.K + (size_t)t * 128 + (g - 24) * 64;
        for (int i = 8 * sub; i < 8 * sub + 8; ++i) {
            const float x1 = tr[i] * rinv * nwp[i], x2 = tr[i + 32] * rinv * nwp[i + 32];
            const float2 cs = C.rope[pos * 32 + i];
            dst[i] = f2h((x1 * cs.x - x2 * cs.y) * osc); dst[i + 32] = f2h((x2 * cs.x + x1 * cs.y) * osc);
        }
    } else if (g < 28) {
        for (int c = 16 * sub; c < 16 * sub + 16; ++c) C.V[(size_t)t * 128 + (g - 26) * 64 + c] = f2h(tr[c]);
    } else if (g < 36) {
        for (int c = 16 * sub; c < 16 * sub + 16; ++c) C.GA[(size_t)t * 512 + (g - 28) * 64 + c] = f2h(silu_f(tr[c]));
    } else if (g < 45) {
        u16* dst = g < 44 ? C.QI + (size_t)t * 512 + (g - 36) * 64 : C.KI + (size_t)t * 64;
        for (int i = 8 * sub; i < 8 * sub + 8; ++i) {
            const float x1 = tr[i], x2 = tr[i + 32];
            const float2 cs = C.rope[pos * 32 + i];
            dst[i] = f2h(x1 * cs.x - x2 * cs.y); dst[i + 32] = f2h(x2 * cs.x + x1 * cs.y);
        }
    } else {
        if (sub == 0) for (int c = 0; c < 8; ++c) C.WI[(size_t)t * 8 + c] = tr[c];
    }
}
__device__ __forceinline__ void phase1_naive(const Ctx& C) {
    LAS float* tile = (LAS float*)C.lds;
    for (int u = C.bid; u < 46 * 128; u += C.G) {
        const int g = u % 46, r0 = (u / 46) * 128, w = C.wave, lane = C.lane, wr = w & 3, wcn = w >> 2;
        const u16* ap = C.XN + (size_t)(r0 + wr * 32 + (lane & 31)) * DM + 8 * (lane >> 5);
        const u16* bp = C.WinT + (size_t)(g * 64 + wcn * 32 + (lane & 31)) * DM + 8 * (lane >> 5);
        f32x16 acc;
#pragma unroll
        for (int r = 0; r < 16; ++r) acc[r] = 0.f;
        for (int k0 = 0; k0 < DM; k0 += 16) {
            const h16x8 a = *(const h16x8*)(ap + k0), bb = *(const h16x8*)(bp + k0);
            acc = __builtin_amdgcn_mfma_f32_32x32x16_f16(a, bb, acc, 0, 0, 0);
        }
        __syncthreads();
#pragma unroll
        for (int r = 0; r < 16; ++r) tile[(wr * 32 + (r & 3) + 8 * (r >> 2) + 4 * (lane >> 5)) * 65 + wcn * 32 + (lane & 31)] = acc[r];
        __syncthreads();
        const int row = C.tid >> 2, sub = C.tid & 3;
        p1_epilogue_row(C, g, r0 + row, sub, tile + row * 65);
    }
}

__device__ __forceinline__ void pool_unit_naive(const Ctx& C, int u) {
    LAS float* pl = (LAS float*)C.lds;
    const int t0 = (u >> 2) * 64, g = u & 3, tid = C.tid, win = 2 << g;
    __syncthreads();
    for (int idx = tid; idx < 64 * 128; idx += NTH) {
        const int tl = idx >> 7, c = idx & 127, t = t0 + tl, pos = t & (SEQ - 1);
        const int cnt = (pos + 1 < win) ? pos + 1 : win;
        float s = 0.f;
        for (int j = 0; j < cnt; ++j) s += h2f(C.U[(size_t)(t - j) * 512 + g * 128 + c]);
        pl[tl * 128 + c] = s / (float)cnt - h2f(C.U[(size_t)t * 512 + g * 128 + c]);
    }
    __syncthreads();
    const int d = tid & 127, rh = tid >> 7;
    float acc[16];
#pragma unroll
    for (int i = 0; i < 16; ++i) acc[i] = 0.f;
    const float* wp = C.w_pool + (size_t)g * 128 * 128 + d;
    for (int c = 0; c < 128; ++c) {
        const float wv = wp[(size_t)c * 128];
#pragma unroll
        for (int i = 0; i < 16; ++i) acc[i] += pl[(rh * 16 + i) * 128 + c] * wv;
    }
    const float ps = C.pool_scale[g * 128 + d];
#pragma unroll
    for (int i = 0; i < 16; ++i) {
        const int t = t0 + rh * 16 + i;
        C.MIX[(size_t)t * 1024 + g * 128 + d] = f2h(acc[i] * ps * h2f(C.SG[(size_t)t * 512 + g * 128 + d]));
    }
}


__device__ __forceinline__ int pswz(int row, int ch) { return row * 256 + ((ch ^ (row & 15)) << 4); }
__device__ __forceinline__ void pool_unit(const Ctx& C, int u) {
    LAS unsigned char* L = C.lds;
    const int t0 = (u >> 2) * 128, g = u & 3, win = 2 << g, w = C.wave, lane = C.lane;
    __syncthreads();
    {
        const int cp = lane, c0 = 2 * cp;
        const int tb = t0 + 16 * w, pos0 = tb & (SEQ - 1);
        const u16* up = C.U + (size_t)tb * 512 + g * 128 + c0;
        float s0 = 0.f, s1 = 0.f;
        const int npre = pos0 < win ? pos0 : win;
        for (int j = 1; j <= npre; ++j) { const unsigned v = *(const unsigned*)(up - (size_t)j * 512); s0 += h2f((u16)(v & 0xffffu)); s1 += h2f((u16)(v >> 16)); }
#pragma unroll 4
        for (int i = 0; i < 16; ++i) {
            const int pos = pos0 + i;
            const unsigned v = *(const unsigned*)(up + (size_t)i * 512);
            const float a0 = h2f((u16)(v & 0xffffu)), a1 = h2f((u16)(v >> 16));
            s0 += a0; s1 += a1;
            if (pos >= win) { const unsigned vo = *(const unsigned*)(up + (size_t)(i - win) * 512); s0 -= h2f((u16)(vo & 0xffffu)); s1 -= h2f((u16)(vo >> 16)); }
            const float cnt = (float)(pos + 1 < win ? pos + 1 : win);
            const int row = 16 * w + i;
            *(LAS unsigned*)(L + pswz(row, c0 >> 3) + (c0 & 7) * 2) = pk2h(s0 / cnt - a0, s1 / cnt - a1);
        }
    }
    __syncthreads();
    const int q32 = lane & 31, half = lane >> 5, dt = w & 3, tp = w >> 2;
    h16x8 af[8];
    const u16* wp = C.WpT + ((size_t)g * 128 + 32 * dt + q32) * 128 + 8 * half;
#pragma unroll
    for (int ks = 0; ks < 8; ++ks) af[ks] = *(const h16x8*)(wp + 16 * ks);
    const int d0 = g * 128 + 32 * dt + 4 * half;
#pragma unroll
    for (int tt = 0; tt < 2; ++tt) {
        const int trow = 64 * tp + 32 * tt + q32;
        f32x16 acc;
#pragma unroll
        for (int r = 0; r < 16; ++r) acc[r] = 0.f;
#pragma unroll
        for (int ks = 0; ks < 8; ++ks) {
            const h16x8 bf = *(const LAS h16x8*)(L + pswz(trow, 2 * ks + half));
            acc = __builtin_amdgcn_mfma_f32_32x32x16_f16(af[ks], bf, acc, 0, 0, 0);
        }
        const int t = t0 + trow;
#pragma unroll
        for (int g4 = 0; g4 < 4; ++g4) {
            const int d = d0 + 8 * g4;
            const f32x4 ps = *(const f32x4*)(C.pool_scale + d);
            const uint2 gv = *(const uint2*)(C.SG + (size_t)t * 512 + d);
            uint2 ov;
            ov.x = pk2h(acc[4 * g4] * ps[0] * h2f((u16)(gv.x & 0xffffu)), acc[4 * g4 + 1] * ps[1] * h2f((u16)(gv.x >> 16)));
            ov.y = pk2h(acc[4 * g4 + 2] * ps[2] * h2f((u16)(gv.y & 0xffffu)), acc[4 * g4 + 3] * ps[3] * h2f((u16)(gv.y >> 16)));
            *(uint2*)(C.MIX + (size_t)t * 1024 + d) = ov;
        }
    }
}
__device__ __forceinline__ unsigned fkey(float f) { const unsigned u = __float_as_uint(f); return (u & 0x80000000u) ? ~u : (u | 0x80000000u); }
__device__ __forceinline__ int block_sum_int(int v, LAS int* red) {
#pragma unroll
    for (int o = 1; o < 64; o <<= 1) v += __shfl_xor(v, o);
    __syncthreads();
    if ((threadIdx.x & 63) == 0) red[threadIdx.x >> 6] = v;
    __syncthreads();
    return red[0] + red[1] + red[2] + red[3] + red[4] + red[5] + red[6] + red[7];
}


struct WorkQ {
    unsigned* head; LAS int* slot; int cur, nxt_pending;
};
__device__ __forceinline__ int wq_first(const Ctx& C, unsigned* head) {
    LAS int* slot = (LAS int*)(C.lds + LDSCTL_OFF + 256);
    __syncthreads();
    if (C.tid == 0) *slot = (int)__hip_atomic_fetch_add(head, 1u, __ATOMIC_RELAXED, __HIP_MEMORY_SCOPE_AGENT);
    __syncthreads();
    return *slot;
}

template <int CTRL, int RM> __device__ __forceinline__ int dpp_i(int idv, int v) { return __builtin_amdgcn_update_dpp(idv, v, CTRL, RM, 0xF, false); }
__device__ __forceinline__ int wave_sum_i(int v) {
    v += dpp_i<0x111, 0xF>(0, v); v += dpp_i<0x112, 0xF>(0, v); v += dpp_i<0x114, 0xF>(0, v); v += dpp_i<0x118, 0xF>(0, v);
    v += dpp_i<0x142, 0xA>(0, v); v += dpp_i<0x143, 0xC>(0, v);
    return __builtin_amdgcn_readlane(v, 63);
}
__device__ __forceinline__ float wave_max_f(float v) {
    constexpr int NI = (int)0xFF800000u;
    v = fmaxf(v, __int_as_float(dpp_i<0x111, 0xF>(NI, __float_as_int(v)))); v = fmaxf(v, __int_as_float(dpp_i<0x112, 0xF>(NI, __float_as_int(v))));
    v = fmaxf(v, __int_as_float(dpp_i<0x114, 0xF>(NI, __float_as_int(v)))); v = fmaxf(v, __int_as_float(dpp_i<0x118, 0xF>(NI, __float_as_int(v))));
    v = fmaxf(v, __int_as_float(dpp_i<0x142, 0xA>(NI, __float_as_int(v)))); v = fmaxf(v, __int_as_float(dpp_i<0x143, 0xC>(NI, __float_as_int(v))));
    return __int_as_float(__builtin_amdgcn_readlane(__float_as_int(v), 63));
}
constexpr int QS = 2052;
__device__ __forceinline__ int cnt4(int c, float k0, float k1, float k2, float k3, float x) {
    unsigned long long m0, m1, m2, m3;
    asm volatile("v_cmp_ge_f32_e64 %1, %5, %9\n\tv_cmp_ge_f32_e64 %2, %6, %9\n\tv_cmp_ge_f32_e64 %3, %7, %9\n\tv_cmp_ge_f32_e64 %4, %8, %9\n\t"
                 "v_addc_co_u32_e64 %0, vcc, %0, 0, %1\n\tv_addc_co_u32_e64 %0, vcc, %0, 0, %2\n\tv_addc_co_u32_e64 %0, vcc, %0, 0, %3\n\tv_addc_co_u32_e64 %0, vcc, %0, 0, %4"
                 : "+v"(c), "=&s"(m0), "=&s"(m1), "=&s"(m2), "=&s"(m3) : "v"(k0), "v"(k1), "v"(k2), "v"(k3), "v"(x) : "vcc");
    return c;
}
__device__ __forceinline__ int cnt_lane(const float (&sv)[32], int nreg, float x) {
    int c = 0;
#pragma unroll
    for (int jj = 0; jj < 8; ++jj) if (4 * jj < nreg) c = cnt4(c, sv[4 * jj], sv[4 * jj + 1], sv[4 * jj + 2], sv[4 * jj + 3], x);
    return c;
}
__device__ __forceinline__ unsigned skey(float f) { return f == -INFINITY ? 0u : fkey(f); }

struct SelSt {
    float lo, hi, flo, fhi, tau; int side; bool found, fail; unsigned T, J;
    __device__ __forceinline__ void init(int n) { found = n <= 256; fail = false; tau = -3.0e38f; lo = hi = 0.f; flo = (float)(n - 256) + 0.5f; fhi = -255.5f; side = 0; T = 0u; J = 2047u; }
    __device__ __forceinline__ bool active() const { return !(found || fail); }
    __device__ __forceinline__ float pivot() {
        float x = (lo * fhi - hi * flo) * __builtin_amdgcn_rcpf(fhi - flo);
        if (!(x > lo && x < hi)) x = 0.5f * (lo + hi);
        if (!(x > lo && x < hi)) fail = true;
        return x;
    }
    __device__ __forceinline__ void update(float x, int c) {
        if (found || fail) return;
        if (c == 256) { found = true; tau = x; }
        else if (c > 256) { lo = x; flo = (float)(c - 256) + 0.5f; if (side == 1) fhi *= 0.5f; side = 1; }
        else { hi = x; fhi = (float)(c - 256) + 0.5f; if (side == -1) flo *= 0.5f; side = -1; }
    }
};
__device__ __forceinline__ void sel_minmax(const float (&sv)[32], int nreg, int n, int lane, SelSt& S) {
    float mx = -INFINITY, mn = INFINITY;
#pragma unroll
    for (int j = 0; j < 32; ++j) if (j < nreg) {
        mx = fmaxf(mx, sv[j]);
        if (64 * (j + 1) <= n) mn = fminf(mn, sv[j]); else if (64 * j < n) mn = fminf(mn, (lane < n - 64 * j) ? sv[j] : INFINITY);
    }
    const float hi = wave_max_f(mx);
    S.lo = -wave_max_f(-mn);
    S.hi = hi + fmaxf(fabsf(hi) * 1e-6f, 1e-30f);
}
__device__ __forceinline__ void sel_exact(const float (&sv)[32], int nreg, int lane, SelSt& S) {
    unsigned kk[32];
#pragma unroll
    for (int j = 0; j < 32; ++j) kk[j] = (j < nreg) ? skey(sv[j]) : 0u;
    const unsigned klo = fkey(S.lo), khi = fkey(S.hi), diff = klo ^ khi;
    const int hb = 31 - __builtin_clz(diff | 1u);
    unsigned T = hb >= 31 ? 0u : (klo & ~((2u << hb) - 1u));
    bool exact256 = false;
#pragma unroll 1
    for (int bit = hb; bit >= 0; --bit) {
        const unsigned cand = T | (1u << bit);
        int c = 0;
#pragma unroll
        for (int j = 0; j < 32; ++j) if (j < nreg) c += kk[j] >= cand ? 1 : 0;
        c = wave_sum_i(c);
        if (c >= 256) T = cand;
        if (c == 256) { exact256 = true; break; }
    }
    S.T = T; S.J = 2047u;
    if (exact256) return;
    int cg = 0;
#pragma unroll
    for (int j = 0; j < 32; ++j) if (j < nreg) cg += kk[j] > T ? 1 : 0;
    const int need = 256 - wave_sum_i(cg);
    unsigned Jt = 0u;
#pragma unroll 1
    for (int bit = 10; bit >= 0; --bit) {
        const unsigned cj = Jt | (1u << bit);
        int c2 = 0;
#pragma unroll
        for (int j = 0; j < 32; ++j) if (j < nreg) c2 += (kk[j] == T && (unsigned)(64 * j + lane) < cj) ? 1 : 0;
        if (wave_sum_i(c2) < need) Jt = cj;
    }
    S.J = Jt;
}
__device__ __forceinline__ void sel_write(const Ctx& C, const float (&sv)[32], int nreg, int lane, const SelSt& S, int t) {
    int mlo = 0, mhi = 0;
#pragma unroll
    for (int j = 0; j < 32; ++j) if (j < nreg) {
        bool sj;
        if (S.found) sj = sv[j] >= S.tau; else { const unsigned k = skey(sv[j]); sj = k > S.T || (k == S.T && (unsigned)(64 * j + lane) <= S.J); }
        const unsigned long long bal = __ballot(sj);
        mlo = (lane == j) ? (int)(unsigned)bal : mlo; mhi = (lane == j) ? (int)(unsigned)(bal >> 32) : mhi;
    }
    if (lane < 32) *(uint2*)(C.MASK + (size_t)t * 64 + 2 * lane) = make_uint2((unsigned)mlo, (unsigned)mhi);
}
__device__ __forceinline__ float unkey(unsigned k) { return __uint_as_float((k & 0x80000000u) ? (k ^ 0x80000000u) : ~k); }
__device__ __forceinline__ void stageA_unit(const Ctx& C, int b, int qb, int par) {
    LAS float* SC = (LAS float*)C.lds;
    LAS unsigned* RM = (LAS unsigned*)(C.lds + 16 * QS * 4);
    LAS unsigned* RT = RM + 64;
    const int w = C.wave, lane = C.lane, fr = lane & 15, fq = lane >> 4;
    const int nregU = (qb >> 2) + 1;
    if (C.tid < 16) { RM[par * 32 + C.tid] = 0u; RM[par * 32 + 16 + C.tid] = 0xFFFFFFFFu; }
    if (C.tid == 32) RT[par] = 0u;
    TS(20);
    __syncthreads();
    TS(12);
    {
        const int pos = 16 * qb + fr, t = b * SEQ + pos;
        h16x8 qf[8][2];
#pragma unroll
        for (int h = 0; h < 8; ++h)
#pragma unroll
            for (int ks = 0; ks < 2; ++ks) qf[h][ks] = *(const h16x8*)(C.QI + (size_t)t * 512 + h * 64 + 32 * ks + 8 * fq);
        float wi[8];
        { const f32x4 w0 = *(const f32x4*)(C.WI + (size_t)t * 8), w1 = *(const f32x4*)(C.WI + (size_t)t * 8 + 4);
          wi[0] = w0[0]; wi[1] = w0[1]; wi[2] = w0[2]; wi[3] = w0[3]; wi[4] = w1[0]; wi[5] = w1[1]; wi[6] = w1[2]; wi[7] = w1[3]; }
        const int lim = pos - 4 * fq;
        float mx = -INFINITY, mn = INFINITY;
        const u16* kbase = C.KI + (size_t)(b * SEQ + fr) * 64 + 8 * fq;
        const int stlim = 2 * nregU;
        h16x8 c00, c01, c10, c11;
        { const int st = w; const bool in0 = st < stlim && 2 * st <= qb, in1 = st < stlim && 2 * st + 1 <= qb;
          const u16* kp = kbase + (size_t)(32 * st) * 64; const h16x8 z = {0, 0, 0, 0, 0, 0, 0, 0};
          c00 = in0 ? *(const h16x8*)kp : z; c01 = in0 ? *(const h16x8*)(kp + 32) : z; c10 = in1 ? *(const h16x8*)(kp + 16 * 64) : z; c11 = in1 ? *(const h16x8*)(kp + 16 * 64 + 32) : z; }
#pragma unroll 1
        for (int st = w; st < stlim; st += 8) {
            h16x8 n00, n01, n10, n11;
            { const int sn = st + 8; const bool in0 = sn < stlim && 2 * sn <= qb, in1 = sn < stlim && 2 * sn + 1 <= qb;
              const u16* kp = kbase + (size_t)(32 * sn) * 64; const h16x8 z = {0, 0, 0, 0, 0, 0, 0, 0};
              n00 = in0 ? *(const h16x8*)kp : z; n01 = in0 ? *(const h16x8*)(kp + 32) : z; n10 = in1 ? *(const h16x8*)(kp + 16 * 64) : z; n11 = in1 ? *(const h16x8*)(kp + 16 * 64 + 32) : z; }
#pragma unroll
            for (int tt = 0; tt < 2; ++tt) {
                const int kt = 2 * st + tt;
                f32x4 sc = {-INFINITY, -INFINITY, -INFINITY, -INFINITY};
                if (kt <= qb) {
                    const h16x8 a0 = tt ? c10 : c00, a1 = tt ? c11 : c01;
                    f32x4 sum = {0.f, 0.f, 0.f, 0.f};
#pragma unroll
                    for (int h = 0; h < 8; ++h) {
                        f32x4 acc = {0.f, 0.f, 0.f, 0.f};
                        acc = __builtin_amdgcn_mfma_f32_16x16x32_f16(a0, qf[h][0], acc, 0, 0, 0);
                        acc = __builtin_amdgcn_mfma_f32_16x16x32_f16(a1, qf[h][1], acc, 0, 0, 0);
#pragma unroll
                        for (int r = 0; r < 4; ++r) sum[r] += wi[h] * fmaxf(acc[r], 0.f);
                    }
#pragma unroll
                    for (int r = 0; r < 4; ++r) { const bool ok = 16 * kt + r <= lim; sc[r] = ok ? sum[r] : -INFINITY; mx = fmaxf(mx, sc[r]); mn = fminf(mn, ok ? sum[r] : INFINITY); }
                }
                *(LAS f32x4*)(SC + fr * QS + 32 * st + 16 * tt + 4 * fq) = sc;
            }
            c00 = n00; c01 = n01; c10 = n10; c11 = n11;
        }
        mx = fmaxf(mx, __shfl_xor(mx, 16)); mx = fmaxf(mx, __shfl_xor(mx, 32)); mn = fminf(mn, __shfl_xor(mn, 16)); mn = fminf(mn, __shfl_xor(mn, 32));
        if (fq == 0 && mx > -INFINITY) { atomicMax((unsigned*)&RM[par * 32 + fr], fkey(mx)); atomicMin((unsigned*)&RM[par * 32 + 16 + fr], fkey(mn)); }
    }
    TS(13);
    __syncthreads();
    TS(14);
#pragma unroll 1
    for (;;) {
        int q = 0;
        if (lane == 0) q = (int)atomicAdd((unsigned*)&RT[par], 1u);
        q = __builtin_amdgcn_readfirstlane(q);
        if (q >= 16) break;
        const int pos = 16 * qb + q, n = pos + 1;
        float sv[32];
#pragma unroll
        for (int j = 0; j < 32; ++j) sv[j] = (j < nregU) ? SC[q * QS + 64 * j + lane] : -INFINITY;
        SelSt A; A.init(n);
        if (n > 256) {
            const float hi = unkey(RM[par * 32 + q]);
            A.lo = unkey(RM[par * 32 + 16 + q]);
            A.hi = hi + fmaxf(fabsf(hi) * 1e-6f, 1e-30f);
#pragma unroll 1
            for (int it = 0; it < 20; ++it) {
                if (!A.active()) break;
                const float x = A.pivot();
                const int c = wave_sum_i(cnt_lane(sv, nregU, x));
                A.update(x, c);
            }
            if (!A.found) sel_exact(sv, nregU, lane, A);
        }
        sel_write(C, sv, nregU, lane, A, b * SEQ + pos);
    }
}
__device__ __forceinline__ void pool_unit(const Ctx& C, int u);
__device__ __forceinline__ void stageA_phase(const Ctx& C, unsigned* head) {
    LAS int* slot = (LAS int*)(C.lds + LDSCTL_OFF + 256);
    int tk = wq_first(C, head), par = 0;
    while (tk < 1536) {
        int nx = 0;
        if (C.tid == 0) nx = (int)__hip_atomic_fetch_add(head, 1u, __ATOMIC_RELAXED, __HIP_MEMORY_SCOPE_AGENT);
        if (tk < 1024) { stageA_unit(C, tk & 7, 127 - (tk >> 3), par); par ^= 1; TS(17); }
        else { pool_unit(C, tk - 1024); TS(21); }
        __syncthreads();
        if (C.tid == 0) *slot = nx;
        __syncthreads();
        tk = *slot;
    }
}
__device__ __forceinline__ int swz(int r, int c) { return r * 128 + ((c ^ ((r >> 1) & 7)) << 4); }
__device__ __forceinline__ float maskf(float sv, unsigned mbits, int pos) {
    const unsigned m = (unsigned)(((int)(mbits << (31 - pos))) >> 31);
    return __uint_as_float((__float_as_uint(sv) & m) | (~m & 0xFF800000u));
}
__device__ __forceinline__ h16x8 pack8(const f32x16& p, int b0) {
    typedef __fp16 hh2 __attribute__((ext_vector_type(2)));
    typedef unsigned u4 __attribute__((ext_vector_type(4)));
    u4 v;
    v.x = __builtin_bit_cast(unsigned, (hh2)__builtin_amdgcn_cvt_pkrtz(p[b0], p[b0 + 1])); v.y = __builtin_bit_cast(unsigned, (hh2)__builtin_amdgcn_cvt_pkrtz(p[b0 + 2], p[b0 + 3]));
    v.z = __builtin_bit_cast(unsigned, (hh2)__builtin_amdgcn_cvt_pkrtz(p[b0 + 4], p[b0 + 5])); v.w = __builtin_bit_cast(unsigned, (hh2)__builtin_amdgcn_cvt_pkrtz(p[b0 + 6], p[b0 + 7]));
    return __builtin_bit_cast(h16x8, v);
}
#define MX3(a, b, c) __builtin_fmaxf(__builtin_fmaxf((a), (b)), (c))
__device__ __forceinline__ void stageB_unit(const Ctx& C, int b, int kvh, int qb) {
    LAS unsigned char* L = C.lds;
    const int w = C.wave, lane = C.lane, q32 = lane & 31, half = lane >> 5, h = kvh * 4 + (w & 3);
    const int t = b * SEQ + 64 * qb + 32 * (w >> 2) + q32;
    h16x8 qf[4];
#pragma unroll
    for (int ks = 0; ks < 4; ++ks) qf[ks] = *(const h16x8*)(C.Q + (size_t)t * 512 + h * 64 + 16 * ks + 8 * half);
    f32x16 o0, o1, negm;
#pragma unroll
    for (int r = 0; r < 16; ++r) { o0[r] = 0.f; o1[r] = 0.f; negm[r] = 0.f; }
    float m_run = 0.f, l_run = 0.f; bool has = false;
    const int lr = C.tid >> 3, lc = C.tid & 7;
    const u16* kg = C.K + ((size_t)(b * SEQ) + lr) * 128 + kvh * 64 + lc * 8;
    const u16* vg = C.VT + ((size_t)((b * 2 + kvh) * 64 + lr)) * SEQ + lc * 8;
    const int ldsw = swz(lr, lc);
    const unsigned* mg = C.MASK + (size_t)t * 64;
    __syncthreads();
    { const v4u kr = *(const v4u*)kg, vr = *(const v4u*)vg; *(LAS v4u*)(L + ldsw) = kr; *(LAS v4u*)(L + 16384 + ldsw) = vr; }
    uint2 mw = *(const uint2*)mg;
    __syncthreads();
    const int nt = qb + 1;
    constexpr float THR = 8.f;
#pragma unroll 1
    for (int j = 0; j < nt; ++j) {
        const int cur = (j & 1) * 8192;
        const bool more = j + 1 < nt;
        v4u kr = {0u, 0u, 0u, 0u}, vr = {0u, 0u, 0u, 0u}; uint2 mwn = make_uint2(0u, 0u);
        if (more) { kr = *(const v4u*)(kg + (size_t)(j + 1) * 64 * 128); vr = *(const v4u*)(vg + (j + 1) * 64); mwn = *(const uint2*)(mg + 2 * (j + 1)); }
        TS(22);
        f32x16 s0, s1;
#pragma unroll
        for (int ks = 0; ks < 4; ++ks) {
            const h16x8 a0 = *(const LAS h16x8*)(L + cur + swz(q32, 2 * ks + half)), a1 = *(const LAS h16x8*)(L + cur + swz(32 + q32, 2 * ks + half));
            s0 = __builtin_amdgcn_mfma_f32_32x32x16_f16(a0, qf[ks], ks == 0 ? negm : s0, 0, 0, 0);
            s1 = __builtin_amdgcn_mfma_f32_32x32x16_f16(a1, qf[ks], ks == 0 ? negm : s1, 0, 0, 0);
        }
        TS(23);
        const unsigned m0 = mw.x >> (4 * half), m1 = mw.y >> (4 * half);
#pragma unroll
        for (int r = 0; r < 16; ++r) { const int pos = (r & 3) + 8 * (r >> 2); s0[r] = maskf(s0[r], m0, pos); s1[r] = maskf(s1[r], m1, pos); }
        float mx = MX3(s0[0], s0[1], s1[0]), my = MX3(s0[2], s0[3], s1[1]);
        mx = MX3(mx, s1[2], s1[3]);
#pragma unroll
        for (int r = 4; r < 16; r += 4) { mx = MX3(mx, s0[r], s0[r + 1]); my = MX3(my, s0[r + 2], s0[r + 3]); mx = MX3(mx, s1[r], s1[r + 1]); my = MX3(my, s1[r + 2], s1[r + 3]); }
        mx = fmaxf(mx, my); mx = fmaxf(mx, __shfl_xor(mx, 32));
        TS(24);
        if (__any(mx > THR || (!has && mx > -INFINITY))) {
            const float dl = has ? fmaxf(mx, 0.f) : (mx > -INFINITY ? mx : 0.f);
            has = has || mx > -INFINITY;
            m_run += dl;
            const float f = __builtin_amdgcn_exp2f(-dl);
            l_run *= f;
#pragma unroll
            for (int r = 0; r < 16; ++r) { s0[r] -= dl; s1[r] -= dl; o0[r] *= f; o1[r] *= f; negm[r] = -m_run; }
        }
        float ls = 0.f, lt = 0.f;
#pragma unroll
        for (int r = 0; r < 16; ++r) { s0[r] = __builtin_amdgcn_exp2f(s0[r]); s1[r] = __builtin_amdgcn_exp2f(s1[r]); ls += s0[r]; lt += s1[r]; }
        l_run += ls + lt;
        TS(25);
        const h16x8 pb0 = pack8(s0, 0), pb1 = pack8(s0, 8), pb2 = pack8(s1, 0), pb3 = pack8(s1, 8);
#pragma unroll
        for (int kc = 0; kc < 4; ++kc) {
            const h16x8 va0 = *(const LAS h16x8*)(L + 16384 + cur + swz(q32, 2 * kc + half)), va1 = *(const LAS h16x8*)(L + 16384 + cur + swz(32 + q32, 2 * kc + half));
            const h16x8 pb = kc == 0 ? pb0 : kc == 1 ? pb1 : kc == 2 ? pb2 : pb3;
            o0 = __builtin_amdgcn_mfma_f32_32x32x16_f16(va0, pb, o0, 0, 0, 0);
            o1 = __builtin_amdgcn_mfma_f32_32x32x16_f16(va1, pb, o1, 0, 0, 0);
        }
        TS(26);
        if (more) { *(LAS v4u*)(L + (cur ^ 8192) + ldsw) = kr; *(LAS v4u*)(L + 16384 + (cur ^ 8192) + ldsw) = vr; }
        mw = mwn;
        TS(27);
        __syncthreads();
        TS(28);
    }
    l_run += __shfl_xor(l_run, 32);
    const float inv = 1.f / l_run;
    const u16* gp = C.GA + (size_t)t * 512 + h * 64 + 4 * half; u16* mp = C.MIX + (size_t)t * 1024 + 512 + h * 64 + 4 * half;
#pragma unroll
    for (int dt = 0; dt < 2; ++dt)
#pragma unroll
        for (int g4 = 0; g4 < 4; ++g4) {
            const int d0 = 32 * dt + 8 * g4;
            const uint2 gv = *(const uint2*)(gp + d0);
            const float ga0 = h2f((u16)(gv.x & 0xffffu)), ga1 = h2f((u16)(gv.x >> 16)), ga2 = h2f((u16)(gv.y & 0xffffu)), ga3 = h2f((u16)(gv.y >> 16));
            const f32x16& oo = dt ? o1 : o0;
            uint2 ov; ov.x = pk2h(oo[4 * g4] * inv * ga0, oo[4 * g4 + 1] * inv * ga1); ov.y = pk2h(oo[4 * g4 + 2] * inv * ga2, oo[4 * g4 + 3] * inv * ga3);
            *(uint2*)(mp + d0) = ov;
        }
}
__device__ __forceinline__ void stageB_phase(const Ctx& C, unsigned* head) {
    LAS int* slot = (LAS int*)(C.lds + LDSCTL_OFF + 256);
    int tk = wq_first(C, head);
    while (tk < 512) {
        int nx = 0;
        if (C.tid == 0) nx = (int)__hip_atomic_fetch_add(head, 1u, __ATOMIC_RELAXED, __HIP_MEMORY_SCOPE_AGENT);
        const int bk = tk & 15;
        stageB_unit(C, bk >> 1, bk & 1, 31 - (tk >> 4));
        __syncthreads();
        if (C.tid == 0) *slot = nx;
        __syncthreads();
        tk = *slot;
    }
}
__device__ __forceinline__ void selattn_row_naive(const Ctx& C, int t) {
    LAS float* qs = (LAS float*)C.lds;
    LAS unsigned* keys = (LAS unsigned*)(C.lds + 2048);
    LAS unsigned* mk = (LAS unsigned*)(C.lds + 10240);
    LAS int* wpre = (LAS int*)(C.lds + 10496);
    LAS int* red = (LAS int*)(C.lds + 10816);
    LAS int* sel = (LAS int*)(C.lds + 10880);
    LAS float* p = (LAS float*)(C.lds + 11904);
    LAS float* hl = (LAS float*)(C.lds + 21120);
    const int b = t >> 11, pos = t & (SEQ - 1), n = pos + 1, tid = C.tid;
    __syncthreads();
    if (tid < 64) mk[tid] = C.MASK[(size_t)t * 64 + tid];
    __syncthreads();
    if (tid == 0) { int a = 0; for (int i = 0; i < 64; ++i) { wpre[i] = a; a += __popc(mk[i]); } wpre[64] = a; }
    __syncthreads();
    const int nsel = wpre[64];
    for (int s = tid; s < n; s += NTH) { const unsigned wv = mk[s >> 5]; if ((wv >> (s & 31)) & 1u) sel[wpre[s >> 5] + __popc(wv & ((1u << (s & 31)) - 1u))] = s; }
    for (int i = tid; i < 512; i += NTH) qs[i] = h2f(C.Q[(size_t)t * 512 + i]);
    __syncthreads();
    if (tid < 256) {
        if (tid < nsel) {
            const int s = sel[tid];
#pragma unroll
            for (int kvh = 0; kvh < 2; ++kvh) {
                const u16* kp = C.K + (size_t)(b * SEQ + s) * 128 + kvh * 64;
                float dq[4] = {0.f, 0.f, 0.f, 0.f};
#pragma unroll 1
                for (int i = 0; i < 8; ++i) { const h16x8 v8 = *(const h16x8*)(kp + 8 * i);
#pragma unroll
                    for (int gq = 0; gq < 4; ++gq) {
#pragma unroll
                        for (int j = 0; j < 8; ++j) dq[gq] += qs[(kvh * 4 + gq) * 64 + 8 * i + j] * (float)v8[j]; } }
#pragma unroll
                for (int gq = 0; gq < 4; ++gq) p[tid * 9 + kvh * 4 + gq] = dq[gq];
            }
        } else {
#pragma unroll
            for (int h = 0; h < 8; ++h) p[tid * 9 + h] = -INFINITY;
        }
    }
    __syncthreads();
    {
        const int h = C.wave, lane = C.lane;
        float m = -INFINITY;
        for (int j = lane; j < 256; j += 64) m = fmaxf(m, p[j * 9 + h]);
#pragma unroll
        for (int o2 = 1; o2 < 64; o2 <<= 1) m = fmaxf(m, __shfl_xor(m, o2));
        float l = 0.f;
        for (int j = lane; j < 256; j += 64) { const float e = exp2f(p[j * 9 + h] - m); p[j * 9 + h] = e; l += e; }
        l = wave_sum(l);
        if (lane == 0) hl[h] = l;
    }
    __syncthreads();
    {
        const int h = tid >> 6, d = tid & 63, kvh = h >> 2;
        float a0 = 0.f;
        for (int j = 0; j < nsel; ++j) a0 += p[j * 9 + h] * h2f(C.V[(size_t)(b * SEQ + sel[j]) * 128 + kvh * 64 + d]);
        C.MIX[(size_t)t * 1024 + 512 + h * 64 + d] = f2h(a0 / hl[h] * h2f(C.GA[(size_t)t * 512 + h * 64 + d]));
    }
}

__device__ __forceinline__ void phase3_naive(const Ctx& C) {
    for (int u = C.bid; u < 16 * 128; u += C.G) {
        const int c0 = (u & 15) * 64, r0 = (u >> 4) * 128, w = C.wave, lane = C.lane, wr = w & 3, wcn = w >> 2;
        const u16* ap = C.MIX + (size_t)(r0 + wr * 32 + (lane & 31)) * DM + 8 * (lane >> 5);
        const u16* bp = C.WoutT + (size_t)(c0 + wcn * 32 + (lane & 31)) * DM + 8 * (lane >> 5);
        f32x16 acc;
#pragma unroll
        for (int r = 0; r < 16; ++r) acc[r] = 0.f;
        for (int k0 = 0; k0 < DM; k0 += 16) {
            const h16x8 a = *(const h16x8*)(ap + k0), bb = *(const h16x8*)(bp + k0);
            acc = __builtin_amdgcn_mfma_f32_32x32x16_f16(a, bb, acc, 0, 0, 0);
        }
        const int col = c0 + wcn * 32 + (lane & 31), b = r0 >> 11;
        const float gate = C.mod[b * 3072 + 2048 + col];
#pragma unroll
        for (int r = 0; r < 16; ++r) {
            const int row = r0 + wr * 32 + (r & 3) + 8 * (r >> 2) + 4 * (lane >> 5);
            C.out[(size_t)row * DM + col] = C.x[(size_t)row * DM + col] + gate * acc[r];
        }
    }
}

struct Args { const float* in[11]; float* out; unsigned char* ws; };
__global__ void __launch_bounds__(NTH, 2) mk_fwd(Args a) {
    extern __shared__ __attribute__((aligned(16))) unsigned char lds_raw[];
    Ctx C;
    C.lds = (LAS unsigned char*)lds_raw;
    C.tid = threadIdx.x; C.lane = C.tid & 63; C.wave = __builtin_amdgcn_readfirstlane(C.tid >> 6); C.bid = blockIdx.x; C.G = gridDim.x;
    C.x = a.in[0]; C.c = a.in[1]; C.norm_w = a.in[2]; C.w_ada = a.in[3]; C.b_ada = a.in[4]; C.w_in = a.in[5]; C.qnw = a.in[6]; C.knw = a.in[7];
    C.w_pool = a.in[8]; C.pool_scale = a.in[9]; C.w_out = a.in[10]; C.out = a.out;
    unsigned char* ws = a.ws;
    C.mod = (float*)(ws + WS_MOD); C.rope = (float2*)(ws + WS_ROPE); C.WinT = (u16*)(ws + WS_WINT); C.WoutT = (u16*)(ws + WS_WOUTT); C.XN = (u16*)(ws + WS_XN);
    C.U = (u16*)(ws + WS_U); C.SG = (u16*)(ws + WS_SG); C.Q = (u16*)(ws + WS_Q); C.GA = (u16*)(ws + WS_GA); C.QI = (u16*)(ws + WS_QI);
    C.K = (u16*)(ws + WS_K); C.V = (u16*)(ws + WS_V); C.KI = (u16*)(ws + WS_KI); C.VT = C.V; C.WpT = (u16*)(ws + WS_WPT); C.WI = (float*)(ws + WS_WI); C.MASK = (unsigned*)(ws + WS_MASK); C.MIX = (u16*)(ws + WS_MIX);
    volatile LAS unsigned* MISC = (volatile LAS unsigned*)(C.lds + MISC_OFF);
    for (int u = C.tid; u < (LDS_BYTES - LDSCTL_OFF) / 4; u += NTH) ((LAS unsigned*)(C.lds + LDSCTL_OFF))[u] = 0u;
    __syncthreads();
    XcdBarrier bar = xcd_barrier_post((unsigned*)(ws + WS_CTL) + CW_BAR, MISC + 8);

    TS(30);
    phase0(C);
    TS(0); xcd_barrier(bar); TS(1);
    phase0b(C);
    TS(2); xcd_barrier(bar); TS(3);
    {
        pg8::Gemm g{C.XN, C.WinT, MT, NPAD, DM}; pg8::StaticOrder S; S.init(MT, NPAD, C.G, C.bid);
        EpiP1 E{C.U, C.SG, C.Q, C.GA, C.QI, C.K, C.V, C.KI, C.WI, C.qnw, C.knw, C.rope};
        pg8::gemm_phase<EpiP1, pg8::StaticOrder, true, true>(C.lds, g, S, E);
    }
    TS(4); xcd_barrier(bar); TS(5);
    stageA_phase(C, (unsigned*)(ws + WS_CTL) + CW_QA);
    TS(6); xcd_barrier(bar); TS(8);
    stageB_phase(C, (unsigned*)(ws + WS_CTL) + CW_QB);
    TS(9); xcd_barrier(bar); TS(10);
    {
        pg8::Gemm g{C.MIX, C.WoutT, MT, DM, DM}; pg8::StaticOrder S; S.init(MT, DM, C.G, C.bid);
        EpiOut E{C.x, C.mod + 2048, C.out};
        pg8::gemm_phase<EpiOut, pg8::StaticOrder, true, true>(C.lds, g, S, E);
    }
    TS(11);
    if (ECHO >= 0) { if (threadIdx.x == 0) { volatile LAS unsigned long long* tsb_ = (volatile LAS unsigned long long*)(C.lds + LDSCTL_OFF + 512); unsigned long long d_ = 0; for (int k_ = 0; k_ < 30; ++k_) if ((ECHOM >> k_) & 1) d_ += tsb_[k_]; const unsigned long long t0_ = __builtin_amdgcn_s_memtime(); while (__builtin_amdgcn_s_memtime() - t0_ < d_) __builtin_amdgcn_s_sleep(8); } __syncthreads(); }
}

extern "C" void kernel_launch(void* const* d_in, const int* in_sizes, int n_in, void* d_out, int out_size, void* d_ws, size_t ws_size, hipStream_t stream) {
    (void)in_sizes; (void)out_size;
    static int grid = 0;
    if (grid == 0) {
        if (n_in != 11 || ws_size < WS_END) { fprintf(stderr, "kernel_launch: unexpected inputs / workspace (%d, %zu)\n", n_in, ws_size); grid = -1; return; }
        int dev = 0, cus = 0, per_cu = 0;
        hipGetDevice(&dev); hipDeviceGetAttribute(&cus, hipDeviceAttributeMultiprocessorCount, dev);
        hipFuncSetAttribute((const void*)mk_fwd, hipFuncAttributeMaxDynamicSharedMemorySize, LDS_BYTES);
        hipOccupancyMaxActiveBlocksPerMultiprocessor(&per_cu, (const void*)mk_fwd, NTH, LDS_BYTES);
        (void)hipGetLastError();
        if (per_cu < 1) { fprintf(stderr, "kernel_launch: occupancy query says %d blocks per CU\n", per_cu); per_cu = 1; }
        grid = cus;
    }
    if (grid < 0) return;
    hipMemsetAsync((char*)d_ws + WS_CTL, 0, CTL_ZERO_BYTES, stream);
    Args a{};
    for (int i = 0; i < 11; ++i) a.in[i] = (const float*)d_in[i];
    a.out = (float*)d_out; a.ws = (unsigned char*)d_ws;
    void* kargs[] = {&a};
    hipError_t e = hipLaunchCooperativeKernel((const void*)mk_fwd, dim3(grid), dim3(NTH), kargs, LDS_BYTES, stream);
    if (e != hipSuccess) fprintf(stderr, "kernel_launch: cooperative launch failed: %s (grid %d)\n", hipGetErrorString(e), grid);
}
```

```cpp
#include <hip/hip_runtime.h>
#include <stdint.h>
#include <cstdio>

typedef unsigned short u16;
typedef _Float16 h16x8 __attribute__((ext_vector_type(8)));
typedef float f32x16 __attribute__((ext_vector_type(16)));
typedef float f32x4 __attribute__((ext_vector_type(4)));
typedef unsigned v4u __attribute__((ext_vector_type(4)));
#define LAS __attribute__((address_space(3)))
#define GAS __attribute__((address_space(1)))

constexpr int NB = 8, SEQ = 2048, DM = 1024, MT = NB * SEQ;
constexpr int NPROJ = 2888, NPAD = 3072;
constexpr int NTH = 512, NWAVES = 8;
constexpr float QSCALE = 0.18033688011112042f;
constexpr float EPS = 1e-6f;

constexpr size_t WS_CTL = 0, CTL_ZERO_BYTES = 65536 + (size_t)NB * 3072 * 4;
constexpr size_t WS_MOD = 65536;
constexpr size_t WS_ROPE = WS_MOD + (size_t)NB * 3072 * 4;
constexpr size_t WS_WINT = WS_ROPE + (size_t)SEQ * 32 * 8;
constexpr size_t WS_WOUTT = WS_WINT + (size_t)NPAD * DM * 2;
constexpr size_t WS_XN = WS_WOUTT + (size_t)DM * DM * 2;
constexpr size_t WS_U = WS_XN + (size_t)MT * DM * 2;
constexpr size_t WS_SG = WS_U + (size_t)MT * 512 * 2;
constexpr size_t WS_Q = WS_SG + (size_t)MT * 512 * 2;
constexpr size_t WS_GA = WS_Q + (size_t)MT * 512 * 2;
constexpr size_t WS_QI = WS_GA + (size_t)MT * 512 * 2;
constexpr size_t WS_K = WS_QI + (size_t)MT * 512 * 2;
constexpr size_t WS_V = WS_K + (size_t)MT * 128 * 2;
constexpr size_t WS_KI = WS_V + (size_t)MT * 128 * 2;
constexpr size_t WS_WI = WS_KI + (size_t)MT * 64 * 2;
constexpr size_t WS_MASK = WS_WI + (size_t)MT * 8 * 4;
constexpr size_t WS_MIX = WS_MASK + (size_t)MT * 64 * 4;
constexpr size_t WS_WPT = WS_MIX + (size_t)MT * DM * 2;
constexpr size_t WS_END = WS_WPT + (size_t)4 * 128 * 128 * 2;
constexpr int CW_BAR = 1024;
constexpr int CW_QA = 8192, CW_QB = 8192 + 64;


#ifndef ECHO
#define ECHO -1
#endif
#ifndef ECHOM
#define ECHOM (1u << (ECHO < 0 ? 31 : ECHO))
#endif
#define TS(k) do { __builtin_amdgcn_sched_barrier(0); if (ECHO >= 0 && threadIdx.x == 0) { volatile LAS unsigned long long* tsb_ = (volatile LAS unsigned long long*)(C.lds + LDSCTL_OFF + 512); \
    const unsigned long long t_ = __builtin_amdgcn_s_memtime(); tsb_[(k)] += t_ - tsb_[31]; tsb_[31] = t_; } } while (0)
constexpr int LDS_BYTES = 147456;
constexpr int LDSCTL_OFF = LDS_BYTES - 1024, MISC_OFF = LDSCTL_OFF + 320;
__device__ __forceinline__ u16 f2h(float f) { return __builtin_bit_cast(u16, (_Float16)f); }
__device__ __forceinline__ float h2f(u16 h) { return (float)__builtin_bit_cast(_Float16, h); }
__device__ __forceinline__ float silu_f(float v) { return v / (1.f + __expf(-v)); }
__device__ __forceinline__ float wave_sum(float v) {
#pragma unroll
    for (int o = 1; o < 64; o <<= 1) v += __shfl_xor(v, o);
    return v;
}

__constant__ double ROPE_FREQ[32] = {1.0,0.7498942093324559,0.5623413251903491,0.4216965034285822,0.31622776601683794,0.23713737056616552,0.1778279410038923,0.1333521432163324,0.1,0.07498942093324558,0.05623413251903491,0.042169650342858224,0.03162277660168379,0.023713737056616554,0.01778279410038923,0.01333521432163324,0.01,0.007498942093324558,0.005623413251903491,0.004216965034285823,0.0031622776601683794,0.0023713737056616554,0.0017782794100389228,0.001333521432163324,0.001,0.0007498942093324559,0.0005623413251903491,0.00042169650342858224,0.00031622776601683794,0.00023713737056616554,0.00017782794100389227,0.0001333521432163324};

#define XB_TMO      128
#define XB_XCNT(j)  (256  + 64 * (j))
#define XB_XSUB(j)  (1280 + 64 * (j))
#define XB_XGEN(j)  (2304 + 64 * (j))
#define XB_TOP      3328
#define XB_TOPGEN   3392
#define XCD_BAR_WORDS 3456
#define XB_SPIN_CAP (1u << 18)

__device__ __forceinline__ unsigned xb_ld(unsigned* p)              { return __hip_atomic_load(p, __ATOMIC_RELAXED, __HIP_MEMORY_SCOPE_AGENT); }
__device__ __forceinline__ unsigned xb_add(unsigned* p, unsigned v) { return __hip_atomic_fetch_add(p, v, __ATOMIC_RELAXED, __HIP_MEMORY_SCOPE_AGENT); }
__device__ __forceinline__ unsigned xb_xcc_id() { return (unsigned)__builtin_amdgcn_s_getreg((3 << 11) | 20) & 0xFu; }
#define XB_SPIN(cond, bar) do { unsigned _sp = 0; while (cond) { __builtin_amdgcn_s_sleep(1); \
    if ((++_sp & 255u) == 0u) { if (xb_ld(&(bar)[XB_TMO])) break; if (_sp > XB_SPIN_CAP) { atomicAdd(&(bar)[XB_TMO], 1u); break; } } } } while (0)

struct XcdBarrier {
    unsigned* bar; unsigned x;
    volatile LAS unsigned* st;
};

__device__ __forceinline__ XcdBarrier xcd_barrier_post(unsigned* bar, volatile LAS unsigned* st) {
    XcdBarrier b; b.bar = bar; b.x = xb_xcc_id(); b.st = st;
    if (threadIdx.x == 0) (void)xb_add(&bar[XB_XCNT(b.x)], 1u);
    return b;
}
__device__ __forceinline__ void xcd_barrier_complete(unsigned* bar, unsigned x, unsigned& nloc, unsigned& nx) {
    const unsigned G = gridDim.x * gridDim.y * gridDim.z;
    unsigned sum, cnt, mine, sp = 0u;
    for (;;) {
        sum = 0u; cnt = 0u; mine = 0u;
#pragma unroll
        for (unsigned j = 0; j < 16; ++j) { const unsigned c = xb_ld(&bar[XB_XCNT(j)]); sum += c; cnt += (c > 0u) ? 1u : 0u; mine = (j == x) ? c : mine; }
        if (sum == G) break;
        __builtin_amdgcn_s_sleep(1);
        if ((++sp & 255u) == 0u) { if (xb_ld(&bar[XB_TMO])) break; if (sp > XB_SPIN_CAP) { atomicAdd(&bar[XB_TMO], 1u); break; } }
    }
    nloc = mine > 0u ? mine : 1u; nx = cnt > 0u ? cnt : 1u;
}

__device__ __forceinline__ void xcd_barrier(const XcdBarrier& b) {
    asm volatile("s_waitcnt vmcnt(0)" ::: "memory");
    __syncthreads();
    if (threadIdx.x == 0) {
        unsigned* bar = b.bar;
        __builtin_amdgcn_s_waitcnt(0);
        unsigned nloc = b.st[0], nx = b.st[1];
        if (nloc == 0u) { xcd_barrier_complete(bar, b.x, nloc, nx); b.st[0] = nloc; b.st[1] = nx; }
        const unsigned old = xb_add(&bar[XB_XSUB(b.x)], 1u);
        const unsigned gen = old / nloc;
        if (old + 1u == (gen + 1u) * nloc) {
            __builtin_amdgcn_fence(__ATOMIC_RELEASE, "agent");
            asm volatile("s_waitcnt vmcnt(0)" ::: "memory");
            const unsigned og = xb_add(&bar[XB_TOP], 1u);
            const unsigned tg = og / nx;
            if (og + 1u == (tg + 1u) * nx) xb_add(&bar[XB_TOPGEN], 1u);
            else XB_SPIN(xb_ld(&bar[XB_TOPGEN]) == tg, bar);
            __builtin_amdgcn_fence(__ATOMIC_ACQUIRE, "agent");
            xb_add(&bar[XB_XGEN(b.x)], 1u);
            asm volatile("s_waitcnt vmcnt(0)" ::: "memory");
        } else {
            XB_SPIN(xb_ld(&bar[XB_XGEN(b.x)]) == gen, bar);
            __builtin_amdgcn_fence(__ATOMIC_ACQUIRE, "agent");
            asm volatile("s_waitcnt vmcnt(0)" ::: "memory");
        }
    }
    __syncthreads();
}


struct Ctx {
    const float *x, *c, *norm_w, *w_ada, *b_ada, *w_in, *qnw, *knw, *w_pool, *pool_scale, *w_out;
    float* out;
    float* mod; float2* rope; u16 *WinT, *WoutT, *XN, *U, *SG, *Q, *GA, *QI, *K, *V, *KI, *VT, *WpT; float* WI; unsigned* MASK; u16* MIX;
    LAS unsigned char* lds;
    int tid, lane, wave, bid, G;
};

__device__ __forceinline__ unsigned pk2h(float lo, float hi);
__device__ __forceinline__ void p0_mod_unit(const Ctx& C, int u) {
    LAS float* sc = (LAS float*)C.lds;
    const int nb = u >> 4, ks = u & 15, d0 = ks * 64;
    __syncthreads();
    { const int bb = C.tid >> 6, dd = C.tid & 63; sc[C.tid] = silu_f(C.c[bb * DM + d0 + dd]); }
    __syncthreads();
    const int col = nb * 256 + (C.tid & 255), bh = (C.tid >> 8) * 4;
    float a0 = 0.f, a1 = 0.f, a2 = 0.f, a3 = 0.f;
    const float* wp = C.w_ada + (size_t)d0 * 3072 + col;
#pragma unroll 8
    for (int d = 0; d < 64; ++d) { const float wv = wp[(size_t)d * 3072]; a0 += sc[(bh + 0) * 64 + d] * wv; a1 += sc[(bh + 1) * 64 + d] * wv; a2 += sc[(bh + 2) * 64 + d] * wv; a3 += sc[(bh + 3) * 64 + d] * wv; }
    if (ks == 0) { const float bv = C.b_ada[col]; a0 += bv; a1 += bv; a2 += bv; a3 += bv; }
    atomicAdd(C.mod + (bh + 0) * 3072 + col, a0); atomicAdd(C.mod + (bh + 1) * 3072 + col, a1); atomicAdd(C.mod + (bh + 2) * 3072 + col, a2); atomicAdd(C.mod + (bh + 3) * 3072 + col, a3);
}
__device__ __forceinline__ void p0_rope_unit(const Ctx& C, int u) {
    const int idx = u * NTH + C.tid, pos = idx >> 5, i = idx & 31;
    const double ang = (double)pos * ROPE_FREQ[i];
    double t = ang * 0.15915494309189533576888;
    t -= floor(t + 0.5);
    const double x = t * 6.283185307179586476925287, x2 = x * x;
    double s = 0.0, cc = 0.0, ts = x, tc = 1.0;
#pragma unroll 1
    for (int n = 0; n < 14; ++n) { cc += tc; s += ts; tc *= -x2 / (double)((2 * n + 1) * (2 * n + 2)); ts *= -x2 / (double)((2 * n + 2) * (2 * n + 3)); }
    C.rope[idx] = make_float2((float)cc, (float)s);
}
__device__ __forceinline__ void p0_conv_item(const Ctx& C, const float* W, int N, u16* WT, int Kdim, bool perm, LAS float* scr, int item) {
    const int lane = C.lane, nkb = Kdim >> 6, kb = item % nkb, nb = item / nkb, k0 = 64 * kb, n0 = 32 * nb;
    const int nn = lane & 31, n = n0 + nn;
#pragma unroll 8
    for (int i = 0; i < 32; ++i) { const int kk = 2 * i + (lane >> 5); scr[kk * 33 + nn] = n < N ? W[(size_t)(k0 + kk) * N + n] : 0.f; }
    asm volatile("s_waitcnt lgkmcnt(0)" ::: "memory");
    const int c = lane & 7;
#pragma unroll
    for (int j = 0; j < 4; ++j) {
        const int nr = (lane >> 3) + 8 * j; const LAS float* sp = scr + (8 * c) * 33 + nr;
        v4u o; o.x = pk2h(sp[0 * 33], sp[1 * 33]); o.y = pk2h(sp[2 * 33], sp[3 * 33]); o.z = pk2h(sp[4 * 33], sp[5 * 33]); o.w = pk2h(sp[6 * 33], sp[7 * 33]);
        const int nl = n0 + nr, np = perm ? ((nl & ~255) | (((nl >> 5) & 1) << 7) | (((nl >> 6) & 3) << 5) | (nl & 31)) : nl;
        *(v4u*)(WT + (size_t)np * Kdim + k0 + 8 * c) = o;
    }
    asm volatile("s_waitcnt lgkmcnt(0)" ::: "memory");
}
__device__ __forceinline__ void phase0(const Ctx& C) {
    constexpr int U_MOD = 192, U_ROPE = 128;
    for (int u = C.bid; u < U_MOD + U_ROPE; u += C.G) { if (u < U_MOD) p0_mod_unit(C, u); else p0_rope_unit(C, u - U_MOD); }
    __syncthreads();
    LAS float* scr = (LAS float*)(C.lds + C.wave * 16384);
    constexpr int I_WIN = 16 * 96, I_WOUT = 16 * 32, I_WP = 4 * 2 * 4, I_ALL = I_WIN + I_WOUT + I_WP;
    const int gw0 = ((C.bid + 64) % C.G) * NWAVES + C.wave, NGW = C.G * NWAVES;
    for (int it = gw0; it < I_ALL; it += NGW) {
        int r = it;
        if (r < I_WIN) { p0_conv_item(C, C.w_in, NPROJ, C.WinT, DM, true, scr, r); continue; } r -= I_WIN;
        if (r < I_WOUT) { p0_conv_item(C, C.w_out, DM, C.WoutT, DM, false, scr, r); continue; } r -= I_WOUT;
        p0_conv_item(C, C.w_pool + (size_t)(r >> 3) * 128 * 128, 128, C.WpT + (size_t)(r >> 3) * 128 * 128, 128, false, scr, r & 7);
    }
}

__device__ __forceinline__ void phase0b(const Ctx& C) {
    for (int row = C.bid * NWAVES + C.wave; row < MT; row += C.G * NWAVES) {
        const int lane = C.lane, b = row >> 11;
        const float4* xr = (const float4*)(C.x + (size_t)row * DM) + lane;
        float4 v[4]; float s = 0.f;
#pragma unroll
        for (int j = 0; j < 4; ++j) { v[j] = xr[64 * j]; s += v[j].x * v[j].x + v[j].y * v[j].y + v[j].z * v[j].z + v[j].w * v[j].w; }
        const float rstd = rsqrtf(wave_sum(s) * (1.f / DM) + EPS);
        const float* shift = C.mod + b * 3072; const float* scale = shift + 1024;
#pragma unroll
        for (int j = 0; j < 4; ++j) {
            const int k = 4 * lane + 256 * j;
            const float4 w4 = *(const float4*)(C.norm_w + k), s4 = *(const float4*)(scale + k), h4 = *(const float4*)(shift + k);
            const float o0 = v[j].x * rstd * w4.x * (1.f + s4.x) + h4.x, o1 = v[j].y * rstd * w4.y * (1.f + s4.y) + h4.y;
            const float o2 = v[j].z * rstd * w4.z * (1.f + s4.z) + h4.z, o3 = v[j].w * rstd * w4.w * (1.f + s4.w) + h4.w;
            ushort4 o; o.x = f2h(o0); o.y = f2h(o1); o.z = f2h(o2); o.w = f2h(o3);
            *(ushort4*)(C.XN + (size_t)row * DM + k) = o;
        }
    }
}


namespace pg8 {
#define PG8_LAS __attribute__((address_space(3)))
typedef unsigned short bf16_t;
typedef _Float16 bf16x8 __attribute__((ext_vector_type(8)));
typedef float f32x4 __attribute__((ext_vector_type(4)));
typedef unsigned u32x4 __attribute__((ext_vector_type(4)));
constexpr int BM = 256, BK = 64, HALF = 128, HTB = HALF * BK * 2  , STAGE_BYTES = 8 * HTB, NXCD = 8, WGM = 8;

__host__ __device__ __forceinline__ int lds_byte(int r, int c) { const int st = (r >> 4) * 2 + (c >> 5), rr = r & 15, cc = c & 31, ob = rr * 64 + cc * 2; return st * 1024 + (ob ^ (((ob >> 9) & 1) << 5)); }
__host__ __device__ __forceinline__ void stage_rc(int b, int& R, int& C) { const int st = b / 1024, sb = b % 1024, swz = sb ^ (((sb >> 9) & 1) << 5); R = (st >> 1) * 16 + swz / 64; C = (st & 1) * 32 + (swz % 64) / 2; }
__host__ __device__ __forceinline__ int perm32(int rho) { const int n = rho >> 4, i = rho & 15; return 8 * (i >> 2) + 4 * n + (i & 3); }

struct Unit { int pm, pn; };
struct Gemm { const bf16_t* A; const bf16_t* Bt; int M, N, K; };

struct StaticOrder {
    int nM, nN, nwg, G, c;
    __host__ __device__ void init(int M, int N, int G_, int c_) { nM = M / BM; nN = N / BM; nwg = nM * nN; G = G_; c = c_; }
    __host__ __device__ bool next(int i, Unit& u) const {
        const long L = (long)i * G + c; if (L >= nwg) return false;
        int wgid = (int)L; { const int q = nwg / NXCD, r = nwg % NXCD, xcd = wgid % NXCD, off = wgid / NXCD; wgid = (xcd < r ? xcd * (q + 1) : r * (q + 1) + (xcd - r) * q) + off; }
        const int nig = WGM * nN, gid = wgid / nig, fm = gid * WGM, gsz = (nM - fm) < WGM ? (nM - fm) : WGM;
        u.pm = fm + ((wgid % nig) % gsz); u.pn = (wgid % nig) / gsz; return true;
    }
    __device__ __forceinline__ void a_ready(const Unit&) const {}
    __device__ __forceinline__ void done(const Unit&) const {}
};

template <class Epi, class Sched, bool ALIGN_EPI = false, bool SP2 = false>
__device__ __forceinline__ void gemm_phase(PG8_LAS unsigned char* lds, const Gemm g, const Sched& S, const Epi& E) {
    int tid_ = threadIdx.x; asm volatile("" : "+v"(tid_));
    const int tid = tid_, wid = __builtin_amdgcn_readfirstlane(tid >> 6), lane = tid & 63, wr = wid >> 2, wc = wid & 3, fr = lane & 15, fq = lane >> 4;
    const int K = g.K, nt = K / BK;
    unsigned voffA[2], voffB[2];
#pragma unroll
    for (int i = 0; i < 2; ++i) { int R, C; stage_rc(tid * 16 + i * 8192, R, C); const int Rb = Epi::PERM ? ((R & ~31) + perm32(R & 31)) : R;
        voffA[i] = (unsigned)(R * K + C) * 2u; voffB[i] = (unsigned)(Rb * K + C) * 2u; }
    const size_t kstep = (size_t)(BK * 2);
    const size_t hstep = (size_t)HALF * K * 2;
    const size_t tstep = 2 * hstep;
    const unsigned ldsw = (unsigned)wid * 1024u;
    const int aoff = lds_byte(wr * 64 + fr, fq * 8), boff = lds_byte(wc * 32 + fr, fq * 8);
#define PG8_SA(b, h) (((b) * 2 + (h)) * HTB)
#define PG8_SB(b, h) ((4 + (b) * 2 + (h)) * HTB)
#define PG8_STAGE(bufoff, gbase, voff) do { _Pragma("unroll") for (int _i = 0; _i < 2; ++_i) \
        __builtin_amdgcn_global_load_lds((const unsigned*)((const char*)(gbase) + (voff)[_i]), (PG8_LAS unsigned*)(lds + (bufoff) + ldsw + _i * 8192), 16, 0, 0); } while (0)
#define PG8_LDA(dst, b, h) do { _Pragma("unroll") for (int m = 0; m < 4; ++m) _Pragma("unroll") for (int k = 0; k < 2; ++k) dst[m][k] = *(const PG8_LAS bf16x8*)(lds + PG8_SA(b, h) + aoff + m * 2048 + k * 1024); } while (0)
#define PG8_LDB(dst, b, h) do { _Pragma("unroll") for (int n = 0; n < 2; ++n) _Pragma("unroll") for (int k = 0; k < 2; ++k) dst[n][k] = *(const PG8_LAS bf16x8*)(lds + PG8_SB(b, h) + boff + n * 2048 + k * 1024); } while (0)
#define PG8_MMA(ai, bj, At, Bt) do { __builtin_amdgcn_s_setprio(1); _Pragma("unroll") for (int m = 0; m < 4; ++m) _Pragma("unroll") for (int n = 0; n < 2; ++n) _Pragma("unroll") for (int k = 0; k < 2; ++k) \
        acc[ai][bj][m][n] = __builtin_amdgcn_mfma_f32_16x16x32_f16(Bt[n][k], At[m][k], acc[ai][bj][m][n], 0, 0, 0); __builtin_amdgcn_s_setprio(0); } while (0)
#define PG8_WAIT_V(n) asm volatile("s_waitcnt vmcnt(" #n ")" ::: "memory")
#define PG8_WAIT_L(n) asm volatile("s_waitcnt lgkmcnt(" #n ")" ::: "memory")
#define PG8_BAR __builtin_amdgcn_s_barrier()
#define PG8_SCHED __builtin_amdgcn_sched_barrier(0)
    Unit cur, nxt; int ui = 0;
    if (!S.next(0, cur)) return;
    f32x4 acc[2][2][4][2];
#pragma unroll
    for (int a = 0; a < 2; ++a)
#pragma unroll
        for (int b = 0; b < 2; ++b)
#pragma unroll
            for (int m = 0; m < 4; ++m)
#pragma unroll
                for (int n = 0; n < 2; ++n) acc[a][b][m][n] = (f32x4){0.f, 0.f, 0.f, 0.f};
    bf16x8 At[4][2], B0[2][2], B1[2][2];
    const char* cA = (const char*)g.A + (size_t)cur.pm * tstep; const char* cB = (const char*)g.Bt + (size_t)cur.pn * tstep;
    S.a_ready(cur);
    if constexpr (SP2) {
        PG8_STAGE(PG8_SB(0, 0), cB, voffB); PG8_STAGE(PG8_SB(0, 1), cB + hstep, voffB); PG8_STAGE(PG8_SA(0, 0), cA, voffA); PG8_STAGE(PG8_SA(0, 1), cA + hstep, voffA);
        if (wr == 1) PG8_BAR;
        PG8_WAIT_V(2); PG8_BAR;
        PG8_STAGE(PG8_SB(1, 0), cB + kstep, voffB); PG8_STAGE(PG8_SA(1, 0), cA + kstep, voffA); PG8_STAGE(PG8_SB(1, 1), cB + hstep + kstep, voffB);
        PG8_WAIT_V(6); PG8_BAR;
    } else {
        PG8_STAGE(PG8_SB(0, 0), cB, voffB); PG8_STAGE(PG8_SA(0, 0), cA, voffA); PG8_STAGE(PG8_SB(0, 1), cB + hstep, voffB); PG8_STAGE(PG8_SA(0, 1), cA + hstep, voffA);
        if (wr == 1) PG8_BAR;
        PG8_WAIT_V(4); PG8_BAR;
        PG8_STAGE(PG8_SB(1, 0), cB + kstep, voffB); PG8_STAGE(PG8_SA(1, 0), cA + kstep, voffA); PG8_STAGE(PG8_SB(1, 1), cB + hstep + kstep, voffB);
        PG8_WAIT_V(6); PG8_BAR;
    }
    for (;;) {
        const bool has_next = S.next(ui + 1, nxt);
        const char* nA = has_next ? (const char*)g.A + (size_t)nxt.pm * tstep : cA; const char* nB = has_next ? (const char*)g.Bt + (size_t)nxt.pn * tstep : cB;
        for (int t = 0; t < nt; t += 2) {
            const bool last = (t == nt - 2);
            const char* a1 = cA + (size_t)(t + 1) * kstep;
            const char* a2 = last ? nA : cA + (size_t)(t + 2) * kstep; const char* b2 = last ? nB : cB + (size_t)(t + 2) * kstep;
            const char* a3 = a2 + kstep; const char* b3 = b2 + kstep;
            if (last && has_next) S.a_ready(nxt);
            if constexpr (SP2) {
            PG8_LDB(B0, 0, 0); PG8_LDB(B1, 0, 1); PG8_SCHED; PG8_LDA(At, 0, 0); PG8_STAGE(PG8_SA(1, 1), a1 + hstep, voffA);
            PG8_WAIT_V(8); PG8_WAIT_L(0); PG8_BAR; PG8_MMA(0, 0, At, B0); PG8_MMA(0, 1, At, B1); PG8_BAR; PG8_SCHED;
            PG8_LDA(At, 0, 1); PG8_STAGE(PG8_SB(0, 0), b2, voffB); PG8_STAGE(PG8_SB(0, 1), b2 + hstep, voffB); PG8_STAGE(PG8_SA(0, 0), a2, voffA);
            PG8_WAIT_V(8); PG8_WAIT_L(0); PG8_BAR; PG8_MMA(1, 0, At, B0); PG8_MMA(1, 1, At, B1); PG8_BAR; PG8_SCHED;
            PG8_LDB(B0, 1, 0); PG8_LDB(B1, 1, 1); PG8_SCHED; PG8_LDA(At, 1, 0); PG8_STAGE(PG8_SA(0, 1), a2 + hstep, voffA);
            PG8_WAIT_V(8); PG8_WAIT_L(0); PG8_BAR; PG8_MMA(0, 0, At, B0); PG8_MMA(0, 1, At, B1); PG8_BAR; PG8_SCHED;
            PG8_LDA(At, 1, 1); PG8_STAGE(PG8_SB(1, 0), b3, voffB); PG8_STAGE(PG8_SB(1, 1), b3 + hstep, voffB); PG8_STAGE(PG8_SA(1, 0), a3, voffA);
            PG8_WAIT_V(8); PG8_WAIT_L(0); PG8_BAR; PG8_MMA(1, 0, At, B0); PG8_MMA(1, 1, At, B1); PG8_BAR; PG8_SCHED;
            } else {
            PG8_LDB(B0, 0, 0); PG8_SCHED; PG8_LDA(At, 0, 0); PG8_STAGE(PG8_SA(1, 1), a1 + hstep, voffA);
            PG8_WAIT_L(8); PG8_BAR; PG8_WAIT_L(0); PG8_MMA(0, 0, At, B0); PG8_BAR; PG8_SCHED;
            PG8_LDB(B1, 0, 1); PG8_STAGE(PG8_SB(0, 0), b2, voffB);
            PG8_BAR; PG8_WAIT_L(0); PG8_MMA(0, 1, At, B1); PG8_BAR;
            PG8_LDA(At, 0, 1); PG8_STAGE(PG8_SA(0, 0), a2, voffA);
            PG8_BAR; PG8_WAIT_L(0); PG8_MMA(1, 0, At, B0); PG8_BAR; PG8_SCHED;
            PG8_STAGE(PG8_SB(0, 1), b2 + hstep, voffB);
            PG8_WAIT_V(6); PG8_BAR; PG8_MMA(1, 1, At, B1); PG8_BAR;
            PG8_LDB(B0, 1, 0); PG8_SCHED; PG8_LDA(At, 1, 0); PG8_STAGE(PG8_SA(0, 1), a2 + hstep, voffA);
            PG8_WAIT_L(8); PG8_BAR; PG8_WAIT_L(0); PG8_MMA(0, 0, At, B0); PG8_BAR; PG8_SCHED;
            PG8_LDB(B1, 1, 1); PG8_STAGE(PG8_SB(1, 0), b3, voffB);
            PG8_BAR; PG8_WAIT_L(0); PG8_MMA(0, 1, At, B1); PG8_BAR;
            PG8_LDA(At, 1, 1); PG8_STAGE(PG8_SA(1, 0), a3, voffA);
            PG8_BAR; PG8_WAIT_L(0); PG8_MMA(1, 0, At, B0); PG8_BAR; PG8_SCHED;
            PG8_STAGE(PG8_SB(1, 1), b3 + hstep, voffB);
            PG8_WAIT_V(6); PG8_BAR; PG8_MMA(1, 1, At, B1); PG8_BAR;
            }
        }
        if constexpr (ALIGN_EPI) { if (wr == 0) PG8_BAR; }
        if constexpr (!Epi::AFTER_DRAIN) { E(acc, cur, wr, wc, fr, fq); S.done(cur); }
        if (!has_next) break;
#pragma unroll
        for (int a = 0; a < 2; ++a)
#pragma unroll
            for (int b = 0; b < 2; ++b)
#pragma unroll
                for (int m = 0; m < 4; ++m)
#pragma unroll
                    for (int n = 0; n < 2; ++n) acc[a][b][m][n] = (f32x4){0.f, 0.f, 0.f, 0.f};
        cur = nxt; cA = nA; cB = nB; ++ui;
        if constexpr (ALIGN_EPI) { if (wr == 1) PG8_BAR; }
    }
    PG8_WAIT_V(0);
    if constexpr (!ALIGN_EPI) { if (wr == 0) PG8_BAR; }
    PG8_BAR;
    if constexpr (Epi::AFTER_DRAIN) { E.fused(acc, cur, wr, wc, fr, fq, lds, wid, lane); S.done(cur); }
#undef PG8_SA
#undef PG8_SB
#undef PG8_STAGE
#undef PG8_LDA
#undef PG8_LDB
#undef PG8_MMA
#undef PG8_WAIT_V
#undef PG8_WAIT_L
#undef PG8_BAR
#undef PG8_SCHED
}
}


__device__ __forceinline__ unsigned pk2h(float lo, float hi) { typedef _Float16 h2 __attribute__((ext_vector_type(2))); h2 v; v.x = (_Float16)lo; v.y = (_Float16)hi; return __builtin_bit_cast(unsigned, v); }

struct EpiP1 {
    static constexpr bool PERM = true, AFTER_DRAIN = false;
    u16 *U, *SG, *Q, *GA, *QI, *K, *V, *KI; float* WI; const float *qnw, *knw; const float2* rope;
    __device__ __forceinline__ void operator()(const f32x4 (&acc)[2][2][4][2], const pg8::Unit& u, int wr, int wc, int fr, int fq) const {
        const int g = u.pn * 4 + wc;
        if (g > 45) return;
        int mode, ld; u16* dst; const float* nwp = qnw; float osc = 1.f;
        if (g < 8) { mode = 0; dst = U + g * 64; ld = 512; }
        else if (g < 16) { mode = 1; dst = SG + (g - 8) * 64; ld = 512; }
        else if (g < 24) { mode = 2; dst = Q + (g - 16) * 64; ld = 512; osc = QSCALE; }
        else if (g < 26) { mode = 2; dst = K + (g - 24) * 64; ld = 128; nwp = knw; }
        else if (g < 28) { mode = 5; dst = V; ld = 128; }
        else if (g < 36) { mode = 1; dst = GA + (g - 28) * 64; ld = 512; }
        else if (g < 44) { mode = 3; dst = QI + (g - 36) * 64; ld = 512; }
        else if (g == 44) { mode = 3; dst = KI; ld = 64; }
        else { mode = 4; dst = KI; ld = 64; }
        const int row0 = u.pm * 256 + wr * 64 + fr;
        if (mode == 5) {
            const int kvh = g - 26;
#pragma unroll
            for (int ai = 0; ai < 2; ++ai)
#pragma unroll
                for (int m = 0; m < 4; ++m) {
                    const int t = row0 + ai * 128 + m * 16, bb = t >> 11, pos = t & (SEQ - 1), pp = (pos & ~12) | ((pos & 4) << 1) | ((pos & 8) >> 1);
                    u16* vp = dst + ((size_t)((bb * 2 + kvh) * 64 + 8 * fq)) * SEQ + pp;
#pragma unroll
                    for (int bj = 0; bj < 2; ++bj)
#pragma unroll
                        for (int n = 0; n < 2; ++n)
#pragma unroll
                            for (int j = 0; j < 4; ++j) vp[(size_t)(32 * bj + 4 * n + j) * SEQ] = f2h(acc[ai][bj][m][n][j]);
                }
            return;
        }
        if (mode == 4) {
            if (fq == 0) {
#pragma unroll
                for (int ai = 0; ai < 2; ++ai)
#pragma unroll
                    for (int m = 0; m < 4; ++m) { float* wp = WI + (size_t)(row0 + ai * 128 + m * 16) * 8; *(f32x4*)wp = acc[ai][0][m][0]; *(f32x4*)(wp + 4) = acc[ai][0][m][1]; }
            }
            return;
        }
        f32x4 nlo0 = {1.f, 1.f, 1.f, 1.f}, nlo1 = nlo0, nhi0 = nlo0, nhi1 = nlo0;
        if (mode == 2) { nlo0 = *(const f32x4*)(nwp + 8 * fq); nlo1 = *(const f32x4*)(nwp + 8 * fq + 4); nhi0 = *(const f32x4*)(nwp + 32 + 8 * fq); nhi1 = *(const f32x4*)(nwp + 36 + 8 * fq); }
#pragma unroll
        for (int ai = 0; ai < 2; ++ai)
#pragma unroll
            for (int m = 0; m < 4; ++m) {
                const int t = row0 + ai * 128 + m * 16;
                f32x4 a0 = acc[ai][0][m][0], a1 = acc[ai][0][m][1], b0 = acc[ai][1][m][0], b1 = acc[ai][1][m][1];
                if (mode == 1) {
#pragma unroll
                    for (int j = 0; j < 4; ++j) { a0[j] = silu_f(a0[j]); a1[j] = silu_f(a1[j]); b0[j] = silu_f(b0[j]); b1[j] = silu_f(b1[j]); }
                } else if (mode >= 2) {
                    if (mode == 2) {
                        float ss = 0.f;
#pragma unroll
                        for (int j = 0; j < 4; ++j) ss += a0[j] * a0[j] + a1[j] * a1[j] + b0[j] * b0[j] + b1[j] * b1[j];
                        ss += __shfl_xor(ss, 16); ss += __shfl_xor(ss, 32);
                        const float rinv = rsqrtf(ss * (1.f / 64.f) + EPS);
                        a0 = a0 * rinv * nlo0; a1 = a1 * rinv * nlo1; b0 = b0 * rinv * nhi0; b1 = b1 * rinv * nhi1;
                    }
                    const f32x4* rp = (const f32x4*)(rope + (size_t)(t & (SEQ - 1)) * 32 + 8 * fq);
                    const f32x4 r0 = rp[0], r1 = rp[1], r2 = rp[2], r3 = rp[3];
                    f32x4 o0, o1, p0, p1;
                    o0[0] = a0[0] * r0[0] - b0[0] * r0[1]; p0[0] = b0[0] * r0[0] + a0[0] * r0[1];
                    o0[1] = a0[1] * r0[2] - b0[1] * r0[3]; p0[1] = b0[1] * r0[2] + a0[1] * r0[3];
                    o0[2] = a0[2] * r1[0] - b0[2] * r1[1]; p0[2] = b0[2] * r1[0] + a0[2] * r1[1];
                    o0[3] = a0[3] * r1[2] - b0[3] * r1[3]; p0[3] = b0[3] * r1[2] + a0[3] * r1[3];
                    o1[0] = a1[0] * r2[0] - b1[0] * r2[1]; p1[0] = b1[0] * r2[0] + a1[0] * r2[1];
                    o1[1] = a1[1] * r2[2] - b1[1] * r2[3]; p1[1] = b1[1] * r2[2] + a1[1] * r2[3];
                    o1[2] = a1[2] * r3[0] - b1[2] * r3[1]; p1[2] = b1[2] * r3[0] + a1[2] * r3[1];
                    o1[3] = a1[3] * r3[2] - b1[3] * r3[3]; p1[3] = b1[3] * r3[2] + a1[3] * r3[3];
                    a0 = o0 * osc; a1 = o1 * osc; b0 = p0 * osc; b1 = p1 * osc;
                }
                u16* dp = dst + (size_t)t * ld + 8 * fq;
                v4u lo, hi; lo.x = pk2h(a0[0], a0[1]); lo.y = pk2h(a0[2], a0[3]); lo.z = pk2h(a1[0], a1[1]); lo.w = pk2h(a1[2], a1[3]);
                hi.x = pk2h(b0[0], b0[1]); hi.y = pk2h(b0[2], b0[3]); hi.z = pk2h(b1[0], b1[1]); hi.w = pk2h(b1[2], b1[3]);
                *(v4u*)dp = lo; *(v4u*)(dp + 32) = hi;
                if (m & 1) asm volatile("" ::: "memory");
            }
    }
};
struct EpiOut {
    static constexpr bool PERM = true, AFTER_DRAIN = false;
    const float* x; const float* gate; float* out;
    __device__ __forceinline__ void operator()(const f32x4 (&acc)[2][2][4][2], const pg8::Unit& u, int wr, int wc, int fr, int fq) const {
        const int row0 = u.pm * 256 + wr * 64 + fr, col0 = u.pn * 256 + wc * 32 + 8 * fq, b = (u.pm * 256) >> 11;
        f32x4 gv[2][2];
#pragma unroll
        for (int bj = 0; bj < 2; ++bj)
#pragma unroll
            for (int n = 0; n < 2; ++n) gv[bj][n] = *(const f32x4*)(gate + b * 3072 + col0 + bj * 128 + 4 * n);
#pragma unroll
        for (int ai = 0; ai < 2; ++ai)
#pragma unroll
            for (int m = 0; m < 4; ++m) {
                const size_t off = (size_t)(row0 + ai * 128 + m * 16) * DM + col0;
#pragma unroll
                for (int bj = 0; bj < 2; ++bj)
#pragma unroll
                    for (int n = 0; n < 2; ++n) { const f32x4 xv = *(const f32x4*)(x + off + bj * 128 + 4 * n); *(f32x4*)(out + off + bj * 128 + 4 * n) = xv + gv[bj][n] * acc[ai][bj][m][n]; }
                if (m & 1) asm volatile("" ::: "memory");
            }
    }
};

__device__ __forceinline__ void p1_epilogue_row(const Ctx& C, int g, int t, int sub, const LAS float* tr) {
    const int pos = t & (SEQ - 1);
    if (g < 8) {
        for (int c = 16 * sub; c < 16 * sub + 16; ++c) C.U[(size_t)t * 512 + g * 64 + c] = f2h(tr[c]);
    } else if (g < 16) {
        for (int c = 16 * sub; c < 16 * sub + 16; ++c) C.SG[(size_t)t * 512 + (g - 8) * 64 + c] = f2h(silu_f(tr[c]));
    } else if (g < 26) {
        float ss = 0.f;
        for (int c = 16 * sub; c < 16 * sub + 16; ++c) ss += tr[c] * tr[c];
        ss += __shfl_xor(ss, 1); ss += __shfl_xor(ss, 2);
        const float rinv = rsqrtf(ss * (1.f / 64.f) + EPS);
        const bool isq = g < 24; const float* nwp = isq ? C.qnw : C.knw; const float osc = isq ? QSCALE : 1.f;
        u16* dst = isq ? C.Q + (size_t)t * 512 + (g - 16) * 64 : C.K + (size_t)t * 128 + (g - 24) * 64;
        for (int i = 8 * sub; i < 8 * sub + 8; ++i) {
            const float x1 = tr[i] * rinv * nwp[i], x2 = tr[i + 32] * rinv * nwp[i + 32];
            const float2 cs = C.rope[pos * 32 + i];
            dst[i] = f2h((x1 * cs.x - x2 * cs.y) * osc); dst[i + 32] = f2h((x2 * cs.x + x1 * cs.y) * osc);
        }
    } else if (g < 28) {
        for (int c = 16 * sub; c < 16 * sub + 16; ++c) C.V[(size_t)t * 128 + (g - 26) * 64 + c] = f2h(tr[c]);
    } else if (g < 36) {
        for (int c = 16 * sub; c < 16 * sub + 16; ++c) C.GA[(size_t)t * 512 + (g - 28) * 64 + c] = f2h(silu_f(tr[c]));
    } else if (g < 45) {
        u16* dst = g < 44 ? C.QI + (size_t)t * 512 + (g - 36) * 64 : C.KI + (size_t)t * 64;
        for (int i = 8 * sub; i < 8 * sub + 8; ++i) {
            const float x1 = tr[i], x2 = tr[i + 32];
            const float2 cs = C.rope[pos * 32 + i];
            dst[i] = f2h(x1 * cs.x - x2 * cs.y); dst[i + 32] = f2h(x2 * cs.x + x1 * cs.y);
        }
    } else {
        if (sub == 0) for (int c = 0; c < 8; ++c) C.WI[(size_t)t * 8 + c] = tr[c];
    }
}
__device__ __forceinline__ void phase1_naive(const Ctx& C) {
    LAS float* tile = (LAS float*)C.lds;
    for (int u = C.bid; u < 46 * 128; u += C.G) {
        const int g = u % 46, r0 = (u / 46) * 128, w = C.wave, lane = C.lane, wr = w & 3, wcn = w >> 2;
        const u16* ap = C.XN + (size_t)(r0 + wr * 32 + (lane & 31)) * DM + 8 * (lane >> 5);
        const u16* bp = C.WinT + (size_t)(g * 64 + wcn * 32 + (lane & 31)) * DM + 8 * (lane >> 5);
        f32x16 acc;
#pragma unroll
        for (int r = 0; r < 16; ++r) acc[r] = 0.f;
        for (int k0 = 0; k0 < DM; k0 += 16) {
            const h16x8 a = *(const h16x8*)(ap + k0), bb = *(const h16x8*)(bp + k0);
            acc = __builtin_amdgcn_mfma_f32_32x32x16_f16(a, bb, acc, 0, 0, 0);
        }
        __syncthreads();
#pragma unroll
        for (int r = 0; r < 16; ++r) tile[(wr * 32 + (r & 3) + 8 * (r >> 2) + 4 * (lane >> 5)) * 65 + wcn * 32 + (lane & 31)] = acc[r];
        __syncthreads();
        const int row = C.tid >> 2, sub = C.tid & 3;
        p1_epilogue_row(C, g, r0 + row, sub, tile + row * 65);
    }
}

__device__ __forceinline__ void pool_unit_naive(const Ctx& C, int u) {
    LAS float* pl = (LAS float*)C.lds;
    const int t0 = (u >> 2) * 64, g = u & 3, tid = C.tid, win = 2 << g;
    __syncthreads();
    for (int idx = tid; idx < 64 * 128; idx += NTH) {
        const int tl = idx >> 7, c = idx & 127, t = t0 + tl, pos = t & (SEQ - 1);
        const int cnt = (pos + 1 < win) ? pos + 1 : win;
        float s = 0.f;
        for (int j = 0; j < cnt; ++j) s += h2f(C.U[(size_t)(t - j) * 512 + g * 128 + c]);
        pl[tl * 128 + c] = s / (float)cnt - h2f(C.U[(size_t)t * 512 + g * 128 + c]);
    }
    __syncthreads();
    const int d = tid & 127, rh = tid >> 7;
    float acc[16];
#pragma unroll
    for (int i = 0; i < 16; ++i) acc[i] = 0.f;
    const float* wp = C.w_pool + (size_t)g * 128 * 128 + d;
    for (int c = 0; c < 128; ++c) {
        const float wv = wp[(size_t)c * 128];
#pragma unroll
        for (int i = 0; i < 16; ++i) acc[i] += pl[(rh * 16 + i) * 128 + c] * wv;
    }
    const float ps = C.pool_scale[g * 128 + d];
#pragma unroll
    for (int i = 0; i < 16; ++i) {
        const int t = t0 + rh * 16 + i;
        C.MIX[(size_t)t * 1024 + g * 128 + d] = f2h(acc[i] * ps * h2f(C.SG[(size_t)t * 512 + g * 128 + d]));
    }
}


__device__ __forceinline__ int pswz(int row, int ch) { return row * 256 + ((ch ^ (row & 15)) << 4); }
__device__ __forceinline__ void pool_unit(const Ctx& C, int u) {
    LAS unsigned char* L = C.lds;
    const int t0 = (u >> 2) * 128, g = u & 3, win = 2 << g, w = C.wave, lane = C.lane;
    __syncthreads();
    {
        const int cp = lane, c0 = 2 * cp;
        const int tb = t0 + 16 * w, pos0 = tb & (SEQ - 1);
        const u16* up = C.U + (size_t)tb * 512 + g * 128 + c0;
        float s0 = 0.f, s1 = 0.f;
        const int npre = pos0 < win ? pos0 : win;
        for (int j = 1; j <= npre; ++j) { const unsigned v = *(const unsigned*)(up - (size_t)j * 512); s0 += h2f((u16)(v & 0xffffu)); s1 += h2f((u16)(v >> 16)); }
#pragma unroll 4
        for (int i = 0; i < 16; ++i) {
            const int pos = pos0 + i;
            const unsigned v = *(const unsigned*)(up + (size_t)i * 512);
            const float a0 = h2f((u16)(v & 0xffffu)), a1 = h2f((u16)(v >> 16));
            s0 += a0; s1 += a1;
            if (pos >= win) { const unsigned vo = *(const unsigned*)(up + (size_t)(i - win) * 512); s0 -= h2f((u16)(vo & 0xffffu)); s1 -= h2f((u16)(vo >> 16)); }
            const float cnt = (float)(pos + 1 < win ? pos + 1 : win);
            const int row = 16 * w + i;
            *(LAS unsigned*)(L + pswz(row, c0 >> 3) + (c0 & 7) * 2) = pk2h(s0 / cnt - a0, s1 / cnt - a1);
        }
    }
    __syncthreads();
    const int q32 = lane & 31, half = lane >> 5, dt = w & 3, tp = w >> 2;
    h16x8 af[8];
    const u16* wp = C.WpT + ((size_t)g * 128 + 32 * dt + q32) * 128 + 8 * half;
#pragma unroll
    for (int ks = 0; ks < 8; ++ks) af[ks] = *(const h16x8*)(wp + 16 * ks);
    const int d0 = g * 128 + 32 * dt + 4 * half;
#pragma unroll
    for (int tt = 0; tt < 2; ++tt) {
        const int trow = 64 * tp + 32 * tt + q32;
        f32x16 acc;
#pragma unroll
        for (int r = 0; r < 16; ++r) acc[r] = 0.f;
#pragma unroll
        for (int ks = 0; ks < 8; ++ks) {
            const h16x8 bf = *(const LAS h16x8*)(L + pswz(trow, 2 * ks + half));
            acc = __builtin_amdgcn_mfma_f32_32x32x16_f16(af[ks], bf, acc, 0, 0, 0);
        }
        const int t = t0 + trow;
#pragma unroll
        for (int g4 = 0; g4 < 4; ++g4) {
            const int d = d0 + 8 * g4;
            const f32x4 ps = *(const f32x4*)(C.pool_scale + d);
            const uint2 gv = *(const uint2*)(C.SG + (size_t)t * 512 + d);
            uint2 ov;
            ov.x = pk2h(acc[4 * g4] * ps[0] * h2f((u16)(gv.x & 0xffffu)), acc[4 * g4 + 1] * ps[1] * h2f((u16)(gv.x >> 16)));
            ov.y = pk2h(acc[4 * g4 + 2] * ps[2] * h2f((u16)(gv.y & 0xffffu)), acc[4 * g4 + 3] * ps[3] * h2f((u16)(gv.y >> 16)));
            *(uint2*)(C.MIX + (size_t)t * 1024 + d) = ov;
        }
    }
}
__device__ __forceinline__ unsigned fkey(float f) { const unsigned u = __float_as_uint(f); return (u & 0x80000000u) ? ~u : (u | 0x80000000u); }
__device__ __forceinline__ int block_sum_int(int v, LAS int* red) {
#pragma unroll
    for (int o = 1; o < 64; o <<= 1) v += __shfl_xor(v, o);
    __syncthreads();
    if ((threadIdx.x & 63) == 0) red[threadIdx.x >> 6] = v;
    __syncthreads();
    return red[0] + red[1] + red[2] + red[3] + red[4] + red[5] + red[6] + red[7];
}


struct WorkQ {
    unsigned* head; LAS int* slot; int cur, nxt_pending;
};
__device__ __forceinline__ int wq_first(const Ctx& C, unsigned* head) {
    LAS int* slot = (LAS int*)(C.lds + LDSCTL_OFF + 256);
    __syncthreads();
    if (C.tid == 0) *slot = (int)__hip_atomic_fetch_add(head, 1u, __ATOMIC_RELAXED, __HIP_MEMORY_SCOPE_AGENT);
    __syncthreads();
    return *slot;
}

template <int CTRL, int RM> __device__ __forceinline__ int dpp_i(int idv, int v) { return __builtin_amdgcn_update_dpp(idv, v, CTRL, RM, 0xF, false); }
__device__ __forceinline__ int wave_sum_i(int v) {
    v += dpp_i<0x111, 0xF>(0, v); v += dpp_i<0x112, 0xF>(0, v); v += dpp_i<0x114, 0xF>(0, v); v += dpp_i<0x118, 0xF>(0, v);
    v += dpp_i<0x142, 0xA>(0, v); v += dpp_i<0x143, 0xC>(0, v);
    return __builtin_amdgcn_readlane(v, 63);
}
__device__ __forceinline__ float wave_max_f(float v) {
    constexpr int NI = (int)0xFF800000u;
    v = fmaxf(v, __int_as_float(dpp_i<0x111, 0xF>(NI, __float_as_int(v)))); v = fmaxf(v, __int_as_float(dpp_i<0x112, 0xF>(NI, __float_as_int(v))));
    v = fmaxf(v, __int_as_float(dpp_i<0x114, 0xF>(NI, __float_as_int(v)))); v = fmaxf(v, __int_as_float(dpp_i<0x118, 0xF>(NI, __float_as_int(v))));
    v = fmaxf(v, __int_as_float(dpp_i<0x142, 0xA>(NI, __float_as_int(v)))); v = fmaxf(v, __int_as_float(dpp_i<0x143, 0xC>(NI, __float_as_int(v))));
    return __int_as_float(__builtin_amdgcn_readlane(__float_as_int(v), 63));
}
constexpr int QS = 2052;
__device__ __forceinline__ int cnt4(int c, float k0, float k1, float k2, float k3, float x) {
    unsigned long long m0, m1, m2, m3;
    asm volatile("v_cmp_ge_f32_e64 %1, %5, %9\n\tv_cmp_ge_f32_e64 %2, %6, %9\n\tv_cmp_ge_f32_e64 %3, %7, %9\n\tv_cmp_ge_f32_e64 %4, %8, %9\n\t"
                 "v_addc_co_u32_e64 %0, vcc, %0, 0, %1\n\tv_addc_co_u32_e64 %0, vcc, %0, 0, %2\n\tv_addc_co_u32_e64 %0, vcc, %0, 0, %3\n\tv_addc_co_u32_e64 %0, vcc, %0, 0, %4"
                 : "+v"(c), "=&s"(m0), "=&s"(m1), "=&s"(m2), "=&s"(m3) : "v"(k0), "v"(k1), "v"(k2), "v"(k3), "v"(x) : "vcc");
    return c;
}
__device__ __forceinline__ int cnt_lane(const float (&sv)[32], int nreg, float x) {
    int c = 0;
#pragma unroll
    for (int jj = 0; jj < 8; ++jj) if (4 * jj < nreg) c = cnt4(c, sv[4 * jj], sv[4 * jj + 1], sv[4 * jj + 2], sv[4 * jj + 3], x);
    return c;
}
__device__ __forceinline__ unsigned skey(float f) { return f == -INFINITY ? 0u : fkey(f); }

struct SelSt {
    float lo, hi, flo, fhi, tau; int side; bool found, fail; unsigned T, J;
    __device__ __forceinline__ void init(int n) { found = n <= 256; fail = false; tau = -3.0e38f; lo = hi = 0.f; flo = (float)(n - 256) + 0.5f; fhi = -255.5f; side = 0; T = 0u; J = 2047u; }
    __device__ __forceinline__ bool active() const { return !(found || fail); }
    __device__ __forceinline__ float pivot() {
        float x = (lo * fhi - hi * flo) * __builtin_amdgcn_rcpf(fhi - flo);
        if (!(x > lo && x < hi)) x = 0.5f * (lo + hi);
        if (!(x > lo && x < hi)) fail = true;
        return x;
    }
    __device__ __forceinline__ void update(float x, int c) {
        if (found || fail) return;
        if (c == 256) { found = true; tau = x; }
        else if (c > 256) { lo = x; flo = (float)(c - 256) + 0.5f; if (side == 1) fhi *= 0.5f; side = 1; }
        else { hi = x; fhi = (float)(c - 256) + 0.5f; if (side == -1) flo *= 0.5f; side = -1; }
    }
};
__device__ __forceinline__ void sel_minmax(const float (&sv)[32], int nreg, int n, int lane, SelSt& S) {
    float mx = -INFINITY, mn = INFINITY;
#pragma unroll
    for (int j = 0; j < 32; ++j) if (j < nreg) {
        mx = fmaxf(mx, sv[j]);
        if (64 * (j + 1) <= n) mn = fminf(mn, sv[j]); else if (64 * j < n) mn = fminf(mn, (lane < n - 64 * j) ? sv[j] : INFINITY);
    }
    const float hi = wave_max_f(mx);
    S.lo = -wave_max_f(-mn);
    S.hi = hi + fmaxf(fabsf(hi) * 1e-6f, 1e-30f);
}
__device__ __forceinline__ void sel_exact(const float (&sv)[32], int nreg, int lane, SelSt& S) {
    unsigned kk[32];
#pragma unroll
    for (int j = 0; j < 32; ++j) kk[j] = (j < nreg) ? skey(sv[j]) : 0u;
    const unsigned klo = fkey(S.lo), khi = fkey(S.hi), diff = klo ^ khi;
    const int hb = 31 - __builtin_clz(diff | 1u);
    unsigned T = hb >= 31 ? 0u : (klo & ~((2u << hb) - 1u));
    bool exact256 = false;
#pragma unroll 1
    for (int bit = hb; bit >= 0; --bit) {
        const unsigned cand = T | (1u << bit);
        int c = 0;
#pragma unroll
        for (int j = 0; j < 32; ++j) if (j < nreg) c += kk[j] >= cand ? 1 : 0;
        c = wave_sum_i(c);
        if (c >= 256) T = cand;
        if (c == 256) { exact256 = true; break; }
    }
    S.T = T; S.J = 2047u;
    if (exact256) return;
    int cg = 0;
#pragma unroll
    for (int j = 0; j < 32; ++j) if (j < nreg) cg += kk[j] > T ? 1 : 0;
    const int need = 256 - wave_sum_i(cg);
    unsigned Jt = 0u;
#pragma unroll 1
    for (int bit = 10; bit >= 0; --bit) {
        const unsigned cj = Jt | (1u << bit);
        int c2 = 0;
#pragma unroll
        for (int j = 0; j < 32; ++j) if (j < nreg) c2 += (kk[j] == T && (unsigned)(64 * j + lane) < cj) ? 1 : 0;
        if (wave_sum_i(c2) < need) Jt = cj;
    }
    S.J = Jt;
}
__device__ __forceinline__ void sel_write(const Ctx& C, const float (&sv)[32], int nreg, int lane, const SelSt& S, int t) {
    int mlo = 0, mhi = 0;
#pragma unroll
    for (int j = 0; j < 32; ++j) if (j < nreg) {
        bool sj;
        if (S.found) sj = sv[j] >= S.tau; else { const unsigned k = skey(sv[j]); sj = k > S.T || (k == S.T && (unsigned)(64 * j + lane) <= S.J); }
        const unsigned long long bal = __ballot(sj);
        mlo = (lane == j) ? (int)(unsigned)bal : mlo; mhi = (lane == j) ? (int)(unsigned)(bal >> 32) : mhi;
    }
    if (lane < 32) *(uint2*)(C.MASK + (size_t)t * 64 + 2 * lane) = make_uint2((unsigned)mlo, (unsigned)mhi);
}
__device__ __forceinline__ float unkey(unsigned k) { return __uint_as_float((k & 0x80000000u) ? (k ^ 0x80000000u) : ~k); }
__device__ __forceinline__ void stageA_unit(const Ctx& C, int b, int qb, int par) {
    LAS float* SC = (LAS float*)C.lds;
    LAS unsigned* RM = (LAS unsigned*)(C.lds + 16 * QS * 4);
    LAS unsigned* RT = RM + 64;
    const int w = C.wave, lane = C.lane, fr = lane & 15, fq = lane >> 4;
    const int nregU = (qb >> 2) + 1;
    if (C.tid < 16) { RM[par * 32 + C.tid] = 0u; RM[par * 32 + 16 + C.tid] = 0xFFFFFFFFu; }
    if (C.tid == 32) RT[par] = 0u;
    TS(20);
    __syncthreads();
    TS(12);
    {
        const int pos = 16 * qb + fr, t = b * SEQ + pos;
        h16x8 qf[8][2];
#pragma unroll
        for (int h = 0; h < 8; ++h)
#pragma unroll
            for (int ks = 0; ks < 2; ++ks) qf[h][ks] = *(const h16x8*)(C.QI + (size_t)t * 512 + h * 64 + 32 * ks + 8 * fq);
        float wi[8];
        { const f32x4 w0 = *(const f32x4*)(C.WI + (size_t)t * 8), w1 = *(const f32x4*)(C.WI + (size_t)t * 8 + 4);
          wi[0] = w0[0]; wi[1] = w0[1]; wi[2] = w0[2]; wi[3] = w0[3]; wi[4] = w1[0]; wi[5] = w1[1]; wi[6] = w1[2]; wi[7] = w1[3]; }
        const int lim = pos - 4 * fq;
        float mx = -INFINITY, mn = INFINITY;
        const u16* kbase = C.KI + (size_t)(b * SEQ + fr) * 64 + 8 * fq;
        const int stlim = 2 * nregU;
        h16x8 c00, c01, c10, c11;
        { const int st = w; const bool in0 = st < stlim && 2 * st <= qb, in1 = st < stlim && 2 * st + 1 <= qb;
          const u16* kp = kbase + (size_t)(32 * st) * 64; const h16x8 z = {0, 0, 0, 0, 0, 0, 0, 0};
          c00 = in0 ? *(const h16x8*)kp : z; c01 = in0 ? *(const h16x8*)(kp + 32) : z; c10 = in1 ? *(const h16x8*)(kp + 16 * 64) : z; c11 = in1 ? *(const h16x8*)(kp + 16 * 64 + 32) : z; }
#pragma unroll 1
        for (int st = w; st < stlim; st += 8) {
            h16x8 n00, n01, n10, n11;
            { const int sn = st + 8; const bool in0 = sn < stlim && 2 * sn <= qb, in1 = sn < stlim && 2 * sn + 1 <= qb;
              const u16* kp = kbase + (size_t)(32 * sn) * 64; const h16x8 z = {0, 0, 0, 0, 0, 0, 0, 0};
              n00 = in0 ? *(const h16x8*)kp : z; n01 = in0 ? *(const h16x8*)(kp + 32) : z; n10 = in1 ? *(const h16x8*)(kp + 16 * 64) : z; n11 = in1 ? *(const h16x8*)(kp + 16 * 64 + 32) : z; }
#pragma unroll
            for (int tt = 0; tt < 2; ++tt) {
                const int kt = 2 * st + tt;
                f32x4 sc = {-INFINITY, -INFINITY, -INFINITY, -INFINITY};
                if (kt <= qb) {
                    const h16x8 a0 = tt ? c10 : c00, a1 = tt ? c11 : c01;
                    f32x4 sum = {0.f, 0.f, 0.f, 0.f};
#pragma unroll
                    for (int h = 0; h < 8; ++h) {
                        f32x4 acc = {0.f, 0.f, 0.f, 0.f};
                        acc = __builtin_amdgcn_mfma_f32_16x16x32_f16(a0, qf[h][0], acc, 0, 0, 0);
                        acc = __builtin_amdgcn_mfma_f32_16x16x32_f16(a1, qf[h][1], acc, 0, 0, 0);
#pragma unroll
                        for (int r = 0; r < 4; ++r) sum[r] += wi[h] * fmaxf(acc[r], 0.f);
                    }
#pragma unroll
                    for (int r = 0; r < 4; ++r) { const bool ok = 16 * kt + r <= lim; sc[r] = ok ? sum[r] : -INFINITY; mx = fmaxf(mx, sc[r]); mn = fminf(mn, ok ? sum[r] : INFINITY); }
                }
                *(LAS f32x4*)(SC + fr * QS + 32 * st + 16 * tt + 4 * fq) = sc;
            }
            c00 = n00; c01 = n01; c10 = n10; c11 = n11;
        }
        mx = fmaxf(mx, __shfl_xor(mx, 16)); mx = fmaxf(mx, __shfl_xor(mx, 32)); mn = fminf(mn, __shfl_xor(mn, 16)); mn = fminf(mn, __shfl_xor(mn, 32));
        if (fq == 0 && mx > -INFINITY) { atomicMax((unsigned*)&RM[par * 32 + fr], fkey(mx)); atomicMin((unsigned*)&RM[par * 32 + 16 + fr], fkey(mn)); }
    }
    TS(13);
    __syncthreads();
    TS(14);
#pragma unroll 1
    for (;;) {
        int q = 0;
        if (lane == 0) q = (int)atomicAdd((unsigned*)&RT[par], 1u);
        q = __builtin_amdgcn_readfirstlane(q);
        if (q >= 16) break;
        const int pos = 16 * qb + q, n = pos + 1;
        float sv[32];
#pragma unroll
        for (int j = 0; j < 32; ++j) sv[j] = (j < nregU) ? SC[q * QS + 64 * j + lane] : -INFINITY;
        SelSt A; A.init(n);
        if (n > 256) {
            const float hi = unkey(RM[par * 32 + q]);
            A.lo = unkey(RM[par * 32 + 16 + q]);
            A.hi = hi + fmaxf(fabsf(hi) * 1e-6f, 1e-30f);
#pragma unroll 1
            for (int it = 0; it < 20; ++it) {
                if (!A.active()) break;
                const float x = A.pivot();
                const int c = wave_sum_i(cnt_lane(sv, nregU, x));
                A.update(x, c);
            }
            if (!A.found) sel_exact(sv, nregU, lane, A);
        }
        sel_write(C, sv, nregU, lane, A, b * SEQ + pos);
    }
}
__device__ __forceinline__ void pool_unit(const Ctx& C, int u);
__device__ __forceinline__ void stageA_phase(const Ctx& C, unsigned* head) {
    LAS int* slot = (LAS int*)(C.lds + LDSCTL_OFF + 256);
    int tk = wq_first(C, head), par = 0;
    while (tk < 1536) {
        int nx = 0;
        if (C.tid == 0) nx = (int)__hip_atomic_fetch_add(head, 1u, __ATOMIC_RELAXED, __HIP_MEMORY_SCOPE_AGENT);
        if (tk < 1024) { stageA_unit(C, tk & 7, 127 - (tk >> 3), par); par ^= 1; TS(17); }
        else { pool_unit(C, tk - 1024); TS(21); }
        __syncthreads();
        if (C.tid == 0) *slot = nx;
        __syncthreads();
        tk = *slot;
    }
}
__device__ __forceinline__ int swz(int r, int c) { return r * 128 + ((c ^ ((r >> 1) & 7)) << 4); }
__device__ __forceinline__ float maskf(float sv, unsigned mbits, int pos) {
    const int m = __builtin_amdgcn_sbfe(mbits, pos, 1);
    float r; const float ninf = -INFINITY;
    asm("v_bfi_b32 %0, %1, %2, %3" : "=v"(r) : "v"(m), "v"(sv), "s"(ninf));
    return r;
}
__device__ __forceinline__ h16x8 pack8(const f32x16& p, int b0) {
    typedef __fp16 hh2 __attribute__((ext_vector_type(2)));
    typedef unsigned u4 __attribute__((ext_vector_type(4)));
    u4 v;
    v.x = __builtin_bit_cast(unsigned, (hh2)__builtin_amdgcn_cvt_pkrtz(p[b0], p[b0 + 1])); v.y = __builtin_bit_cast(unsigned, (hh2)__builtin_amdgcn_cvt_pkrtz(p[b0 + 2], p[b0 + 3]));
    v.z = __builtin_bit_cast(unsigned, (hh2)__builtin_amdgcn_cvt_pkrtz(p[b0 + 4], p[b0 + 5])); v.w = __builtin_bit_cast(unsigned, (hh2)__builtin_amdgcn_cvt_pkrtz(p[b0 + 6], p[b0 + 7]));
    return __builtin_bit_cast(h16x8, v);
}
#define MX3(a, b, c) __builtin_fmaxf(__builtin_fmaxf((a), (b)), (c))
#define SBAR0() __builtin_amdgcn_sched_barrier(0)
__device__ __forceinline__ int opq(int x) { asm volatile("" : "+v"(x)); return x; }
__device__ __forceinline__ void stageB_unit(const Ctx& C0, int b, int kvh, int qb) {
    Ctx C = C0; C.tid = opq(C0.tid); C.lane = C.tid & 63;
    LAS unsigned char* L = C.lds;
    const int w = C.wave, lane = C.lane, q32 = lane & 31, half = lane >> 5, h = kvh * 4 + (w & 3);
    const int t = b * SEQ + 64 * qb + 32 * (w >> 2) + q32;
    h16x8 qf[4];
#pragma unroll
    for (int ks = 0; ks < 4; ++ks) qf[ks] = *(const h16x8*)(C.Q + (size_t)t * 512 + h * 64 + 16 * ks + 8 * half);
    f32x16 o0, o1, sN0, sN1, sC0, sC1;
    const f32x16 zero16 = {0.f, 0.f, 0.f, 0.f, 0.f, 0.f, 0.f, 0.f, 0.f, 0.f, 0.f, 0.f, 0.f, 0.f, 0.f, 0.f};
#pragma unroll
    for (int r = 0; r < 16; ++r) { o0[r] = 0.f; o1[r] = 0.f; }
    float m_run = 0.f, l_run = 0.f; bool has = false;
    asm volatile("" : "+v"(m_run));
    const int lr = C.tid >> 3, lc = C.tid & 7;
    const u16* kg = C.K + ((size_t)(b * SEQ) + lr) * 128 + kvh * 64 + lc * 8;
    const u16* vg = C.VT + ((size_t)((b * 2 + kvh) * 64 + lr)) * SEQ + lc * 8;
    const int ldsw = swz(lr, lc);
    const unsigned* mg = C.MASK + (size_t)t * 64;
    const int nt = qb + 1;
    constexpr float THR = 8.f;
    const int fo0 = swz(q32, half);
#define fo1 (fo0 ^ 32)
#define fo2 (fo0 ^ 64)
#define fo3 (fo0 ^ 96)
    h16x8 kf[8], vf[8];
#define LDK(slot) do { LAS unsigned char* kb_ = L + (slot) * 8192; \
        kf[0] = *(const LAS h16x8*)(kb_ + fo0); kf[1] = *(const LAS h16x8*)(kb_ + 4096 + fo0); kf[2] = *(const LAS h16x8*)(kb_ + fo1); kf[3] = *(const LAS h16x8*)(kb_ + 4096 + fo1); \
        kf[4] = *(const LAS h16x8*)(kb_ + fo2); kf[5] = *(const LAS h16x8*)(kb_ + 4096 + fo2); kf[6] = *(const LAS h16x8*)(kb_ + fo3); kf[7] = *(const LAS h16x8*)(kb_ + 4096 + fo3); } while (0)
#define LDV(slot) do { LAS unsigned char* vb_ = L + 32768 + (slot) * 8192; \
        vf[0] = *(const LAS h16x8*)(vb_ + fo0); vf[1] = *(const LAS h16x8*)(vb_ + 4096 + fo0); vf[2] = *(const LAS h16x8*)(vb_ + fo1); vf[3] = *(const LAS h16x8*)(vb_ + 4096 + fo1); \
        vf[4] = *(const LAS h16x8*)(vb_ + fo2); vf[5] = *(const LAS h16x8*)(vb_ + 4096 + fo2); vf[6] = *(const LAS h16x8*)(vb_ + fo3); vf[7] = *(const LAS h16x8*)(vb_ + 4096 + fo3); } while (0)
#define QKT() do { \
        sN0 = __builtin_amdgcn_mfma_f32_32x32x16_f16(kf[0], qf[0], zero16, 0, 0, 0); sN1 = __builtin_amdgcn_mfma_f32_32x32x16_f16(kf[1], qf[0], zero16, 0, 0, 0); \
        sN0 = __builtin_amdgcn_mfma_f32_32x32x16_f16(kf[2], qf[1], sN0, 0, 0, 0);  sN1 = __builtin_amdgcn_mfma_f32_32x32x16_f16(kf[3], qf[1], sN1, 0, 0, 0); \
        sN0 = __builtin_amdgcn_mfma_f32_32x32x16_f16(kf[4], qf[2], sN0, 0, 0, 0);  sN1 = __builtin_amdgcn_mfma_f32_32x32x16_f16(kf[5], qf[2], sN1, 0, 0, 0); \
        sN0 = __builtin_amdgcn_mfma_f32_32x32x16_f16(kf[6], qf[3], sN0, 0, 0, 0);  sN1 = __builtin_amdgcn_mfma_f32_32x32x16_f16(kf[7], qf[3], sN1, 0, 0, 0); } while (0)
#define SM1(mwx, mwy) do { const unsigned m0_ = (mwx) >> (4 * half), m1_ = (mwy) >> (4 * half); \
        _Pragma("unroll") for (int r = 0; r < 16; ++r) { const int pos = (r & 3) + 8 * (r >> 2); sC0[r] = maskf(sN0[r] - m_run, m0_, pos); sC1[r] = maskf(sN1[r] - m_run, m1_, pos); } \
        float mx = MX3(sC0[0], sC0[1], sC1[0]), my = MX3(sC0[2], sC0[3], sC1[1]); mx = MX3(mx, sC1[2], sC1[3]); \
        _Pragma("unroll") for (int r = 4; r < 16; r += 4) { mx = MX3(mx, sC0[r], sC0[r + 1]); my = MX3(my, sC0[r + 2], sC0[r + 3]); mx = MX3(mx, sC1[r], sC1[r + 1]); my = MX3(my, sC1[r + 2], sC1[r + 3]); } \
        mx = fmaxf(mx, my); mx = fmaxf(mx, __shfl_xor(mx, 32)); \
        if (__any(mx > THR || (!has && mx > -INFINITY))) { \
            const float dl = has ? fmaxf(mx, 0.f) : (mx > -INFINITY ? mx : 0.f); has = has || mx > -INFINITY; m_run += dl; \
            const float f = __builtin_amdgcn_exp2f(-dl); l_run *= f; \
            _Pragma("unroll") for (int r = 0; r < 16; ++r) { sC0[r] -= dl; sC1[r] -= dl; o0[r] *= f; o1[r] *= f; } } } while (0)
    __syncthreads();
    {
        v4u kr0 = *(const v4u*)kg, vr0 = *(const v4u*)vg, kr1 = kr0, vr1 = vr0, kr2 = kr0, vr2 = vr0;
        if (nt > 1) { kr1 = *(const v4u*)(kg + (size_t)64 * 128); vr1 = *(const v4u*)(vg + 64); }
        if (nt > 2) { kr2 = *(const v4u*)(kg + (size_t)128 * 128); vr2 = *(const v4u*)(vg + 128); }
        *(LAS v4u*)(L + ldsw) = kr0; *(LAS v4u*)(L + 32768 + ldsw) = vr0;
        *(LAS v4u*)(L + 8192 + ldsw) = kr1; *(LAS v4u*)(L + 32768 + 8192 + ldsw) = vr1;
        *(LAS v4u*)(L + 16384 + ldsw) = kr2; *(LAS v4u*)(L + 32768 + 16384 + ldsw) = vr2;
    }
    uint2 mwB = *(const uint2*)mg, mwC = make_uint2(0u, 0u);
    __syncthreads();
    LDK(0); QKT();
    SM1(mwB.x, mwB.y);
    if (nt > 1) { mwB = *(const uint2*)(mg + 2); LDK(1); }
#pragma unroll 1
    for (int j = 0; j < nt; ++j) {
        const bool l3 = j + 3 < nt, n1 = j + 1 < nt, n2 = j + 2 < nt;
        v4u kr = {0u, 0u, 0u, 0u}, vr = {0u, 0u, 0u, 0u};
        if (l3) { kr = *(const v4u*)(kg + (size_t)(j + 3) * 64 * 128); vr = *(const v4u*)(vg + (j + 3) * 64); }
        if (n2) mwC = *(const uint2*)(mg + 2 * (j + 2));
        SBAR0();
        if (n1) QKT();
        SBAR0();
        LDV(j & 3);
        SBAR0();
        float ls = 0.f, lt = 0.f;
#pragma unroll
        for (int r = 0; r < 16; ++r) { sC0[r] = __builtin_amdgcn_exp2f(sC0[r]); sC1[r] = __builtin_amdgcn_exp2f(sC1[r]); ls += sC0[r]; lt += sC1[r]; }
        l_run += ls + lt;
        const h16x8 pb0 = pack8(sC0, 0), pb1 = pack8(sC0, 8), pb2 = pack8(sC1, 0), pb3 = pack8(sC1, 8);
        SBAR0();
        o0 = __builtin_amdgcn_mfma_f32_32x32x16_f16(vf[0], pb0, o0, 0, 0, 0); o1 = __builtin_amdgcn_mfma_f32_32x32x16_f16(vf[1], pb0, o1, 0, 0, 0);
        o0 = __builtin_amdgcn_mfma_f32_32x32x16_f16(vf[2], pb1, o0, 0, 0, 0); o1 = __builtin_amdgcn_mfma_f32_32x32x16_f16(vf[3], pb1, o1, 0, 0, 0);
        o0 = __builtin_amdgcn_mfma_f32_32x32x16_f16(vf[4], pb2, o0, 0, 0, 0); o1 = __builtin_amdgcn_mfma_f32_32x32x16_f16(vf[5], pb2, o1, 0, 0, 0);
        o0 = __builtin_amdgcn_mfma_f32_32x32x16_f16(vf[6], pb3, o0, 0, 0, 0); o1 = __builtin_amdgcn_mfma_f32_32x32x16_f16(vf[7], pb3, o1, 0, 0, 0);
        SBAR0();
        if (n2) LDK((j + 2) & 3);
        SBAR0();
        if (n1) { SM1(mwB.x, mwB.y); }
        mwB = mwC;
        SBAR0();
        if (l3) { *(LAS v4u*)(L + ((j + 3) & 3) * 8192 + ldsw) = kr; *(LAS v4u*)(L + 32768 + ((j + 3) & 3) * 8192 + ldsw) = vr; }
        __syncthreads();
    }
#undef fo1
#undef fo2
#undef fo3
#undef LDK
#undef LDV
#undef QKT
#undef SM1
    l_run += __shfl_xor(l_run, 32);
    const float inv = 1.f / l_run;
    const u16* gp = C.GA + (size_t)t * 512 + h * 64 + 4 * half; u16* mp = C.MIX + (size_t)t * 1024 + 512 + h * 64 + 4 * half;
#pragma unroll
    for (int dt = 0; dt < 2; ++dt)
#pragma unroll
        for (int g4 = 0; g4 < 4; ++g4) {
            const int d0 = 32 * dt + 8 * g4;
            const uint2 gv = *(const uint2*)(gp + d0);
            const float ga0 = h2f((u16)(gv.x & 0xffffu)), ga1 = h2f((u16)(gv.x >> 16)), ga2 = h2f((u16)(gv.y & 0xffffu)), ga3 = h2f((u16)(gv.y >> 16));
            const f32x16& oo = dt ? o1 : o0;
            uint2 ov; ov.x = pk2h(oo[4 * g4] * inv * ga0, oo[4 * g4 + 1] * inv * ga1); ov.y = pk2h(oo[4 * g4 + 2] * inv * ga2, oo[4 * g4 + 3] * inv * ga3);
            *(uint2*)(mp + d0) = ov;
        }
}
__device__ __forceinline__ void stageB_phase(const Ctx& C, unsigned* head) {
    LAS int* slot = (LAS int*)(C.lds + LDSCTL_OFF + 256);
    int tk = wq_first(C, head);
    while (tk < 512) {
        int nx = 0;
        if (C.tid == 0) nx = (int)__hip_atomic_fetch_add(head, 1u, __ATOMIC_RELAXED, __HIP_MEMORY_SCOPE_AGENT);
        const int bk = tk & 15;
        stageB_unit(C, bk >> 1, bk & 1, 31 - (tk >> 4));
        __syncthreads();
        if (C.tid == 0) *slot = nx;
        __syncthreads();
        tk = *slot;
    }
}
__device__ __forceinline__ void selattn_row_naive(const Ctx& C, int t) {
    LAS float* qs = (LAS float*)C.lds;
    LAS unsigned* keys = (LAS unsigned*)(C.lds + 2048);
    LAS unsigned* mk = (LAS unsigned*)(C.lds + 10240);
    LAS int* wpre = (LAS int*)(C.lds + 10496);
    LAS int* red = (LAS int*)(C.lds + 10816);
    LAS int* sel = (LAS int*)(C.lds + 10880);
    LAS float* p = (LAS float*)(C.lds + 11904);
    LAS float* hl = (LAS float*)(C.lds + 21120);
    const int b = t >> 11, pos = t & (SEQ - 1), n = pos + 1, tid = C.tid;
    __syncthreads();
    if (tid < 64) mk[tid] = C.MASK[(size_t)t * 64 + tid];
    __syncthreads();
    if (tid == 0) { int a = 0; for (int i = 0; i < 64; ++i) { wpre[i] = a; a += __popc(mk[i]); } wpre[64] = a; }
    __syncthreads();
    const int nsel = wpre[64];
    for (int s = tid; s < n; s += NTH) { const unsigned wv = mk[s >> 5]; if ((wv >> (s & 31)) & 1u) sel[wpre[s >> 5] + __popc(wv & ((1u << (s & 31)) - 1u))] = s; }
    for (int i = tid; i < 512; i += NTH) qs[i] = h2f(C.Q[(size_t)t * 512 + i]);
    __syncthreads();
    if (tid < 256) {
        if (tid < nsel) {
            const int s = sel[tid];
#pragma unroll
            for (int kvh = 0; kvh < 2; ++kvh) {
                const u16* kp = C.K + (size_t)(b * SEQ + s) * 128 + kvh * 64;
                float dq[4] = {0.f, 0.f, 0.f, 0.f};
#pragma unroll 1
                for (int i = 0; i < 8; ++i) { const h16x8 v8 = *(const h16x8*)(kp + 8 * i);
#pragma unroll
                    for (int gq = 0; gq < 4; ++gq) {
#pragma unroll
                        for (int j = 0; j < 8; ++j) dq[gq] += qs[(kvh * 4 + gq) * 64 + 8 * i + j] * (float)v8[j]; } }
#pragma unroll
                for (int gq = 0; gq < 4; ++gq) p[tid * 9 + kvh * 4 + gq] = dq[gq];
            }
        } else {
#pragma unroll
            for (int h = 0; h < 8; ++h) p[tid * 9 + h] = -INFINITY;
        }
    }
    __syncthreads();
    {
        const int h = C.wave, lane = C.lane;
        float m = -INFINITY;
        for (int j = lane; j < 256; j += 64) m = fmaxf(m, p[j * 9 + h]);
#pragma unroll
        for (int o2 = 1; o2 < 64; o2 <<= 1) m = fmaxf(m, __shfl_xor(m, o2));
        float l = 0.f;
        for (int j = lane; j < 256; j += 64) { const float e = exp2f(p[j * 9 + h] - m); p[j * 9 + h] = e; l += e; }
        l = wave_sum(l);
        if (lane == 0) hl[h] = l;
    }
    __syncthreads();
    {
        const int h = tid >> 6, d = tid & 63, kvh = h >> 2;
        float a0 = 0.f;
        for (int j = 0; j < nsel; ++j) a0 += p[j * 9 + h] * h2f(C.V[(size_t)(b * SEQ + sel[j]) * 128 + kvh * 64 + d]);
        C.MIX[(size_t)t * 1024 + 512 + h * 64 + d] = f2h(a0 / hl[h] * h2f(C.GA[(size_t)t * 512 + h * 64 + d]));
    }
}

__device__ __forceinline__ void phase3_naive(const Ctx& C) {
    for (int u = C.bid; u < 16 * 128; u += C.G) {
        const int c0 = (u & 15) * 64, r0 = (u >> 4) * 128, w = C.wave, lane = C.lane, wr = w & 3, wcn = w >> 2;
        const u16* ap = C.MIX + (size_t)(r0 + wr * 32 + (lane & 31)) * DM + 8 * (lane >> 5);
        const u16* bp = C.WoutT + (size_t)(c0 + wcn * 32 + (lane & 31)) * DM + 8 * (lane >> 5);
        f32x16 acc;
#pragma unroll
        for (int r = 0; r < 16; ++r) acc[r] = 0.f;
        for (int k0 = 0; k0 < DM; k0 += 16) {
            const h16x8 a = *(const h16x8*)(ap + k0), bb = *(const h16x8*)(bp + k0);
            acc = __builtin_amdgcn_mfma_f32_32x32x16_f16(a, bb, acc, 0, 0, 0);
        }
        const int col = c0 + wcn * 32 + (lane & 31), b = r0 >> 11;
        const float gate = C.mod[b * 3072 + 2048 + col];
#pragma unroll
        for (int r = 0; r < 16; ++r) {
            const int row = r0 + wr * 32 + (r & 3) + 8 * (r >> 2) + 4 * (lane >> 5);
            C.out[(size_t)row * DM + col] = C.x[(size_t)row * DM + col] + gate * acc[r];
        }
    }
}

struct Args { const float* in[11]; float* out; unsigned char* ws; };
__global__ void __launch_bounds__(NTH, 2) mk_fwd(Args a) {
    extern __shared__ __attribute__((aligned(16))) unsigned char lds_raw[];
    Ctx C;
    C.lds = (LAS unsigned char*)lds_raw;
    C.tid = threadIdx.x; C.lane = C.tid & 63; C.wave = __builtin_amdgcn_readfirstlane(C.tid >> 6); C.bid = blockIdx.x; C.G = gridDim.x;
    C.x = a.in[0]; C.c = a.in[1]; C.norm_w = a.in[2]; C.w_ada = a.in[3]; C.b_ada = a.in[4]; C.w_in = a.in[5]; C.qnw = a.in[6]; C.knw = a.in[7];
    C.w_pool = a.in[8]; C.pool_scale = a.in[9]; C.w_out = a.in[10]; C.out = a.out;
    unsigned char* ws = a.ws;
    C.mod = (float*)(ws + WS_MOD); C.rope = (float2*)(ws + WS_ROPE); C.WinT = (u16*)(ws + WS_WINT); C.WoutT = (u16*)(ws + WS_WOUTT); C.XN = (u16*)(ws + WS_XN);
    C.U = (u16*)(ws + WS_U); C.SG = (u16*)(ws + WS_SG); C.Q = (u16*)(ws + WS_Q); C.GA = (u16*)(ws + WS_GA); C.QI = (u16*)(ws + WS_QI);
    C.K = (u16*)(ws + WS_K); C.V = (u16*)(ws + WS_V); C.KI = (u16*)(ws + WS_KI); C.VT = C.V; C.WpT = (u16*)(ws + WS_WPT); C.WI = (float*)(ws + WS_WI); C.MASK = (unsigned*)(ws + WS_MASK); C.MIX = (u16*)(ws + WS_MIX);
    volatile LAS unsigned* MISC = (volatile LAS unsigned*)(C.lds + MISC_OFF);
    for (int u = C.tid; u < (LDS_BYTES - LDSCTL_OFF) / 4; u += NTH) ((LAS unsigned*)(C.lds + LDSCTL_OFF))[u] = 0u;
    __syncthreads();
    XcdBarrier bar = xcd_barrier_post((unsigned*)(ws + WS_CTL) + CW_BAR, MISC + 8);

    TS(30);
    phase0(C);
    TS(0); xcd_barrier(bar); TS(1);
    phase0b(C);
    TS(2); xcd_barrier(bar); TS(3);
    {
        pg8::Gemm g{C.XN, C.WinT, MT, NPAD, DM}; pg8::StaticOrder S; S.init(MT, NPAD, C.G, C.bid);
        EpiP1 E{C.U, C.SG, C.Q, C.GA, C.QI, C.K, C.V, C.KI, C.WI, C.qnw, C.knw, C.rope};
        pg8::gemm_phase<EpiP1, pg8::StaticOrder, true, true>(C.lds, g, S, E);
    }
    TS(4); xcd_barrier(bar); TS(5);
    stageA_phase(C, (unsigned*)(ws + WS_CTL) + CW_QA);
    TS(6); xcd_barrier(bar); TS(8);
    stageB_phase(C, (unsigned*)(ws + WS_CTL) + CW_QB);
    TS(9); xcd_barrier(bar); TS(10);
    {
        pg8::Gemm g{C.MIX, C.WoutT, MT, DM, DM}; pg8::StaticOrder S; S.init(MT, DM, C.G, C.bid);
        EpiOut E{C.x, C.mod + 2048, C.out};
        pg8::gemm_phase<EpiOut, pg8::StaticOrder, true, true>(C.lds, g, S, E);
    }
    TS(11);
    if (ECHO >= 0) { xcd_barrier(bar); if (threadIdx.x == 0) { volatile LAS unsigned long long* tsb_ = (volatile LAS unsigned long long*)(C.lds + LDSCTL_OFF + 512); unsigned long long d_ = 0; for (int k_ = 0; k_ < 30; ++k_) if ((ECHOM >> k_) & 1) d_ += tsb_[k_]; const unsigned long long t0_ = __builtin_amdgcn_s_memtime(); while (__builtin_amdgcn_s_memtime() - t0_ < d_) __builtin_amdgcn_s_sleep(8); } __syncthreads(); }
}

extern "C" void kernel_launch(void* const* d_in, const int* in_sizes, int n_in, void* d_out, int out_size, void* d_ws, size_t ws_size, hipStream_t stream) {
    (void)in_sizes; (void)out_size;
    static int grid = 0;
    if (grid == 0) {
        if (n_in != 11 || ws_size < WS_END) { fprintf(stderr, "kernel_launch: unexpected inputs / workspace (%d, %zu)\n", n_in, ws_size); grid = -1; return; }
        int dev = 0, cus = 0, per_cu = 0;
        hipGetDevice(&dev); hipDeviceGetAttribute(&cus, hipDeviceAttributeMultiprocessorCount, dev);
        hipFuncSetAttribute((const void*)mk_fwd, hipFuncAttributeMaxDynamicSharedMemorySize, LDS_BYTES);
        hipOccupancyMaxActiveBlocksPerMultiprocessor(&per_cu, (const void*)mk_fwd, NTH, LDS_BYTES);
        (void)hipGetLastError();
        if (per_cu < 1) { fprintf(stderr, "kernel_launch: occupancy query says %d blocks per CU\n", per_cu); per_cu = 1; }
        grid = cus;
    }
    if (grid < 0) return;
    hipMemsetAsync((char*)d_ws + WS_CTL, 0, CTL_ZERO_BYTES, stream);
    Args a{};
    for (int i = 0; i < 11; ++i) a.in[i] = (const float*)d_in[i];
    a.out = (float*)d_out; a.ws = (unsigned char*)d_ws;
    void* kargs[] = {&a};
    hipError_t e = hipLaunchCooperativeKernel((const void*)mk_fwd, dim3(grid), dim3(NTH), kargs, LDS_BYTES, stream);
    if (e != hipSuccess) fprintf(stderr, "kernel_launch: cooperative launch failed: %s (grid %d)\n", hipGetErrorString(e), grid);
}
```

```cpp
#include <hip/hip_runtime.h>
#include <stdint.h>
#include <cstdio>

typedef unsigned short u16;
typedef _Float16 h16x8 __attribute__((ext_vector_type(8)));
typedef float f32x16 __attribute__((ext_vector_type(16)));
typedef float f32x4 __attribute__((ext_vector_type(4)));
typedef unsigned v4u __attribute__((ext_vector_type(4)));
#define LAS __attribute__((address_space(3)))
#define GAS __attribute__((address_space(1)))

constexpr int NB = 8, SEQ = 2048, DM = 1024, MT = NB * SEQ;
constexpr int NPROJ = 2888, NPAD = 3072;
constexpr int NTH = 512, NWAVES = 8;
constexpr float QSCALE = 0.18033688011112042f;
constexpr float EPS = 1e-6f;

constexpr size_t WS_CTL = 0, CTL_ZERO_BYTES = 65536 + (size_t)NB * 3072 * 4;
constexpr size_t WS_MOD = 65536;
constexpr size_t WS_ROPE = WS_MOD + (size_t)NB * 3072 * 4;
constexpr size_t WS_WINT = WS_ROPE + (size_t)SEQ * 32 * 8;
constexpr size_t WS_WOUTT = WS_WINT + (size_t)NPAD * DM * 2;
constexpr size_t WS_XN = WS_WOUTT + (size_t)DM * DM * 2;
constexpr size_t WS_U = WS_XN + (size_t)MT * DM * 2;
constexpr size_t WS_SG = WS_U + (size_t)MT * 512 * 2;
constexpr size_t WS_Q = WS_SG + (size_t)MT * 512 * 2;
constexpr size_t WS_GA = WS_Q + (size_t)MT * 512 * 2;
constexpr size_t WS_QI = WS_GA + (size_t)MT * 512 * 2;
constexpr size_t WS_K = WS_QI + (size_t)MT * 512 * 2;
constexpr size_t WS_V = WS_K + (size_t)MT * 128 * 2;
constexpr size_t WS_KI = WS_V + (size_t)MT * 128 * 2;
constexpr size_t WS_WI = WS_KI + (size_t)MT * 64 * 2;
constexpr size_t WS_MASK = WS_WI + (size_t)MT * 8 * 4;
constexpr size_t WS_MIX = WS_MASK + (size_t)MT * 64 * 4;
constexpr size_t WS_WPT = WS_MIX + (size_t)MT * DM * 2;
constexpr size_t WS_END = WS_WPT + (size_t)4 * 128 * 128 * 2;
constexpr int CW_BAR = 1024;
constexpr int CW_QA = 8192, CW_QB = 8192 + 64;


#ifndef ECHO
#define ECHO -1
#endif
#ifndef ECHOM
#define ECHOM (1u << (ECHO < 0 ? 31 : ECHO))
#endif
#define TS(k) do { __builtin_amdgcn_sched_barrier(0); if (ECHO >= 0 && threadIdx.x == 0) { volatile LAS unsigned long long* tsb_ = (volatile LAS unsigned long long*)(C.lds + LDSCTL_OFF + 512); \
    const unsigned long long t_ = __builtin_amdgcn_s_memtime(); tsb_[(k)] += t_ - tsb_[31]; tsb_[31] = t_; } } while (0)
constexpr int LDS_BYTES = 147456;
constexpr int LDSCTL_OFF = LDS_BYTES - 1024, MISC_OFF = LDSCTL_OFF + 320;
__device__ __forceinline__ u16 f2h(float f) { return __builtin_bit_cast(u16, (_Float16)f); }
__device__ __forceinline__ float h2f(u16 h) { return (float)__builtin_bit_cast(_Float16, h); }
__device__ __forceinline__ float silu_f(float v) { return v / (1.f + __expf(-v)); }
__device__ __forceinline__ float wave_sum(float v) {
#pragma unroll
    for (int o = 1; o < 64; o <<= 1) v += __shfl_xor(v, o);
    return v;
}

__constant__ double ROPE_FREQ[32] = {1.0,0.7498942093324559,0.5623413251903491,0.4216965034285822,0.31622776601683794,0.23713737056616552,0.1778279410038923,0.1333521432163324,0.1,0.07498942093324558,0.05623413251903491,0.042169650342858224,0.03162277660168379,0.023713737056616554,0.01778279410038923,0.01333521432163324,0.01,0.007498942093324558,0.005623413251903491,0.004216965034285823,0.0031622776601683794,0.0023713737056616554,0.0017782794100389228,0.001333521432163324,0.001,0.0007498942093324559,0.0005623413251903491,0.00042169650342858224,0.00031622776601683794,0.00023713737056616554,0.00017782794100389227,0.0001333521432163324};

#define XB_TMO      128
#define XB_XCNT(j)  (256  + 64 * (j))
#define XB_XSUB(j)  (1280 + 64 * (j))
#define XB_XGEN(j)  (2304 + 64 * (j))
#define XB_TOP      3328
#define XB_TOPGEN   3392
#define XCD_BAR_WORDS 3456
#define XB_SPIN_CAP (1u << 18)

__device__ __forceinline__ unsigned xb_ld(unsigned* p)              { return __hip_atomic_load(p, __ATOMIC_RELAXED, __HIP_MEMORY_SCOPE_AGENT); }
__device__ __forceinline__ unsigned xb_add(unsigned* p, unsigned v) { return __hip_atomic_fetch_add(p, v, __ATOMIC_RELAXED, __HIP_MEMORY_SCOPE_AGENT); }
__device__ __forceinline__ unsigned xb_xcc_id() { return (unsigned)__builtin_amdgcn_s_getreg((3 << 11) | 20) & 0xFu; }
#define XB_SPIN(cond, bar) do { unsigned _sp = 0; while (cond) { __builtin_amdgcn_s_sleep(1); \
    if ((++_sp & 255u) == 0u) { if (xb_ld(&(bar)[XB_TMO])) break; if (_sp > XB_SPIN_CAP) { atomicAdd(&(bar)[XB_TMO], 1u); break; } } } } while (0)

struct XcdBarrier {
    unsigned* bar; unsigned x;
    volatile LAS unsigned* st;
};

__device__ __forceinline__ XcdBarrier xcd_barrier_post(unsigned* bar, volatile LAS unsigned* st) {
    XcdBarrier b; b.bar = bar; b.x = xb_xcc_id(); b.st = st;
    if (threadIdx.x == 0) (void)xb_add(&bar[XB_XCNT(b.x)], 1u);
    return b;
}
__device__ __forceinline__ void xcd_barrier_complete(unsigned* bar, unsigned x, unsigned& nloc, unsigned& nx) {
    const unsigned G = gridDim.x * gridDim.y * gridDim.z;
    unsigned sum, cnt, mine, sp = 0u;
    for (;;) {
        sum = 0u; cnt = 0u; mine = 0u;
#pragma unroll
        for (unsigned j = 0; j < 16; ++j) { const unsigned c = xb_ld(&bar[XB_XCNT(j)]); sum += c; cnt += (c > 0u) ? 1u : 0u; mine = (j == x) ? c : mine; }
        if (sum == G) break;
        __builtin_amdgcn_s_sleep(1);
        if ((++sp & 255u) == 0u) { if (xb_ld(&bar[XB_TMO])) break; if (sp > XB_SPIN_CAP) { atomicAdd(&bar[XB_TMO], 1u); break; } }
    }
    nloc = mine > 0u ? mine : 1u; nx = cnt > 0u ? cnt : 1u;
}

__device__ __forceinline__ void xcd_barrier(const XcdBarrier& b) {
    asm volatile("s_waitcnt vmcnt(0)" ::: "memory");
    __syncthreads();
    if (threadIdx.x == 0) {
        unsigned* bar = b.bar;
        __builtin_amdgcn_s_waitcnt(0);
        unsigned nloc = b.st[0], nx = b.st[1];
        if (nloc == 0u) { xcd_barrier_complete(bar, b.x, nloc, nx); b.st[0] = nloc; b.st[1] = nx; }
        const unsigned old = xb_add(&bar[XB_XSUB(b.x)], 1u);
        const unsigned gen = old / nloc;
        if (old + 1u == (gen + 1u) * nloc) {
            __builtin_amdgcn_fence(__ATOMIC_RELEASE, "agent");
            asm volatile("s_waitcnt vmcnt(0)" ::: "memory");
            const unsigned og = xb_add(&bar[XB_TOP], 1u);
            const unsigned tg = og / nx;
            if (og + 1u == (tg + 1u) * nx) xb_add(&bar[XB_TOPGEN], 1u);
            else XB_SPIN(xb_ld(&bar[XB_TOPGEN]) == tg, bar);
            __builtin_amdgcn_fence(__ATOMIC_ACQUIRE, "agent");
            xb_add(&bar[XB_XGEN(b.x)], 1u);
            asm volatile("s_waitcnt vmcnt(0)" ::: "memory");
        } else {
            XB_SPIN(xb_ld(&bar[XB_XGEN(b.x)]) == gen, bar);
            __builtin_amdgcn_fence(__ATOMIC_ACQUIRE, "agent");
            asm volatile("s_waitcnt vmcnt(0)" ::: "memory");
        }
    }
    __syncthreads();
}


struct Ctx {
    const float *x, *c, *norm_w, *w_ada, *b_ada, *w_in, *qnw, *knw, *w_pool, *pool_scale, *w_out;
    float* out;
    float* mod; float2* rope; u16 *WinT, *WoutT, *XN, *U, *SG, *Q, *GA, *QI, *K, *V, *KI, *VT, *WpT; float* WI; unsigned* MASK; u16* MIX;
    LAS unsigned char* lds;
    int tid, lane, wave, bid, G;
};

__device__ __forceinline__ unsigned pk2h(float lo, float hi);
__device__ __forceinline__ void p0_mod_unit(const Ctx& C, int u) {
    LAS float* sc = (LAS float*)C.lds;
    const int nb = u >> 4, ks = u & 15, d0 = ks * 64;
    __syncthreads();
    { const int bb = C.tid >> 6, dd = C.tid & 63; sc[C.tid] = silu_f(C.c[bb * DM + d0 + dd]); }
    __syncthreads();
    const int col = nb * 256 + (C.tid & 255), bh = (C.tid >> 8) * 4;
    float a0 = 0.f, a1 = 0.f, a2 = 0.f, a3 = 0.f;
    const float* wp = C.w_ada + (size_t)d0 * 3072 + col;
#pragma unroll 8
    for (int d = 0; d < 64; ++d) { const float wv = wp[(size_t)d * 3072]; a0 += sc[(bh + 0) * 64 + d] * wv; a1 += sc[(bh + 1) * 64 + d] * wv; a2 += sc[(bh + 2) * 64 + d] * wv; a3 += sc[(bh + 3) * 64 + d] * wv; }
    if (ks == 0) { const float bv = C.b_ada[col]; a0 += bv; a1 += bv; a2 += bv; a3 += bv; }
    atomicAdd(C.mod + (bh + 0) * 3072 + col, a0); atomicAdd(C.mod + (bh + 1) * 3072 + col, a1); atomicAdd(C.mod + (bh + 2) * 3072 + col, a2); atomicAdd(C.mod + (bh + 3) * 3072 + col, a3);
}
__device__ __forceinline__ void p0_rope_unit(const Ctx& C, int u) {
    const int idx = u * NTH + C.tid, pos = idx >> 5, i = idx & 31;
    const double ang = (double)pos * ROPE_FREQ[i];
    double t = ang * 0.15915494309189533576888;
    t -= floor(t + 0.5);
    const double x = t * 6.283185307179586476925287, x2 = x * x;
    double s = 0.0, cc = 0.0, ts = x, tc = 1.0;
#pragma unroll 1
    for (int n = 0; n < 14; ++n) { cc += tc; s += ts; tc *= -x2 / (double)((2 * n + 1) * (2 * n + 2)); ts *= -x2 / (double)((2 * n + 2) * (2 * n + 3)); }
    C.rope[idx] = make_float2((float)cc, (float)s);
}
__device__ __forceinline__ void p0_conv_item(const Ctx& C, const float* W, int N, u16* WT, int Kdim, bool perm, LAS float* scr, int item) {
    const int lane = C.lane, nkb = Kdim >> 6, kb = item % nkb, nb = item / nkb, k0 = 64 * kb, n0 = 32 * nb;
    const int nn = lane & 31, n = n0 + nn;
#pragma unroll 8
    for (int i = 0; i < 32; ++i) { const int kk = 2 * i + (lane >> 5); scr[kk * 33 + nn] = n < N ? W[(size_t)(k0 + kk) * N + n] : 0.f; }
    asm volatile("s_waitcnt lgkmcnt(0)" ::: "memory");
    const int c = lane & 7;
#pragma unroll
    for (int j = 0; j < 4; ++j) {
        const int nr = (lane >> 3) + 8 * j; const LAS float* sp = scr + (8 * c) * 33 + nr;
        v4u o; o.x = pk2h(sp[0 * 33], sp[1 * 33]); o.y = pk2h(sp[2 * 33], sp[3 * 33]); o.z = pk2h(sp[4 * 33], sp[5 * 33]); o.w = pk2h(sp[6 * 33], sp[7 * 33]);
        const int nl = n0 + nr, np = perm ? ((nl & ~255) | (((nl >> 5) & 1) << 7) | (((nl >> 6) & 3) << 5) | (nl & 31)) : nl;
        *(v4u*)(WT + (size_t)np * Kdim + k0 + 8 * c) = o;
    }
    asm volatile("s_waitcnt lgkmcnt(0)" ::: "memory");
}
__device__ __forceinline__ void phase0(const Ctx& C) {
    constexpr int U_MOD = 192, U_ROPE = 128;
    for (int u = C.bid; u < U_MOD + U_ROPE; u += C.G) { if (u < U_MOD) p0_mod_unit(C, u); else p0_rope_unit(C, u - U_MOD); }
    __syncthreads();
    LAS float* scr = (LAS float*)(C.lds + C.wave * 16384);
    constexpr int I_WIN = 16 * 96, I_WOUT = 16 * 32, I_WP = 4 * 2 * 4, I_ALL = I_WIN + I_WOUT + I_WP;
    const int gw0 = ((C.bid + 64) % C.G) * NWAVES + C.wave, NGW = C.G * NWAVES;
    for (int it = gw0; it < I_ALL; it += NGW) {
        int r = it;
        if (r < I_WIN) { p0_conv_item(C, C.w_in, NPROJ, C.WinT, DM, true, scr, r); continue; } r -= I_WIN;
        if (r < I_WOUT) { p0_conv_item(C, C.w_out, DM, C.WoutT, DM, false, scr, r); continue; } r -= I_WOUT;
        p0_conv_item(C, C.w_pool + (size_t)(r >> 3) * 128 * 128, 128, C.WpT + (size_t)(r >> 3) * 128 * 128, 128, false, scr, r & 7);
    }
}

__device__ __forceinline__ void phase0b(const Ctx& C) {
    for (int row = C.bid * NWAVES + C.wave; row < MT; row += C.G * NWAVES) {
        const int lane = C.lane, b = row >> 11;
        const float4* xr = (const float4*)(C.x + (size_t)row * DM) + lane;
        float4 v[4]; float s = 0.f;
#pragma unroll
        for (int j = 0; j < 4; ++j) { v[j] = xr[64 * j]; s += v[j].x * v[j].x + v[j].y * v[j].y + v[j].z * v[j].z + v[j].w * v[j].w; }
        const float rstd = rsqrtf(wave_sum(s) * (1.f / DM) + EPS);
        const float* shift = C.mod + b * 3072; const float* scale = shift + 1024;
#pragma unroll
        for (int j = 0; j < 4; ++j) {
            const int k = 4 * lane + 256 * j;
            const float4 w4 = *(const float4*)(C.norm_w + k), s4 = *(const float4*)(scale + k), h4 = *(const float4*)(shift + k);
            const float o0 = v[j].x * rstd * w4.x * (1.f + s4.x) + h4.x, o1 = v[j].y * rstd * w4.y * (1.f + s4.y) + h4.y;
            const float o2 = v[j].z * rstd * w4.z * (1.f + s4.z) + h4.z, o3 = v[j].w * rstd * w4.w * (1.f + s4.w) + h4.w;
            ushort4 o; o.x = f2h(o0); o.y = f2h(o1); o.z = f2h(o2); o.w = f2h(o3);
            *(ushort4*)(C.XN + (size_t)row * DM + k) = o;
        }
    }
}


namespace pg8 {
#define PG8_LAS __attribute__((address_space(3)))
typedef unsigned short bf16_t;
typedef _Float16 bf16x8 __attribute__((ext_vector_type(8)));
typedef float f32x4 __attribute__((ext_vector_type(4)));
typedef unsigned u32x4 __attribute__((ext_vector_type(4)));
constexpr int BM = 256, BK = 64, HALF = 128, HTB = HALF * BK * 2  , STAGE_BYTES = 8 * HTB, NXCD = 8, WGM = 8;

__host__ __device__ __forceinline__ int lds_byte(int r, int c) { const int st = (r >> 4) * 2 + (c >> 5), rr = r & 15, cc = c & 31, ob = rr * 64 + cc * 2; return st * 1024 + (ob ^ (((ob >> 9) & 1) << 5)); }
__host__ __device__ __forceinline__ void stage_rc(int b, int& R, int& C) { const int st = b / 1024, sb = b % 1024, swz = sb ^ (((sb >> 9) & 1) << 5); R = (st >> 1) * 16 + swz / 64; C = (st & 1) * 32 + (swz % 64) / 2; }
__host__ __device__ __forceinline__ int perm32(int rho) { const int n = rho >> 4, i = rho & 15; return 8 * (i >> 2) + 4 * n + (i & 3); }

struct Unit { int pm, pn; };
struct Gemm { const bf16_t* A; const bf16_t* Bt; int M, N, K; };

struct StaticOrder {
    int nM, nN, nwg, G, c;
    __host__ __device__ void init(int M, int N, int G_, int c_) { nM = M / BM; nN = N / BM; nwg = nM * nN; G = G_; c = c_; }
    __host__ __device__ bool next(int i, Unit& u) const {
        const long L = (long)i * G + c; if (L >= nwg) return false;
        int wgid = (int)L; { const int q = nwg / NXCD, r = nwg % NXCD, xcd = wgid % NXCD, off = wgid / NXCD; wgid = (xcd < r ? xcd * (q + 1) : r * (q + 1) + (xcd - r) * q) + off; }
        const int nig = WGM * nN, gid = wgid / nig, fm = gid * WGM, gsz = (nM - fm) < WGM ? (nM - fm) : WGM;
        u.pm = fm + ((wgid % nig) % gsz); u.pn = (wgid % nig) / gsz; return true;
    }
    __device__ __forceinline__ void a_ready(const Unit&) const {}
    __device__ __forceinline__ void done(const Unit&) const {}
};

template <class Epi, class Sched, bool ALIGN_EPI = false, bool SP2 = false>
__device__ __forceinline__ void gemm_phase(PG8_LAS unsigned char* lds, const Gemm g, const Sched& S, const Epi& E) {
    int tid_ = threadIdx.x; asm volatile("" : "+v"(tid_));
    const int tid = tid_, wid = __builtin_amdgcn_readfirstlane(tid >> 6), lane = tid & 63, wr = wid >> 2, wc = wid & 3, fr = lane & 15, fq = lane >> 4;
    const int K = g.K, nt = K / BK;
    unsigned voffA[2], voffB[2];
#pragma unroll
    for (int i = 0; i < 2; ++i) { int R, C; stage_rc(tid * 16 + i * 8192, R, C); const int Rb = Epi::PERM ? ((R & ~31) + perm32(R & 31)) : R;
        voffA[i] = (unsigned)(R * K + C) * 2u; voffB[i] = (unsigned)(Rb * K + C) * 2u; }
    const size_t kstep = (size_t)(BK * 2);
    const size_t hstep = (size_t)HALF * K * 2;
    const size_t tstep = 2 * hstep;
    const unsigned ldsw = (unsigned)wid * 1024u;
    const int aoff = lds_byte(wr * 64 + fr, fq * 8), boff = lds_byte(wc * 32 + fr, fq * 8);
#define PG8_SA(b, h) (((b) * 2 + (h)) * HTB)
#define PG8_SB(b, h) ((4 + (b) * 2 + (h)) * HTB)
#define PG8_STAGE(bufoff, gbase, voff) do { _Pragma("unroll") for (int _i = 0; _i < 2; ++_i) \
        __builtin_amdgcn_global_load_lds((const unsigned*)((const char*)(gbase) + (voff)[_i]), (PG8_LAS unsigned*)(lds + (bufoff) + ldsw + _i * 8192), 16, 0, 0); } while (0)
#define PG8_LDA(dst, b, h) do { _Pragma("unroll") for (int m = 0; m < 4; ++m) _Pragma("unroll") for (int k = 0; k < 2; ++k) dst[m][k] = *(const PG8_LAS bf16x8*)(lds + PG8_SA(b, h) + aoff + m * 2048 + k * 1024); } while (0)
#define PG8_LDB(dst, b, h) do { _Pragma("unroll") for (int n = 0; n < 2; ++n) _Pragma("unroll") for (int k = 0; k < 2; ++k) dst[n][k] = *(const PG8_LAS bf16x8*)(lds + PG8_SB(b, h) + boff + n * 2048 + k * 1024); } while (0)
#define PG8_MMA(ai, bj, At, Bt) do { __builtin_amdgcn_s_setprio(1); _Pragma("unroll") for (int m = 0; m < 4; ++m) _Pragma("unroll") for (int n = 0; n < 2; ++n) _Pragma("unroll") for (int k = 0; k < 2; ++k) \
        acc[ai][bj][m][n] = __builtin_amdgcn_mfma_f32_16x16x32_f16(Bt[n][k], At[m][k], acc[ai][bj][m][n], 0, 0, 0); __builtin_amdgcn_s_setprio(0); } while (0)
#define PG8_WAIT_V(n) asm volatile("s_waitcnt vmcnt(" #n ")" ::: "memory")
#define PG8_WAIT_L(n) asm volatile("s_waitcnt lgkmcnt(" #n ")" ::: "memory")
#define PG8_BAR __builtin_amdgcn_s_barrier()
#define PG8_SCHED __builtin_amdgcn_sched_barrier(0)
    Unit cur, nxt; int ui = 0;
    if (!S.next(0, cur)) return;
    f32x4 acc[2][2][4][2];
#pragma unroll
    for (int a = 0; a < 2; ++a)
#pragma unroll
        for (int b = 0; b < 2; ++b)
#pragma unroll
            for (int m = 0; m < 4; ++m)
#pragma unroll
                for (int n = 0; n < 2; ++n) acc[a][b][m][n] = (f32x4){0.f, 0.f, 0.f, 0.f};
    bf16x8 At[4][2], B0[2][2], B1[2][2];
    const char* cA = (const char*)g.A + (size_t)cur.pm * tstep; const char* cB = (const char*)g.Bt + (size_t)cur.pn * tstep;
    S.a_ready(cur);
    if constexpr (SP2) {
        PG8_STAGE(PG8_SB(0, 0), cB, voffB); PG8_STAGE(PG8_SB(0, 1), cB + hstep, voffB); PG8_STAGE(PG8_SA(0, 0), cA, voffA); PG8_STAGE(PG8_SA(0, 1), cA + hstep, voffA);
        if (wr == 1) PG8_BAR;
        PG8_WAIT_V(2); PG8_BAR;
        PG8_STAGE(PG8_SB(1, 0), cB + kstep, voffB); PG8_STAGE(PG8_SA(1, 0), cA + kstep, voffA); PG8_STAGE(PG8_SB(1, 1), cB + hstep + kstep, voffB);
        PG8_WAIT_V(6); PG8_BAR;
    } else {
        PG8_STAGE(PG8_SB(0, 0), cB, voffB); PG8_STAGE(PG8_SA(0, 0), cA, voffA); PG8_STAGE(PG8_SB(0, 1), cB + hstep, voffB); PG8_STAGE(PG8_SA(0, 1), cA + hstep, voffA);
        if (wr == 1) PG8_BAR;
        PG8_WAIT_V(4); PG8_BAR;
        PG8_STAGE(PG8_SB(1, 0), cB + kstep, voffB); PG8_STAGE(PG8_SA(1, 0), cA + kstep, voffA); PG8_STAGE(PG8_SB(1, 1), cB + hstep + kstep, voffB);
        PG8_WAIT_V(6); PG8_BAR;
    }
    for (;;) {
        const bool has_next = S.next(ui + 1, nxt);
        const char* nA = has_next ? (const char*)g.A + (size_t)nxt.pm * tstep : cA; const char* nB = has_next ? (const char*)g.Bt + (size_t)nxt.pn * tstep : cB;
        for (int t = 0; t < nt; t += 2) {
            const bool last = (t == nt - 2);
            const char* a1 = cA + (size_t)(t + 1) * kstep;
            const char* a2 = last ? nA : cA + (size_t)(t + 2) * kstep; const char* b2 = last ? nB : cB + (size_t)(t + 2) * kstep;
            const char* a3 = a2 + kstep; const char* b3 = b2 + kstep;
            if (last && has_next) S.a_ready(nxt);
            if constexpr (SP2) {
            PG8_LDB(B0, 0, 0); PG8_LDB(B1, 0, 1); PG8_SCHED; PG8_LDA(At, 0, 0); PG8_STAGE(PG8_SA(1, 1), a1 + hstep, voffA);
            PG8_WAIT_V(8); PG8_WAIT_L(0); PG8_BAR; PG8_MMA(0, 0, At, B0); PG8_MMA(0, 1, At, B1); PG8_BAR; PG8_SCHED;
            PG8_LDA(At, 0, 1); PG8_STAGE(PG8_SB(0, 0), b2, voffB); PG8_STAGE(PG8_SB(0, 1), b2 + hstep, voffB); PG8_STAGE(PG8_SA(0, 0), a2, voffA);
            PG8_WAIT_V(8); PG8_WAIT_L(0); PG8_BAR; PG8_MMA(1, 0, At, B0); PG8_MMA(1, 1, At, B1); PG8_BAR; PG8_SCHED;
            PG8_LDB(B0, 1, 0); PG8_LDB(B1, 1, 1); PG8_SCHED; PG8_LDA(At, 1, 0); PG8_STAGE(PG8_SA(0, 1), a2 + hstep, voffA);
            PG8_WAIT_V(8); PG8_WAIT_L(0); PG8_BAR; PG8_MMA(0, 0, At, B0); PG8_MMA(0, 1, At, B1); PG8_BAR; PG8_SCHED;
            PG8_LDA(At, 1, 1); PG8_STAGE(PG8_SB(1, 0), b3, voffB); PG8_STAGE(PG8_SB(1, 1), b3 + hstep, voffB); PG8_STAGE(PG8_SA(1, 0), a3, voffA);
            PG8_WAIT_V(8); PG8_WAIT_L(0); PG8_BAR; PG8_MMA(1, 0, At, B0); PG8_MMA(1, 1, At, B1); PG8_BAR; PG8_SCHED;
            } else {
            PG8_LDB(B0, 0, 0); PG8_SCHED; PG8_LDA(At, 0, 0); PG8_STAGE(PG8_SA(1, 1), a1 + hstep, voffA);
            PG8_WAIT_L(8); PG8_BAR; PG8_WAIT_L(0); PG8_MMA(0, 0, At, B0); PG8_BAR; PG8_SCHED;
            PG8_LDB(B1, 0, 1); PG8_STAGE(PG8_SB(0, 0), b2, voffB);
            PG8_BAR; PG8_WAIT_L(0); PG8_MMA(0, 1, At, B1); PG8_BAR;
            PG8_LDA(At, 0, 1); PG8_STAGE(PG8_SA(0, 0), a2, voffA);
            PG8_BAR; PG8_WAIT_L(0); PG8_MMA(1, 0, At, B0); PG8_BAR; PG8_SCHED;
            PG8_STAGE(PG8_SB(0, 1), b2 + hstep, voffB);
            PG8_WAIT_V(6); PG8_BAR; PG8_MMA(1, 1, At, B1); PG8_BAR;
            PG8_LDB(B0, 1, 0); PG8_SCHED; PG8_LDA(At, 1, 0); PG8_STAGE(PG8_SA(0, 1), a2 + hstep, voffA);
            PG8_WAIT_L(8); PG8_BAR; PG8_WAIT_L(0); PG8_MMA(0, 0, At, B0); PG8_BAR; PG8_SCHED;
            PG8_LDB(B1, 1, 1); PG8_STAGE(PG8_SB(1, 0), b3, voffB);
            PG8_BAR; PG8_WAIT_L(0); PG8_MMA(0, 1, At, B1); PG8_BAR;
            PG8_LDA(At, 1, 1); PG8_STAGE(PG8_SA(1, 0), a3, voffA);
            PG8_BAR; PG8_WAIT_L(0); PG8_MMA(1, 0, At, B0); PG8_BAR; PG8_SCHED;
            PG8_STAGE(PG8_SB(1, 1), b3 + hstep, voffB);
            PG8_WAIT_V(6); PG8_BAR; PG8_MMA(1, 1, At, B1); PG8_BAR;
            }
        }
        if constexpr (ALIGN_EPI) { if (wr == 0) PG8_BAR; }
        if constexpr (!Epi::AFTER_DRAIN) { E(acc, cur, wr, wc, fr, fq); S.done(cur); }
        if (!has_next) break;
#pragma unroll
        for (int a = 0; a < 2; ++a)
#pragma unroll
            for (int b = 0; b < 2; ++b)
#pragma unroll
                for (int m = 0; m < 4; ++m)
#pragma unroll
                    for (int n = 0; n < 2; ++n) acc[a][b][m][n] = (f32x4){0.f, 0.f, 0.f, 0.f};
        cur = nxt; cA = nA; cB = nB; ++ui;
        if constexpr (ALIGN_EPI) { if (wr == 1) PG8_BAR; }
    }
    PG8_WAIT_V(0);
    if constexpr (!ALIGN_EPI) { if (wr == 0) PG8_BAR; }
    PG8_BAR;
    if constexpr (Epi::AFTER_DRAIN) { E.fused(acc, cur, wr, wc, fr, fq, lds, wid, lane); S.done(cur); }
#undef PG8_SA
#undef PG8_SB
#undef PG8_STAGE
#undef PG8_LDA
#undef PG8_LDB
#undef PG8_MMA
#undef PG8_WAIT_V
#undef PG8_WAIT_L
#undef PG8_BAR
#undef PG8_SCHED
}
}


__device__ __forceinline__ unsigned pk2h(float lo, float hi) { typedef _Float16 h2 __attribute__((ext_vector_type(2))); h2 v; v.x = (_Float16)lo; v.y = (_Float16)hi; return __builtin_bit_cast(unsigned, v); }

struct EpiP1 {
    static constexpr bool PERM = true, AFTER_DRAIN = false;
    u16 *U, *SG, *Q, *GA, *QI, *K, *V, *KI; float* WI; const float *qnw, *knw; const float2* rope;
    __device__ __forceinline__ void operator()(const f32x4 (&acc)[2][2][4][2], const pg8::Unit& u, int wr, int wc, int fr, int fq) const {
        const int g = u.pn * 4 + wc;
        if (g > 45) return;
        int mode, ld; u16* dst; const float* nwp = qnw; float osc = 1.f;
        if (g < 8) { mode = 0; dst = U + g * 64; ld = 512; }
        else if (g < 16) { mode = 1; dst = SG + (g - 8) * 64; ld = 512; }
        else if (g < 24) { mode = 2; dst = Q + (g - 16) * 64; ld = 512; osc = QSCALE; }
        else if (g < 26) { mode = 2; dst = K + (g - 24) * 64; ld = 128; nwp = knw; }
        else if (g < 28) { mode = 5; dst = V; ld = 128; }
        else if (g < 36) { mode = 1; dst = GA + (g - 28) * 64; ld = 512; }
        else if (g < 44) { mode = 3; dst = QI + (g - 36) * 64; ld = 512; }
        else if (g == 44) { mode = 3; dst = KI; ld = 64; }
        else { mode = 4; dst = KI; ld = 64; }
        const int row0 = u.pm * 256 + wr * 64 + fr;
        if (mode == 5) {
            const int kvh = g - 26;
#pragma unroll
            for (int ai = 0; ai < 2; ++ai)
#pragma unroll
                for (int m = 0; m < 4; ++m) {
                    const int t = row0 + ai * 128 + m * 16, bb = t >> 11, pos = t & (SEQ - 1), pp = (pos & ~12) | ((pos & 4) << 1) | ((pos & 8) >> 1);
                    u16* vp = dst + ((size_t)((bb * 2 + kvh) * 64 + 8 * fq)) * SEQ + pp;
#pragma unroll
                    for (int bj = 0; bj < 2; ++bj)
#pragma unroll
                        for (int n = 0; n < 2; ++n)
#pragma unroll
                            for (int j = 0; j < 4; ++j) vp[(size_t)(32 * bj + 4 * n + j) * SEQ] = f2h(acc[ai][bj][m][n][j]);
                }
            return;
        }
        if (mode == 4) {
            if (fq == 0) {
#pragma unroll
                for (int ai = 0; ai < 2; ++ai)
#pragma unroll
                    for (int m = 0; m < 4; ++m) { float* wp = WI + (size_t)(row0 + ai * 128 + m * 16) * 8; *(f32x4*)wp = acc[ai][0][m][0]; *(f32x4*)(wp + 4) = acc[ai][0][m][1]; }
            }
            return;
        }
        f32x4 nlo0 = {1.f, 1.f, 1.f, 1.f}, nlo1 = nlo0, nhi0 = nlo0, nhi1 = nlo0;
        if (mode == 2) { nlo0 = *(const f32x4*)(nwp + 8 * fq); nlo1 = *(const f32x4*)(nwp + 8 * fq + 4); nhi0 = *(const f32x4*)(nwp + 32 + 8 * fq); nhi1 = *(const f32x4*)(nwp + 36 + 8 * fq); }
#pragma unroll
        for (int ai = 0; ai < 2; ++ai)
#pragma unroll
            for (int m = 0; m < 4; ++m) {
                const int t = row0 + ai * 128 + m * 16;
                f32x4 a0 = acc[ai][0][m][0], a1 = acc[ai][0][m][1], b0 = acc[ai][1][m][0], b1 = acc[ai][1][m][1];
                if (mode == 1) {
#pragma unroll
                    for (int j = 0; j < 4; ++j) { a0[j] = silu_f(a0[j]); a1[j] = silu_f(a1[j]); b0[j] = silu_f(b0[j]); b1[j] = silu_f(b1[j]); }
                } else if (mode >= 2) {
                    if (mode == 2) {
                        float ss = 0.f;
#pragma unroll
                        for (int j = 0; j < 4; ++j) ss += a0[j] * a0[j] + a1[j] * a1[j] + b0[j] * b0[j] + b1[j] * b1[j];
                        ss += __shfl_xor(ss, 16); ss += __shfl_xor(ss, 32);
                        const float rinv = rsqrtf(ss * (1.f / 64.f) + EPS);
                        a0 = a0 * rinv * nlo0; a1 = a1 * rinv * nlo1; b0 = b0 * rinv * nhi0; b1 = b1 * rinv * nhi1;
                    }
                    const f32x4* rp = (const f32x4*)(rope + (size_t)(t & (SEQ - 1)) * 32 + 8 * fq);
                    const f32x4 r0 = rp[0], r1 = rp[1], r2 = rp[2], r3 = rp[3];
                    f32x4 o0, o1, p0, p1;
                    o0[0] = a0[0] * r0[0] - b0[0] * r0[1]; p0[0] = b0[0] * r0[0] + a0[0] * r0[1];
                    o0[1] = a0[1] * r0[2] - b0[1] * r0[3]; p0[1] = b0[1] * r0[2] + a0[1] * r0[3];
                    o0[2] = a0[2] * r1[0] - b0[2] * r1[1]; p0[2] = b0[2] * r1[0] + a0[2] * r1[1];
                    o0[3] = a0[3] * r1[2] - b0[3] * r1[3]; p0[3] = b0[3] * r1[2] + a0[3] * r1[3];
                    o1[0] = a1[0] * r2[0] - b1[0] * r2[1]; p1[0] = b1[0] * r2[0] + a1[0] * r2[1];
                    o1[1] = a1[1] * r2[2] - b1[1] * r2[3]; p1[1] = b1[1] * r2[2] + a1[1] * r2[3];
                    o1[2] = a1[2] * r3[0] - b1[2] * r3[1]; p1[2] = b1[2] * r3[0] + a1[2] * r3[1];
                    o1[3] = a1[3] * r3[2] - b1[3] * r3[3]; p1[3] = b1[3] * r3[2] + a1[3] * r3[3];
                    a0 = o0 * osc; a1 = o1 * osc; b0 = p0 * osc; b1 = p1 * osc;
                }
                u16* dp = dst + (size_t)t * ld + 8 * fq;
                v4u lo, hi; lo.x = pk2h(a0[0], a0[1]); lo.y = pk2h(a0[2], a0[3]); lo.z = pk2h(a1[0], a1[1]); lo.w = pk2h(a1[2], a1[3]);
                hi.x = pk2h(b0[0], b0[1]); hi.y = pk2h(b0[2], b0[3]); hi.z = pk2h(b1[0], b1[1]); hi.w = pk2h(b1[2], b1[3]);
                *(v4u*)dp = lo; *(v4u*)(dp + 32) = hi;
                if (m & 1) asm volatile("" ::: "memory");
            }
    }
};
struct EpiOut {
    static constexpr bool PERM = true, AFTER_DRAIN = false;
    const float* x; const float* gate; float* out;
    __device__ __forceinline__ void operator()(const f32x4 (&acc)[2][2][4][2], const pg8::Unit& u, int wr, int wc, int fr, int fq) const {
        const int row0 = u.pm * 256 + wr * 64 + fr, col0 = u.pn * 256 + wc * 32 + 8 * fq, b = (u.pm * 256) >> 11;
        f32x4 gv[2][2];
#pragma unroll
        for (int bj = 0; bj < 2; ++bj)
#pragma unroll
            for (int n = 0; n < 2; ++n) gv[bj][n] = *(const f32x4*)(gate + b * 3072 + col0 + bj * 128 + 4 * n);
#pragma unroll
        for (int ai = 0; ai < 2; ++ai)
#pragma unroll
            for (int m = 0; m < 4; ++m) {
                const size_t off = (size_t)(row0 + ai * 128 + m * 16) * DM + col0;
#pragma unroll
                for (int bj = 0; bj < 2; ++bj)
#pragma unroll
                    for (int n = 0; n < 2; ++n) { const f32x4 xv = *(const f32x4*)(x + off + bj * 128 + 4 * n); *(f32x4*)(out + off + bj * 128 + 4 * n) = xv + gv[bj][n] * acc[ai][bj][m][n]; }
                if (m & 1) asm volatile("" ::: "memory");
            }
    }
};

__device__ __forceinline__ void p1_epilogue_row(const Ctx& C, int g, int t, int sub, const LAS float* tr) {
    const int pos = t & (SEQ - 1);
    if (g < 8) {
        for (int c = 16 * sub; c < 16 * sub + 16; ++c) C.U[(size_t)t * 512 + g * 64 + c] = f2h(tr[c]);
    } else if (g < 16) {
        for (int c = 16 * sub; c < 16 * sub + 16; ++c) C.SG[(size_t)t * 512 + (g - 8) * 64 + c] = f2h(silu_f(tr[c]));
    } else if (g < 26) {
        float ss = 0.f;
        for (int c = 16 * sub; c < 16 * sub + 16; ++c) ss += tr[c] * tr[c];
        ss += __shfl_xor(ss, 1); ss += __shfl_xor(ss, 2);
        const float rinv = rsqrtf(ss * (1.f / 64.f) + EPS);
        const bool isq = g < 24; const float* nwp = isq ? C.qnw : C.knw; const float osc = isq ? QSCALE : 1.f;
        u16* dst = isq ? C.Q + (size_t)t * 512 + (g - 16) * 64 : C.K + (size_t)t * 128 + (g - 24) * 64;
        for (int i = 8 * sub; i < 8 * sub + 8; ++i) {
            const float x1 = tr[i] * rinv * nwp[i], x2 = tr[i + 32] * rinv * nwp[i + 32];
            const float2 cs = C.rope[pos * 32 + i];
            dst[i] = f2h((x1 * cs.x - x2 * cs.y) * osc); dst[i + 32] = f2h((x2 * cs.x + x1 * cs.y) * osc);
        }
    } else if (g < 28) {
        for (int c = 16 * sub; c < 16 * sub + 16; ++c) C.V[(size_t)t * 128 + (g - 26) * 64 + c] = f2h(tr[c]);
    } else if (g < 36) {
        for (int c = 16 * sub; c < 16 * sub + 16; ++c) C.GA[(size_t)t * 512 + (g - 28) * 64 + c] = f2h(silu_f(tr[c]));
    } else if (g < 45) {
        u16* dst = g < 44 ? C.QI + (size_t)t * 512 + (g - 36) * 64 : C.KI + (size_t)t * 64;
        for (int i = 8 * sub; i < 8 * sub + 8; ++i) {
            const float x1 = tr[i], x2 = tr[i + 32];
            const float2 cs = C.rope[pos * 32 + i];
            dst[i] = f2h(x1 * cs.x - x2 * cs.y); dst[i + 32] = f2h(x2 * cs.x + x1 * cs.y);
        }
    } else {
        if (sub == 0) for (int c = 0; c < 8; ++c) C.WI[(size_t)t * 8 + c] = tr[c];
    }
}
__device__ __forceinline__ void phase1_naive(const Ctx& C) {
    LAS float* tile = (LAS float*)C.lds;
    for (int u = C.bid; u < 46 * 128; u += C.G) {
        const int g = u % 46, r0 = (u / 46) * 128, w = C.wave, lane = C.lane, wr = w & 3, wcn = w >> 2;
        const u16* ap = C.XN + (size_t)(r0 + wr * 32 + (lane & 31)) * DM + 8 * (lane >> 5);
        const u16* bp = C.WinT + (size_t)(g * 64 + wcn * 32 + (lane & 31)) * DM + 8 * (lane >> 5);
        f32x16 acc;
#pragma unroll
        for (int r = 0; r < 16; ++r) acc[r] = 0.f;
        for (int k0 = 0; k0 < DM; k0 += 16) {
            const h16x8 a = *(const h16x8*)(ap + k0), bb = *(const h16x8*)(bp + k0);
            acc = __builtin_amdgcn_mfma_f32_32x32x16_f16(a, bb, acc, 0, 0, 0);
        }
        __syncthreads();
#pragma unroll
        for (int r = 0; r < 16; ++r) tile[(wr * 32 + (r & 3) + 8 * (r >> 2) + 4 * (lane >> 5)) * 65 + wcn * 32 + (lane & 31)] = acc[r];
        __syncthreads();
        const int row = C.tid >> 2, sub = C.tid & 3;
        p1_epilogue_row(C, g, r0 + row, sub, tile + row * 65);
    }
}

__device__ __forceinline__ void pool_unit_naive(const Ctx& C, int u) {
    LAS float* pl = (LAS float*)C.lds;
    const int t0 = (u >> 2) * 64, g = u & 3, tid = C.tid, win = 2 << g;
    __syncthreads();
    for (int idx = tid; idx < 64 * 128; idx += NTH) {
        const int tl = idx >> 7, c = idx & 127, t = t0 + tl, pos = t & (SEQ - 1);
        const int cnt = (pos + 1 < win) ? pos + 1 : win;
        float s = 0.f;
        for (int j = 0; j < cnt; ++j) s += h2f(C.U[(size_t)(t - j) * 512 + g * 128 + c]);
        pl[tl * 128 + c] = s / (float)cnt - h2f(C.U[(size_t)t * 512 + g * 128 + c]);
    }
    __syncthreads();
    const int d = tid & 127, rh = tid >> 7;
    float acc[16];
#pragma unroll
    for (int i = 0; i < 16; ++i) acc[i] = 0.f;
    const float* wp = C.w_pool + (size_t)g * 128 * 128 + d;
    for (int c = 0; c < 128; ++c) {
        const float wv = wp[(size_t)c * 128];
#pragma unroll
        for (int i = 0; i < 16; ++i) acc[i] += pl[(rh * 16 + i) * 128 + c] * wv;
    }
    const float ps = C.pool_scale[g * 128 + d];
#pragma unroll
    for (int i = 0; i < 16; ++i) {
        const int t = t0 + rh * 16 + i;
        C.MIX[(size_t)t * 1024 + g * 128 + d] = f2h(acc[i] * ps * h2f(C.SG[(size_t)t * 512 + g * 128 + d]));
    }
}


__device__ __forceinline__ int pswz(int row, int ch) { return row * 256 + ((ch ^ (row & 15)) << 4); }
__device__ __forceinline__ void pool_unit(const Ctx& C, int u) {
    LAS unsigned char* L = C.lds;
    const int t0 = (u >> 2) * 128, g = u & 3, win = 2 << g, w = C.wave, lane = C.lane;
    __syncthreads();
    {
        const int cp = lane, c0 = 2 * cp;
        const int tb = t0 + 16 * w, pos0 = tb & (SEQ - 1);
        const u16* up = C.U + (size_t)tb * 512 + g * 128 + c0;
        unsigned cur[16], old[16];
#pragma unroll
        for (int i = 0; i < 16; ++i) { cur[i] = *(const unsigned*)(up + (size_t)i * 512); old[i] = (pos0 + i >= win) ? *(const unsigned*)(up + (size_t)(i - win) * 512) : 0u; }
        float s0 = 0.f, s1 = 0.f;
        if (win <= 16) {
            const int npre = pos0 < win ? pos0 : win;
            for (int j = 1; j <= npre; ++j) { const unsigned v = *(const unsigned*)(up - (size_t)j * 512); s0 += h2f((u16)(v & 0xffffu)); s1 += h2f((u16)(v >> 16)); }
        }
#pragma unroll
        for (int i = 0; i < 16; ++i) {
            const int pos = pos0 + i;
            const float a0 = h2f((u16)(cur[i] & 0xffffu)), a1 = h2f((u16)(cur[i] >> 16));
            s0 += a0 - h2f((u16)(old[i] & 0xffffu)); s1 += a1 - h2f((u16)(old[i] >> 16));
            const float cnt = (float)(pos + 1 < win ? pos + 1 : win);
            const int row = 16 * w + i;
            *(LAS unsigned*)(L + pswz(row, c0 >> 3) + (c0 & 7) * 2) = pk2h(s0 / cnt - a0, s1 / cnt - a1);
        }
    }
    __syncthreads();
    const int q32 = lane & 31, half = lane >> 5, dt = w & 3, tp = w >> 2;
    h16x8 af[8];
    const u16* wp = C.WpT + ((size_t)g * 128 + 32 * dt + q32) * 128 + 8 * half;
#pragma unroll
    for (int ks = 0; ks < 8; ++ks) af[ks] = *(const h16x8*)(wp + 16 * ks);
    const int d0 = g * 128 + 32 * dt + 4 * half;
#pragma unroll
    for (int tt = 0; tt < 2; ++tt) {
        const int trow = 64 * tp + 32 * tt + q32;
        f32x16 acc;
#pragma unroll
        for (int r = 0; r < 16; ++r) acc[r] = 0.f;
#pragma unroll
        for (int ks = 0; ks < 8; ++ks) {
            const h16x8 bf = *(const LAS h16x8*)(L + pswz(trow, 2 * ks + half));
            acc = __builtin_amdgcn_mfma_f32_32x32x16_f16(af[ks], bf, acc, 0, 0, 0);
        }
        const int t = t0 + trow;
#pragma unroll
        for (int g4 = 0; g4 < 4; ++g4) {
            const int d = d0 + 8 * g4;
            const f32x4 ps = *(const f32x4*)(C.pool_scale + d);
            const uint2 gv = *(const uint2*)(C.SG + (size_t)t * 512 + d);
            uint2 ov;
            ov.x = pk2h(acc[4 * g4] * ps[0] * h2f((u16)(gv.x & 0xffffu)), acc[4 * g4 + 1] * ps[1] * h2f((u16)(gv.x >> 16)));
            ov.y = pk2h(acc[4 * g4 + 2] * ps[2] * h2f((u16)(gv.y & 0xffffu)), acc[4 * g4 + 3] * ps[3] * h2f((u16)(gv.y >> 16)));
            *(uint2*)(C.MIX + (size_t)t * 1024 + d) = ov;
        }
    }
}
__device__ __forceinline__ unsigned fkey(float f) { const unsigned u = __float_as_uint(f); return (u & 0x80000000u) ? ~u : (u | 0x80000000u); }
__device__ __forceinline__ int block_sum_int(int v, LAS int* red) {
#pragma unroll
    for (int o = 1; o < 64; o <<= 1) v += __shfl_xor(v, o);
    __syncthreads();
    if ((threadIdx.x & 63) == 0) red[threadIdx.x >> 6] = v;
    __syncthreads();
    return red[0] + red[1] + red[2] + red[3] + red[4] + red[5] + red[6] + red[7];
}


struct WorkQ {
    unsigned* head; LAS int* slot; int cur, nxt_pending;
};
__device__ __forceinline__ int wq_first(const Ctx& C, unsigned* head) {
    LAS int* slot = (LAS int*)(C.lds + LDSCTL_OFF + 256);
    __syncthreads();
    if (C.tid == 0) *slot = (int)__hip_atomic_fetch_add(head, 1u, __ATOMIC_RELAXED, __HIP_MEMORY_SCOPE_AGENT);
    __syncthreads();
    return *slot;
}

template <int CTRL, int RM> __device__ __forceinline__ int dpp_i(int idv, int v) { return __builtin_amdgcn_update_dpp(idv, v, CTRL, RM, 0xF, false); }
__device__ __forceinline__ int wave_sum_i(int v) {
    v += dpp_i<0x111, 0xF>(0, v); v += dpp_i<0x112, 0xF>(0, v); v += dpp_i<0x114, 0xF>(0, v); v += dpp_i<0x118, 0xF>(0, v);
    v += dpp_i<0x142, 0xA>(0, v); v += dpp_i<0x143, 0xC>(0, v);
    return __builtin_amdgcn_readlane(v, 63);
}
__device__ __forceinline__ float wave_max_f(float v) {
    constexpr int NI = (int)0xFF800000u;
    v = fmaxf(v, __int_as_float(dpp_i<0x111, 0xF>(NI, __float_as_int(v)))); v = fmaxf(v, __int_as_float(dpp_i<0x112, 0xF>(NI, __float_as_int(v))));
    v = fmaxf(v, __int_as_float(dpp_i<0x114, 0xF>(NI, __float_as_int(v)))); v = fmaxf(v, __int_as_float(dpp_i<0x118, 0xF>(NI, __float_as_int(v))));
    v = fmaxf(v, __int_as_float(dpp_i<0x142, 0xA>(NI, __float_as_int(v)))); v = fmaxf(v, __int_as_float(dpp_i<0x143, 0xC>(NI, __float_as_int(v))));
    return __int_as_float(__builtin_amdgcn_readlane(__float_as_int(v), 63));
}
constexpr int QS = 2052;
__device__ __forceinline__ int cnt4(int c, float k0, float k1, float k2, float k3, float x) {
    unsigned long long m0, m1, m2, m3;
    asm volatile("v_cmp_ge_f32_e64 %1, %5, %9\n\tv_cmp_ge_f32_e64 %2, %6, %9\n\tv_cmp_ge_f32_e64 %3, %7, %9\n\tv_cmp_ge_f32_e64 %4, %8, %9\n\t"
                 "v_addc_co_u32_e64 %0, vcc, %0, 0, %1\n\tv_addc_co_u32_e64 %0, vcc, %0, 0, %2\n\tv_addc_co_u32_e64 %0, vcc, %0, 0, %3\n\tv_addc_co_u32_e64 %0, vcc, %0, 0, %4"
                 : "+v"(c), "=&s"(m0), "=&s"(m1), "=&s"(m2), "=&s"(m3) : "v"(k0), "v"(k1), "v"(k2), "v"(k3), "v"(x) : "vcc");
    return c;
}
__device__ __forceinline__ int cnt_lane(const float (&sv)[32], int nreg, float x) {
    int c = 0;
#pragma unroll
    for (int jj = 0; jj < 8; ++jj) if (4 * jj < nreg) c = cnt4(c, sv[4 * jj], sv[4 * jj + 1], sv[4 * jj + 2], sv[4 * jj + 3], x);
    return c;
}
__device__ __forceinline__ unsigned skey(float f) { return f == -INFINITY ? 0u : fkey(f); }

struct SelSt {
    float lo, hi, flo, fhi, tau; int side; bool found, fail; unsigned T, J;
    __device__ __forceinline__ void init(int n) { found = n <= 256; fail = false; tau = -3.0e38f; lo = hi = 0.f; flo = (float)(n - 256) + 0.5f; fhi = -255.5f; side = 0; T = 0u; J = 2047u; }
    __device__ __forceinline__ bool active() const { return !(found || fail); }
    __device__ __forceinline__ float pivot() {
        float x = (lo * fhi - hi * flo) * __builtin_amdgcn_rcpf(fhi - flo);
        if (!(x > lo && x < hi)) x = 0.5f * (lo + hi);
        if (!(x > lo && x < hi)) fail = true;
        return x;
    }
    __device__ __forceinline__ void update(float x, int c) {
        if (found || fail) return;
        if (c == 256) { found = true; tau = x; }
        else if (c > 256) { lo = x; flo = (float)(c - 256) + 0.5f; if (side == 1) fhi *= 0.5f; side = 1; }
        else { hi = x; fhi = (float)(c - 256) + 0.5f; if (side == -1) flo *= 0.5f; side = -1; }
    }
};
__device__ __forceinline__ void sel_minmax(const float (&sv)[32], int nreg, int n, int lane, SelSt& S) {
    float mx = -INFINITY, mn = INFINITY;
#pragma unroll
    for (int j = 0; j < 32; ++j) if (j < nreg) {
        mx = fmaxf(mx, sv[j]);
        if (64 * (j + 1) <= n) mn = fminf(mn, sv[j]); else if (64 * j < n) mn = fminf(mn, (lane < n - 64 * j) ? sv[j] : INFINITY);
    }
    const float hi = wave_max_f(mx);
    S.lo = -wave_max_f(-mn);
    S.hi = hi + fmaxf(fabsf(hi) * 1e-6f, 1e-30f);
}
__device__ __forceinline__ void sel_exact(const float (&sv)[32], int nreg, int lane, SelSt& S) {
    unsigned kk[32];
#pragma unroll
    for (int j = 0; j < 32; ++j) kk[j] = (j < nreg) ? skey(sv[j]) : 0u;
    const unsigned klo = fkey(S.lo), khi = fkey(S.hi), diff = klo ^ khi;
    const int hb = 31 - __builtin_clz(diff | 1u);
    unsigned T = hb >= 31 ? 0u : (klo & ~((2u << hb) - 1u));
    bool exact256 = false;
#pragma unroll 1
    for (int bit = hb; bit >= 0; --bit) {
        const unsigned cand = T | (1u << bit);
        int c = 0;
#pragma unroll
        for (int j = 0; j < 32; ++j) if (j < nreg) c += kk[j] >= cand ? 1 : 0;
        c = wave_sum_i(c);
        if (c >= 256) T = cand;
        if (c == 256) { exact256 = true; break; }
    }
    S.T = T; S.J = 2047u;
    if (exact256) return;
    int cg = 0;
#pragma unroll
    for (int j = 0; j < 32; ++j) if (j < nreg) cg += kk[j] > T ? 1 : 0;
    const int need = 256 - wave_sum_i(cg);
    unsigned Jt = 0u;
#pragma unroll 1
    for (int bit = 10; bit >= 0; --bit) {
        const unsigned cj = Jt | (1u << bit);
        int c2 = 0;
#pragma unroll
        for (int j = 0; j < 32; ++j) if (j < nreg) c2 += (kk[j] == T && (unsigned)(64 * j + lane) < cj) ? 1 : 0;
        if (wave_sum_i(c2) < need) Jt = cj;
    }
    S.J = Jt;
}
__device__ __forceinline__ void sel_write(const Ctx& C, const float (&sv)[32], int nreg, int lane, const SelSt& S, int t) {
    int mlo = 0, mhi = 0;
#pragma unroll
    for (int j = 0; j < 32; ++j) if (j < nreg) {
        bool sj;
        if (S.found) sj = sv[j] >= S.tau; else { const unsigned k = skey(sv[j]); sj = k > S.T || (k == S.T && (unsigned)(64 * j + lane) <= S.J); }
        const unsigned long long bal = __ballot(sj);
        mlo = (lane == j) ? (int)(unsigned)bal : mlo; mhi = (lane == j) ? (int)(unsigned)(bal >> 32) : mhi;
    }
    if (lane < 32) *(uint2*)(C.MASK + (size_t)t * 64 + 2 * lane) = make_uint2((unsigned)mlo, (unsigned)mhi);
}
__device__ __forceinline__ float unkey(unsigned k) { return __uint_as_float((k & 0x80000000u) ? (k ^ 0x80000000u) : ~k); }
__device__ __forceinline__ void stageA_unit(const Ctx& C, int b, int qb, int par) {
    LAS float* SC = (LAS float*)C.lds;
    LAS unsigned* RM = (LAS unsigned*)(C.lds + 16 * QS * 4);
    LAS unsigned* RT = RM + 64;
    const int w = C.wave, lane = C.lane, fr = lane & 15, fq = lane >> 4;
    const int nregU = (qb >> 2) + 1;
    if (C.tid < 16) { RM[par * 32 + C.tid] = 0u; RM[par * 32 + 16 + C.tid] = 0xFFFFFFFFu; }
    if (C.tid == 32) RT[par] = 0u;
    TS(20);
    __syncthreads();
    TS(12);
    {
        const int pos = 16 * qb + fr, t = b * SEQ + pos;
        h16x8 qf[8][2];
#pragma unroll
        for (int h = 0; h < 8; ++h)
#pragma unroll
            for (int ks = 0; ks < 2; ++ks) qf[h][ks] = *(const h16x8*)(C.QI + (size_t)t * 512 + h * 64 + 32 * ks + 8 * fq);
        float wi[8];
        { const f32x4 w0 = *(const f32x4*)(C.WI + (size_t)t * 8), w1 = *(const f32x4*)(C.WI + (size_t)t * 8 + 4);
          wi[0] = w0[0]; wi[1] = w0[1]; wi[2] = w0[2]; wi[3] = w0[3]; wi[4] = w1[0]; wi[5] = w1[1]; wi[6] = w1[2]; wi[7] = w1[3]; }
        const int lim = pos - 4 * fq;
        float mx = -INFINITY, mn = INFINITY;
        const u16* kbase = C.KI + (size_t)(b * SEQ + fr) * 64 + 8 * fq;
        const int stlim = 2 * nregU;
        h16x8 c00, c01, c10, c11;
        { const int st = w; const bool in0 = st < stlim && 2 * st <= qb, in1 = st < stlim && 2 * st + 1 <= qb;
          const u16* kp = kbase + (size_t)(32 * st) * 64; const h16x8 z = {0, 0, 0, 0, 0, 0, 0, 0};
          c00 = in0 ? *(const h16x8*)kp : z; c01 = in0 ? *(const h16x8*)(kp + 32) : z; c10 = in1 ? *(const h16x8*)(kp + 16 * 64) : z; c11 = in1 ? *(const h16x8*)(kp + 16 * 64 + 32) : z; }
#pragma unroll 1
        for (int st = w; st < stlim; st += 8) {
            h16x8 n00, n01, n10, n11;
            { const int sn = st + 8; const bool in0 = sn < stlim && 2 * sn <= qb, in1 = sn < stlim && 2 * sn + 1 <= qb;
              const u16* kp = kbase + (size_t)(32 * sn) * 64; const h16x8 z = {0, 0, 0, 0, 0, 0, 0, 0};
              n00 = in0 ? *(const h16x8*)kp : z; n01 = in0 ? *(const h16x8*)(kp + 32) : z; n10 = in1 ? *(const h16x8*)(kp + 16 * 64) : z; n11 = in1 ? *(const h16x8*)(kp + 16 * 64 + 32) : z; }
#pragma unroll
            for (int tt = 0; tt < 2; ++tt) {
                const int kt = 2 * st + tt;
                f32x4 sc = {-INFINITY, -INFINITY, -INFINITY, -INFINITY};
                if (kt <= qb) {
                    const h16x8 a0 = tt ? c10 : c00, a1 = tt ? c11 : c01;
                    f32x4 sum = {0.f, 0.f, 0.f, 0.f};
#pragma unroll
                    for (int h = 0; h < 8; ++h) {
                        f32x4 acc = {0.f, 0.f, 0.f, 0.f};
                        acc = __builtin_amdgcn_mfma_f32_16x16x32_f16(a0, qf[h][0], acc, 0, 0, 0);
                        acc = __builtin_amdgcn_mfma_f32_16x16x32_f16(a1, qf[h][1], acc, 0, 0, 0);
#pragma unroll
                        for (int r = 0; r < 4; ++r) sum[r] += wi[h] * fmaxf(acc[r], 0.f);
                    }
#pragma unroll
                    for (int r = 0; r < 4; ++r) { const bool ok = 16 * kt + r <= lim; sc[r] = ok ? sum[r] : -INFINITY; mx = fmaxf(mx, sc[r]); mn = fminf(mn, ok ? sum[r] : INFINITY); }
                }
                *(LAS f32x4*)(SC + fr * QS + 32 * st + 16 * tt + 4 * fq) = sc;
            }
            c00 = n00; c01 = n01; c10 = n10; c11 = n11;
        }
        mx = fmaxf(mx, __shfl_xor(mx, 16)); mx = fmaxf(mx, __shfl_xor(mx, 32)); mn = fminf(mn, __shfl_xor(mn, 16)); mn = fminf(mn, __shfl_xor(mn, 32));
        if (fq == 0 && mx > -INFINITY) { atomicMax((unsigned*)&RM[par * 32 + fr], fkey(mx)); atomicMin((unsigned*)&RM[par * 32 + 16 + fr], fkey(mn)); }
    }
    TS(13);
    __syncthreads();
    TS(14);
#pragma unroll 1
    for (;;) {
        int q = 0;
        if (lane == 0) q = (int)atomicAdd((unsigned*)&RT[par], 1u);
        q = __builtin_amdgcn_readfirstlane(q);
        if (q >= 16) break;
        const int pos = 16 * qb + q, n = pos + 1;
        float sv[32];
#pragma unroll
        for (int j = 0; j < 32; ++j) sv[j] = (j < nregU) ? SC[q * QS + 64 * j + lane] : -INFINITY;
        SelSt A; A.init(n);
        if (n > 256) {
            const float hi = unkey(RM[par * 32 + q]);
            A.lo = unkey(RM[par * 32 + 16 + q]);
            A.hi = hi + fmaxf(fabsf(hi) * 1e-6f, 1e-30f);
#pragma unroll 1
            for (int it = 0; it < 20; ++it) {
                if (!A.active()) break;
                const float x = A.pivot();
                const int c = wave_sum_i(cnt_lane(sv, nregU, x));
                A.update(x, c);
            }
            if (!A.found) sel_exact(sv, nregU, lane, A);
        }
        sel_write(C, sv, nregU, lane, A, b * SEQ + pos);
    }
}
__device__ __forceinline__ void pool_unit(const Ctx& C, int u);
__device__ __forceinline__ void stageA_phase(const Ctx& C, unsigned* head) {
    LAS int* slot = (LAS int*)(C.lds + LDSCTL_OFF + 256);
    int tk = wq_first(C, head), par = 0;
    while (tk < 1536) {
        int nx = 0;
        if (C.tid == 0) nx = (int)__hip_atomic_fetch_add(head, 1u, __ATOMIC_RELAXED, __HIP_MEMORY_SCOPE_AGENT);
        if (tk < 1024) { stageA_unit(C, tk & 7, 127 - (tk >> 3), par); par ^= 1; TS(17); }
        else { pool_unit(C, tk - 1024); TS(21); }
        __syncthreads();
        if (C.tid == 0) *slot = nx;
        __syncthreads();
        tk = *slot;
    }
}
__device__ __forceinline__ int swz(int r, int c) { return r * 128 + ((c ^ ((r >> 1) & 7)) << 4); }
__device__ __forceinline__ float maskf(float sv, unsigned mbits, int pos) {
    const int m = __builtin_amdgcn_sbfe(mbits, pos, 1);
    float r; const float ninf = -INFINITY;
    asm("v_bfi_b32 %0, %1, %2, %3" : "=v"(r) : "v"(m), "v"(sv), "s"(ninf));
    return r;
}
__device__ __forceinline__ h16x8 pack8(const f32x16& p, int b0) {
    typedef __fp16 hh2 __attribute__((ext_vector_type(2)));
    typedef unsigned u4 __attribute__((ext_vector_type(4)));
    u4 v;
    v.x = __builtin_bit_cast(unsigned, (hh2)__builtin_amdgcn_cvt_pkrtz(p[b0], p[b0 + 1])); v.y = __builtin_bit_cast(unsigned, (hh2)__builtin_amdgcn_cvt_pkrtz(p[b0 + 2], p[b0 + 3]));
    v.z = __builtin_bit_cast(unsigned, (hh2)__builtin_amdgcn_cvt_pkrtz(p[b0 + 4], p[b0 + 5])); v.w = __builtin_bit_cast(unsigned, (hh2)__builtin_amdgcn_cvt_pkrtz(p[b0 + 6], p[b0 + 7]));
    return __builtin_bit_cast(h16x8, v);
}
#define MX3(a, b, c) __builtin_fmaxf(__builtin_fmaxf((a), (b)), (c))
#define SBAR0() __builtin_amdgcn_sched_barrier(0)
__device__ __forceinline__ int opq(int x) { asm volatile("" : "+v"(x)); return x; }
__device__ __forceinline__ void stageB_unit(const Ctx& C0, int b, int kvh, int qb) {
    Ctx C = C0; C.tid = opq(C0.tid); C.lane = C.tid & 63;
    LAS unsigned char* L = C.lds;
    const int w = C.wave, lane = C.lane, q32 = lane & 31, half = lane >> 5, h = kvh * 4 + (w & 3);
    const int t = b * SEQ + 64 * qb + 32 * (w >> 2) + q32;
    h16x8 qf[4];
#pragma unroll
    for (int ks = 0; ks < 4; ++ks) qf[ks] = *(const h16x8*)(C.Q + (size_t)t * 512 + h * 64 + 16 * ks + 8 * half);
    f32x16 o0, o1, sN0, sN1, sC0, sC1;
    const f32x16 zero16 = {0.f, 0.f, 0.f, 0.f, 0.f, 0.f, 0.f, 0.f, 0.f, 0.f, 0.f, 0.f, 0.f, 0.f, 0.f, 0.f};
#pragma unroll
    for (int r = 0; r < 16; ++r) { o0[r] = 0.f; o1[r] = 0.f; }
    float m_run = 0.f, l_run = 0.f; bool has = false;
    asm volatile("" : "+v"(m_run));
    const int lr = C.tid >> 3, lc = C.tid & 7;
    const u16* kg = C.K + ((size_t)(b * SEQ) + lr) * 128 + kvh * 64 + lc * 8;
    const u16* vg = C.VT + ((size_t)((b * 2 + kvh) * 64 + lr)) * SEQ + lc * 8;
    const int ldsw = swz(lr, lc);
    const unsigned* mg = C.MASK + (size_t)t * 64;
    const int nt = qb + 1;
    constexpr float THR = 8.f;
    const int fo0 = swz(q32, half);
#define fo1 (fo0 ^ 32)
#define fo2 (fo0 ^ 64)
#define fo3 (fo0 ^ 96)
    h16x8 kf[8], vf[8];
#define LDK(slot) do { LAS unsigned char* kb_ = L + (slot) * 8192; \
        kf[0] = *(const LAS h16x8*)(kb_ + fo0); kf[1] = *(const LAS h16x8*)(kb_ + 4096 + fo0); kf[2] = *(const LAS h16x8*)(kb_ + fo1); kf[3] = *(const LAS h16x8*)(kb_ + 4096 + fo1); \
        kf[4] = *(const LAS h16x8*)(kb_ + fo2); kf[5] = *(const LAS h16x8*)(kb_ + 4096 + fo2); kf[6] = *(const LAS h16x8*)(kb_ + fo3); kf[7] = *(const LAS h16x8*)(kb_ + 4096 + fo3); } while (0)
#define LDV(slot) do { LAS unsigned char* vb_ = L + 32768 + (slot) * 8192; \
        vf[0] = *(const LAS h16x8*)(vb_ + fo0); vf[1] = *(const LAS h16x8*)(vb_ + 4096 + fo0); vf[2] = *(const LAS h16x8*)(vb_ + fo1); vf[3] = *(const LAS h16x8*)(vb_ + 4096 + fo1); \
        vf[4] = *(const LAS h16x8*)(vb_ + fo2); vf[5] = *(const LAS h16x8*)(vb_ + 4096 + fo2); vf[6] = *(const LAS h16x8*)(vb_ + fo3); vf[7] = *(const LAS h16x8*)(vb_ + 4096 + fo3); } while (0)
#define QKT() do { \
        sN0 = __builtin_amdgcn_mfma_f32_32x32x16_f16(kf[0], qf[0], zero16, 0, 0, 0); sN1 = __builtin_amdgcn_mfma_f32_32x32x16_f16(kf[1], qf[0], zero16, 0, 0, 0); \
        sN0 = __builtin_amdgcn_mfma_f32_32x32x16_f16(kf[2], qf[1], sN0, 0, 0, 0);  sN1 = __builtin_amdgcn_mfma_f32_32x32x16_f16(kf[3], qf[1], sN1, 0, 0, 0); \
        sN0 = __builtin_amdgcn_mfma_f32_32x32x16_f16(kf[4], qf[2], sN0, 0, 0, 0);  sN1 = __builtin_amdgcn_mfma_f32_32x32x16_f16(kf[5], qf[2], sN1, 0, 0, 0); \
        sN0 = __builtin_amdgcn_mfma_f32_32x32x16_f16(kf[6], qf[3], sN0, 0, 0, 0);  sN1 = __builtin_amdgcn_mfma_f32_32x32x16_f16(kf[7], qf[3], sN1, 0, 0, 0); } while (0)
#define SM1(mwx, mwy) do { const unsigned m0_ = (mwx) >> (4 * half), m1_ = (mwy) >> (4 * half); \
        _Pragma("unroll") for (int r = 0; r < 16; ++r) { const int pos = (r & 3) + 8 * (r >> 2); sC0[r] = maskf(sN0[r] - m_run, m0_, pos); sC1[r] = maskf(sN1[r] - m_run, m1_, pos); } \
        float mx = MX3(sC0[0], sC0[1], sC1[0]), my = MX3(sC0[2], sC0[3], sC1[1]); mx = MX3(mx, sC1[2], sC1[3]); \
        _Pragma("unroll") for (int r = 4; r < 16; r += 4) { mx = MX3(mx, sC0[r], sC0[r + 1]); my = MX3(my, sC0[r + 2], sC0[r + 3]); mx = MX3(mx, sC1[r], sC1[r + 1]); my = MX3(my, sC1[r + 2], sC1[r + 3]); } \
        mx = fmaxf(mx, my); { auto rr_ = __builtin_amdgcn_permlane32_swap(__float_as_uint(mx), __float_as_uint(mx), false, false); mx = fmaxf(__uint_as_float(rr_[0]), __uint_as_float(rr_[1])); } \
        if (__any(mx > THR || (!has && mx > -INFINITY))) { \
            const float dl = has ? fmaxf(mx, 0.f) : (mx > -INFINITY ? mx : 0.f); has = has || mx > -INFINITY; m_run += dl; \
            const float f = __builtin_amdgcn_exp2f(-dl); l_run *= f; \
            _Pragma("unroll") for (int r = 0; r < 16; ++r) { sC0[r] -= dl; sC1[r] -= dl; o0[r] *= f; o1[r] *= f; } } } while (0)
    __syncthreads();
    {
        v4u kr0 = *(const v4u*)kg, vr0 = *(const v4u*)vg, kr1 = kr0, vr1 = vr0, kr2 = kr0, vr2 = vr0;
        if (nt > 1) { kr1 = *(const v4u*)(kg + (size_t)64 * 128); vr1 = *(const v4u*)(vg + 64); }
        if (nt > 2) { kr2 = *(const v4u*)(kg + (size_t)128 * 128); vr2 = *(const v4u*)(vg + 128); }
        *(LAS v4u*)(L + ldsw) = kr0; *(LAS v4u*)(L + 32768 + ldsw) = vr0;
        *(LAS v4u*)(L + 8192 + ldsw) = kr1; *(LAS v4u*)(L + 32768 + 8192 + ldsw) = vr1;
        *(LAS v4u*)(L + 16384 + ldsw) = kr2; *(LAS v4u*)(L + 32768 + 16384 + ldsw) = vr2;
    }
    uint2 mwB = *(const uint2*)mg, mwC = make_uint2(0u, 0u);
    __syncthreads();
    LDK(0); QKT();
    SM1(mwB.x, mwB.y);
    if (nt > 1) { mwB = *(const uint2*)(mg + 2); LDK(1); }
#pragma unroll 1
    for (int j = 0; j < nt; ++j) {
        const bool l3 = j + 3 < nt, n1 = j + 1 < nt, n2 = j + 2 < nt;
        v4u kr = {0u, 0u, 0u, 0u}, vr = {0u, 0u, 0u, 0u};
        if (l3) { kr = *(const v4u*)(kg + (size_t)(j + 3) * 64 * 128); vr = *(const v4u*)(vg + (j + 3) * 64); }
        if (n2) mwC = *(const uint2*)(mg + 2 * (j + 2));
        SBAR0();
        if (n1) QKT();
        SBAR0();
        LDV(j & 3);
        SBAR0();
        float ls = 0.f, lt = 0.f;
#pragma unroll
        for (int r = 0; r < 16; ++r) { sC0[r] = __builtin_amdgcn_exp2f(sC0[r]); sC1[r] = __builtin_amdgcn_exp2f(sC1[r]); ls += sC0[r]; lt += sC1[r]; }
        l_run += ls + lt;
        const h16x8 pb0 = pack8(sC0, 0), pb1 = pack8(sC0, 8), pb2 = pack8(sC1, 0), pb3 = pack8(sC1, 8);
        SBAR0();
        o0 = __builtin_amdgcn_mfma_f32_32x32x16_f16(vf[0], pb0, o0, 0, 0, 0); o1 = __builtin_amdgcn_mfma_f32_32x32x16_f16(vf[1], pb0, o1, 0, 0, 0);
        o0 = __builtin_amdgcn_mfma_f32_32x32x16_f16(vf[2], pb1, o0, 0, 0, 0); o1 = __builtin_amdgcn_mfma_f32_32x32x16_f16(vf[3], pb1, o1, 0, 0, 0);
        o0 = __builtin_amdgcn_mfma_f32_32x32x16_f16(vf[4], pb2, o0, 0, 0, 0); o1 = __builtin_amdgcn_mfma_f32_32x32x16_f16(vf[5], pb2, o1, 0, 0, 0);
        o0 = __builtin_amdgcn_mfma_f32_32x32x16_f16(vf[6], pb3, o0, 0, 0, 0); o1 = __builtin_amdgcn_mfma_f32_32x32x16_f16(vf[7], pb3, o1, 0, 0, 0);
        SBAR0();
        if (n2) LDK((j + 2) & 3);
        SBAR0();
        if (n1) { SM1(mwB.x, mwB.y); }
        mwB = mwC;
        SBAR0();
        if (l3) { *(LAS v4u*)(L + ((j + 3) & 3) * 8192 + ldsw) = kr; *(LAS v4u*)(L + 32768 + ((j + 3) & 3) * 8192 + ldsw) = vr; }
        __syncthreads();
    }
#undef fo1
#undef fo2
#undef fo3
#undef LDK
#undef LDV
#undef QKT
#undef SM1
    { auto rr_ = __builtin_amdgcn_permlane32_swap(__float_as_uint(l_run), __float_as_uint(l_run), false, false); l_run = __uint_as_float(rr_[0]) + __uint_as_float(rr_[1]); }
    const float inv = 1.f / l_run;
    const u16* gp = C.GA + (size_t)t * 512 + h * 64 + 4 * half; u16* mp = C.MIX + (size_t)t * 1024 + 512 + h * 64 + 4 * half;
#pragma unroll
    for (int dt = 0; dt < 2; ++dt)
#pragma unroll
        for (int g4 = 0; g4 < 4; ++g4) {
            const int d0 = 32 * dt + 8 * g4;
            const uint2 gv = *(const uint2*)(gp + d0);
            const float ga0 = h2f((u16)(gv.x & 0xffffu)), ga1 = h2f((u16)(gv.x >> 16)), ga2 = h2f((u16)(gv.y & 0xffffu)), ga3 = h2f((u16)(gv.y >> 16));
            const f32x16& oo = dt ? o1 : o0;
            uint2 ov; ov.x = pk2h(oo[4 * g4] * inv * ga0, oo[4 * g4 + 1] * inv * ga1); ov.y = pk2h(oo[4 * g4 + 2] * inv * ga2, oo[4 * g4 + 3] * inv * ga3);
            *(uint2*)(mp + d0) = ov;
        }
}
__device__ __forceinline__ void stageB_phase(const Ctx& C, unsigned* head) {
    LAS int* slot = (LAS int*)(C.lds + LDSCTL_OFF + 256);
    int tk = wq_first(C, head);
    while (tk < 512) {
        int nx = 0;
        if (C.tid == 0) nx = (int)__hip_atomic_fetch_add(head, 1u, __ATOMIC_RELAXED, __HIP_MEMORY_SCOPE_AGENT);
        const int bk = tk & 15;
        stageB_unit(C, bk >> 1, bk & 1, 31 - (tk >> 4));
        __syncthreads();
        if (C.tid == 0) *slot = nx;
        __syncthreads();
        tk = *slot;
    }
}
__device__ __forceinline__ void selattn_row_naive(const Ctx& C, int t) {
    LAS float* qs = (LAS float*)C.lds;
    LAS unsigned* keys = (LAS unsigned*)(C.lds + 2048);
    LAS unsigned* mk = (LAS unsigned*)(C.lds + 10240);
    LAS int* wpre = (LAS int*)(C.lds + 10496);
    LAS int* red = (LAS int*)(C.lds + 10816);
    LAS int* sel = (LAS int*)(C.lds + 10880);
    LAS float* p = (LAS float*)(C.lds + 11904);
    LAS float* hl = (LAS float*)(C.lds + 21120);
    const int b = t >> 11, pos = t & (SEQ - 1), n = pos + 1, tid = C.tid;
    __syncthreads();
    if (tid < 64) mk[tid] = C.MASK[(size_t)t * 64 + tid];
    __syncthreads();
    if (tid == 0) { int a = 0; for (int i = 0; i < 64; ++i) { wpre[i] = a; a += __popc(mk[i]); } wpre[64] = a; }
    __syncthreads();
    const int nsel = wpre[64];
    for (int s = tid; s < n; s += NTH) { const unsigned wv = mk[s >> 5]; if ((wv >> (s & 31)) & 1u) sel[wpre[s >> 5] + __popc(wv & ((1u << (s & 31)) - 1u))] = s; }
    for (int i = tid; i < 512; i += NTH) qs[i] = h2f(C.Q[(size_t)t * 512 + i]);
    __syncthreads();
    if (tid < 256) {
        if (tid < nsel) {
            const int s = sel[tid];
#pragma unroll
            for (int kvh = 0; kvh < 2; ++kvh) {
                const u16* kp = C.K + (size_t)(b * SEQ + s) * 128 + kvh * 64;
                float dq[4] = {0.f, 0.f, 0.f, 0.f};
#pragma unroll 1
                for (int i = 0; i < 8; ++i) { const h16x8 v8 = *(const h16x8*)(kp + 8 * i);
#pragma unroll
                    for (int gq = 0; gq < 4; ++gq) {
#pragma unroll
                        for (int j = 0; j < 8; ++j) dq[gq] += qs[(kvh * 4 + gq) * 64 + 8 * i + j] * (float)v8[j]; } }
#pragma unroll
                for (int gq = 0; gq < 4; ++gq) p[tid * 9 + kvh * 4 + gq] = dq[gq];
            }
        } else {
#pragma unroll
            for (int h = 0; h < 8; ++h) p[tid * 9 + h] = -INFINITY;
        }
    }
    __syncthreads();
    {
        const int h = C.wave, lane = C.lane;
        float m = -INFINITY;
        for (int j = lane; j < 256; j += 64) m = fmaxf(m, p[j * 9 + h]);
#pragma unroll
        for (int o2 = 1; o2 < 64; o2 <<= 1) m = fmaxf(m, __shfl_xor(m, o2));
        float l = 0.f;
        for (int j = lane; j < 256; j += 64) { const float e = exp2f(p[j * 9 + h] - m); p[j * 9 + h] = e; l += e; }
        l = wave_sum(l);
        if (lane == 0) hl[h] = l;
    }
    __syncthreads();
    {
        const int h = tid >> 6, d = tid & 63, kvh = h >> 2;
        float a0 = 0.f;
        for (int j = 0; j < nsel; ++j) a0 += p[j * 9 + h] * h2f(C.V[(size_t)(b * SEQ + sel[j]) * 128 + kvh * 64 + d]);
        C.MIX[(size_t)t * 1024 + 512 + h * 64 + d] = f2h(a0 / hl[h] * h2f(C.GA[(size_t)t * 512 + h * 64 + d]));
    }
}

__device__ __forceinline__ void phase3_naive(const Ctx& C) {
    for (int u = C.bid; u < 16 * 128; u += C.G) {
        const int c0 = (u & 15) * 64, r0 = (u >> 4) * 128, w = C.wave, lane = C.lane, wr = w & 3, wcn = w >> 2;
        const u16* ap = C.MIX + (size_t)(r0 + wr * 32 + (lane & 31)) * DM + 8 * (lane >> 5);
        const u16* bp = C.WoutT + (size_t)(c0 + wcn * 32 + (lane & 31)) * DM + 8 * (lane >> 5);
        f32x16 acc;
#pragma unroll
        for (int r = 0; r < 16; ++r) acc[r] = 0.f;
        for (int k0 = 0; k0 < DM; k0 += 16) {
            const h16x8 a = *(const h16x8*)(ap + k0), bb = *(const h16x8*)(bp + k0);
            acc = __builtin_amdgcn_mfma_f32_32x32x16_f16(a, bb, acc, 0, 0, 0);
        }
        const int col = c0 + wcn * 32 + (lane & 31), b = r0 >> 11;
        const float gate = C.mod[b * 3072 + 2048 + col];
#pragma unroll
        for (int r = 0; r < 16; ++r) {
            const int row = r0 + wr * 32 + (r & 3) + 8 * (r >> 2) + 4 * (lane >> 5);
            C.out[(size_t)row * DM + col] = C.x[(size_t)row * DM + col] + gate * acc[r];
        }
    }
}

struct Args { const float* in[11]; float* out; unsigned char* ws; };
__global__ void __launch_bounds__(NTH, 2) mk_fwd(Args a) {
    extern __shared__ __attribute__((aligned(16))) unsigned char lds_raw[];
    Ctx C;
    C.lds = (LAS unsigned char*)lds_raw;
    C.tid = threadIdx.x; C.lane = C.tid & 63; C.wave = __builtin_amdgcn_readfirstlane(C.tid >> 6); C.bid = blockIdx.x; C.G = gridDim.x;
    C.x = a.in[0]; C.c = a.in[1]; C.norm_w = a.in[2]; C.w_ada = a.in[3]; C.b_ada = a.in[4]; C.w_in = a.in[5]; C.qnw = a.in[6]; C.knw = a.in[7];
    C.w_pool = a.in[8]; C.pool_scale = a.in[9]; C.w_out = a.in[10]; C.out = a.out;
    unsigned char* ws = a.ws;
    C.mod = (float*)(ws + WS_MOD); C.rope = (float2*)(ws + WS_ROPE); C.WinT = (u16*)(ws + WS_WINT); C.WoutT = (u16*)(ws + WS_WOUTT); C.XN = (u16*)(ws + WS_XN);
    C.U = (u16*)(ws + WS_U); C.SG = (u16*)(ws + WS_SG); C.Q = (u16*)(ws + WS_Q); C.GA = (u16*)(ws + WS_GA); C.QI = (u16*)(ws + WS_QI);
    C.K = (u16*)(ws + WS_K); C.V = (u16*)(ws + WS_V); C.KI = (u16*)(ws + WS_KI); C.VT = C.V; C.WpT = (u16*)(ws + WS_WPT); C.WI = (float*)(ws + WS_WI); C.MASK = (unsigned*)(ws + WS_MASK); C.MIX = (u16*)(ws + WS_MIX);
    volatile LAS unsigned* MISC = (volatile LAS unsigned*)(C.lds + MISC_OFF);
    for (int u = C.tid; u < (LDS_BYTES - LDSCTL_OFF) / 4; u += NTH) ((LAS unsigned*)(C.lds + LDSCTL_OFF))[u] = 0u;
    __syncthreads();
    XcdBarrier bar = xcd_barrier_post((unsigned*)(ws + WS_CTL) + CW_BAR, MISC + 8);

    TS(30);
    phase0(C);
    TS(0); xcd_barrier(bar); TS(1);
    phase0b(C);
    TS(2); xcd_barrier(bar); TS(3);
    {
        pg8::Gemm g{C.XN, C.WinT, MT, NPAD, DM}; pg8::StaticOrder S; S.init(MT, NPAD, C.G, C.bid);
        EpiP1 E{C.U, C.SG, C.Q, C.GA, C.QI, C.K, C.V, C.KI, C.WI, C.qnw, C.knw, C.rope};
        pg8::gemm_phase<EpiP1, pg8::StaticOrder, true, true>(C.lds, g, S, E);
    }
    TS(4); xcd_barrier(bar); TS(5);
    stageA_phase(C, (unsigned*)(ws + WS_CTL) + CW_QA);
    TS(6); xcd_barrier(bar); TS(8);
    stageB_phase(C, (unsigned*)(ws + WS_CTL) + CW_QB);
    TS(9); xcd_barrier(bar); TS(10);
    {
        pg8::Gemm g{C.MIX, C.WoutT, MT, DM, DM}; pg8::StaticOrder S; S.init(MT, DM, C.G, C.bid);
        EpiOut E{C.x, C.mod + 2048, C.out};
        pg8::gemm_phase<EpiOut, pg8::StaticOrder, true, true>(C.lds, g, S, E);
    }
    TS(11);
    if (ECHO >= 0) { xcd_barrier(bar); if (threadIdx.x == 0) { volatile LAS unsigned long long* tsb_ = (volatile LAS unsigned long long*)(C.lds + LDSCTL_OFF + 512); unsigned long long d_ = 0; for (int k_ = 0; k_ < 30; ++k_) if ((ECHOM >> k_) & 1) d_ += tsb_[k_]; const unsigned long long t0_ = __builtin_amdgcn_s_memtime(); while (__builtin_amdgcn_s_memtime() - t0_ < d_) __builtin_amdgcn_s_sleep(8); } __syncthreads(); }
}

extern "C" void kernel_launch(void* const* d_in, const int* in_sizes, int n_in, void* d_out, int out_size, void* d_ws, size_t ws_size, hipStream_t stream) {
    (void)in_sizes; (void)out_size;
    static int grid = 0;
    if (grid == 0) {
        if (n_in != 11 || ws_size < WS_END) { fprintf(stderr, "kernel_launch: unexpected inputs / workspace (%d, %zu)\n", n_in, ws_size); grid = -1; return; }
        int dev = 0, cus = 0, per_cu = 0;
        hipGetDevice(&dev); hipDeviceGetAttribute(&cus, hipDeviceAttributeMultiprocessorCount, dev);
        hipFuncSetAttribute((const void*)mk_fwd, hipFuncAttributeMaxDynamicSharedMemorySize, LDS_BYTES);
        hipOccupancyMaxActiveBlocksPerMultiprocessor(&per_cu, (const void*)mk_fwd, NTH, LDS_BYTES);
        (void)hipGetLastError();
        if (per_cu < 1) { fprintf(stderr, "kernel_launch: occupancy query says %d blocks per CU\n", per_cu); per_cu = 1; }
        grid = cus;
    }
    if (grid < 0) return;
    hipMemsetAsync((char*)d_ws + WS_CTL, 0, CTL_ZERO_BYTES, stream);
    Args a{};
    for (int i = 0; i < 11; ++i) a.in[i] = (const float*)d_in[i];
    a.out = (float*)d_out; a.ws = (unsigned char*)d_ws;
    void* kargs[] = {&a};
    hipError_t e = hipLaunchCooperativeKernel((const void*)mk_fwd, dim3(grid), dim3(NTH), kargs, LDS_BYTES, stream);
    if (e != hipSuccess) fprintf(stderr, "kernel_launch: cooperative launch failed: %s (grid %d)\n", hipGetErrorString(e), grid);
}
```
